# Optimizing an MI355X kernel written in HIP

```python
import jax
import jax.numpy as jnp
from jax import lax
import numpy as np


D_MODEL = 1024
BATCH = 1
SEQ = 16384
DEPTH = 2

CHUNK = 64
N_MEM = 256
N_BRANCH = 5
BRANCH_WIDTH = D_MODEL // 2
N_HEADS = 4
HEAD_DIM = BRANCH_WIDTH // N_HEADS
SB_BLOCK = 128
GMLP_BLOCK = 128
GM_GROUPS = 4
CONV_WIDTH = 4
ROPE_BASE = 10000.0
EPS = 1e-6

kernel_name = "hybrid_stickbreak_mlstm_gmlp_retention_block"


def _in_sizes():
    w, h = BRANCH_WIDTH, N_HEADS
    return ([w] * 4
            + [w] * 5 + [h, h]
            + [w] * 3
            + [w] * 4
            + [w] * 2
            + [N_BRANCH * D_MODEL])


def rms_norm(x, g):
    xf = x.astype(jnp.float32)
    y = xf * lax.rsqrt(jnp.mean(xf * xf, axis=-1, keepdims=True) + EPS)
    return (y * g.astype(jnp.float32)).astype(x.dtype)


def layer_norm(x, g, b):
    xf = x.astype(jnp.float32)
    mu = jnp.mean(xf, axis=-1, keepdims=True)
    var = jnp.mean(jnp.square(xf - mu), axis=-1, keepdims=True)
    y = (xf - mu) * lax.rsqrt(var + EPS)
    return (y * g.astype(jnp.float32) + b.astype(jnp.float32)).astype(x.dtype)


def head_norm(t):
    tf = t.astype(jnp.float32)
    mu = jnp.mean(tf, axis=-1, keepdims=True)
    var = jnp.mean(jnp.square(tf - mu), axis=-1, keepdims=True)
    return (tf - mu) * lax.rsqrt(var + EPS)


def causal_conv(x, w):
    k = w.shape[0]
    return lax.conv_general_dilated(
        x, w[:, None, :].astype(x.dtype), window_strides=(1,), padding=((k - 1, 0),),
        dimension_numbers=('NWC', 'WIO', 'NWC'), feature_group_count=x.shape[-1])


def rotary(t, positions):
    half = t.shape[-1] // 2
    inv_freq = ROPE_BASE ** (-jnp.arange(half, dtype=jnp.float32) / half)
    ang = positions.astype(jnp.float32)[..., None] * inv_freq
    cos, sin = jnp.cos(ang)[:, :, None, :], jnp.sin(ang)[:, :, None, :]
    tf = t.astype(jnp.float32)
    t1, t2 = tf[..., :half], tf[..., half:]
    return jnp.concatenate([t1 * cos - t2 * sin, t1 * sin + t2 * cos], axis=-1)


def to_chunks(t):
    b, s, h = t.shape[:3]
    t = t.astype(jnp.float32).reshape(b, s // CHUNK, CHUNK, h, *t.shape[3:])
    return jnp.moveaxis(t, 3, 1)


def from_chunks(t):
    b, h, nc, l, d = t.shape
    return jnp.moveaxis(t, 1, 3).reshape(b, nc * l, h, d)


def stick_breaking(q, k, v):
    b, s, h, d = q.shape
    nb = s // SB_BLOCK
    qb = q.reshape(b, nb, SB_BLOCK, h, d).transpose(1, 0, 3, 2, 4)
    kf = k.transpose(0, 2, 1, 3).astype(jnp.float32)
    vf = v.transpose(0, 2, 1, 3).astype(jnp.float32)
    key_pos = jnp.arange(s)
    scale = d ** -0.5

    def block(args):
        q_blk, i = args
        z = jnp.einsum('bhqd,bhkd->bhqk', q_blk.astype(jnp.float32), kf) * scale
        q_pos = i * SB_BLOCK + jnp.arange(SB_BLOCK)
        valid = key_pos[None, :] < q_pos[:, None]
        log_keep = jnp.where(valid, -jax.nn.softplus(z), 0.0)
        later = lax.cumsum(log_keep, axis=3, reverse=True) - log_keep
        w = jnp.where(valid, jnp.exp(jax.nn.log_sigmoid(z) + later), 0.0)
        return jnp.einsum('bhqk,bhkd->bhqd', w, vf)

    out = lax.map(block, (qb, jnp.arange(nb)))
    return out.transpose(1, 0, 3, 2, 4).reshape(b, s, h, d).astype(q.dtype)


def mlstm(q, k, v, i_pre, f_pre):
    b_, s_, h_, d = q.shape
    qc, kc, vc = to_chunks(q), to_chunks(k) * d ** -0.5, to_chunks(v)
    ic = to_chunks(i_pre)
    bcum = jnp.cumsum(jax.nn.log_sigmoid(to_chunks(f_pre)), axis=-1)
    g = bcum + lax.cummax(ic - bcum, axis=3)
    b_last, a_last = bcum[..., -1], g[..., -1]
    w_end = jnp.exp(b_last[..., None] - bcum + ic - a_last[..., None])
    kv_loc = jnp.einsum('bhcld,bhcle->bhcde', kc * w_end[..., None], vc)
    n_loc = jnp.einsum('bhcl,bhcld->bhcd', w_end, kc)

    def step(carry, inp):
        c_st, n_st, m_st = carry
        bl, al, kv, nl = inp
        m_new = jnp.maximum(bl + m_st, al)
        d_old = jnp.exp(bl + m_st - m_new)
        d_loc = jnp.exp(al - m_new)
        c_new = d_old[..., None, None] * c_st + d_loc[..., None, None] * kv
        n_new = d_old[..., None] * n_st + d_loc[..., None] * nl
        return (c_new, n_new, m_new), (c_st, n_st, m_st)

    init = (jnp.zeros((b_, h_, d, d), jnp.float32), jnp.zeros((b_, h_, d), jnp.float32),
            jnp.zeros((b_, h_), jnp.float32))
    xs = (jnp.moveaxis(b_last, 2, 0), jnp.moveaxis(a_last, 2, 0),
          jnp.moveaxis(kv_loc, 2, 0), jnp.moveaxis(n_loc, 2, 0))
    _, (c_prev, n_prev, m_prev) = lax.scan(step, init, xs)
    c_prev = jnp.moveaxis(c_prev, 0, 2)
    n_prev = jnp.moveaxis(n_prev, 0, 2)
    m_prev = jnp.moveaxis(m_prev, 0, 2)

    m_t = jnp.maximum(bcum + m_prev[..., None], g)
    d_inter = jnp.exp(bcum + m_prev[..., None] - m_t)
    num = d_inter[..., None] * jnp.einsum('bhcld,bhcde->bhcle', qc, c_prev)
    den = d_inter * jnp.einsum('bhcld,bhcd->bhcl', qc, n_prev)
    causal = jnp.tril(jnp.ones((CHUNK, CHUNK), dtype=bool))
    log_d = bcum[..., :, None] - bcum[..., None, :] + ic[..., None, :] - m_t[..., :, None]
    d_intra = jnp.exp(jnp.where(causal, log_d, -jnp.inf))
    sc = jnp.einsum('bhctd,bhcsd->bhcts', qc, kc) * d_intra
    num = num + jnp.einsum('bhcts,bhcse->bhcte', sc, vc)
    den = den + jnp.sum(sc, axis=-1)
    h = num / jnp.maximum(jnp.abs(den), jnp.exp(-m_t))[..., None]
    return from_chunks(h)


def retention(q, k, v):
    b_, s_, h_, d = q.shape
    qc, kc, vc = to_chunks(q), to_chunks(k) * d ** -0.5, to_chunks(v)
    log_gamma = jnp.log(1.0 - 2.0 ** (-5.0 - jnp.arange(h_, dtype=jnp.float32)))
    idx = jnp.arange(CHUNK, dtype=jnp.float32)
    intra_decay = jnp.exp(log_gamma[:, None, None] * jnp.abs(idx[:, None] - idx[None, :]))
    sc = jnp.einsum('bhcnd,bhcmd->bhcnm', qc, kc) * intra_decay[:, None]
    intra = jnp.einsum('bhcnm,bhcme->bhcne', sc, vc)
    w_end = jnp.exp(log_gamma[:, None] * (CHUNK - 1 - idx))
    kv_loc = jnp.einsum('bhcld,bhcle->bhcde', kc * w_end[None, :, None, :, None], vc)
    chunk_decay = jnp.exp(log_gamma * CHUNK)[None, :, None, None]

    def step(state, kv):
        return chunk_decay * state + kv, state

    _, s_prev = lax.scan(step, jnp.zeros((b_, h_, d, d), jnp.float32), jnp.moveaxis(kv_loc, 2, 0))
    s_prev = jnp.moveaxis(s_prev, 0, 2)
    w_q = jnp.exp(log_gamma[:, None] * (idx + 1.0))
    inter = w_q[:, None, :, None] * jnp.einsum('bhcnd,bhcde->bhcne', qc, s_prev)
    return from_chunks(intra + inter)


def spatial_gating(u, v, ln_g, ln_b, w_s, b_s):
    b_, s_, w = u.shape
    v = layer_norm(v, ln_g, ln_b)
    vb = v.reshape(b_, s_ // GMLP_BLOCK, GMLP_BLOCK, GM_GROUPS, w // GM_GROUPS)
    chunk_id = jnp.arange(GMLP_BLOCK) // CHUNK
    mask = chunk_id[None, :] <= chunk_id[:, None]
    mixed = jnp.einsum('gpq,bnqgc->bnpgc', jnp.where(mask, w_s, 0.0).astype(v.dtype), vb)
    mixed = mixed + b_s.T[:, :, None].astype(v.dtype)
    return u * mixed.reshape(b_, s_, w)


def memory_attention(q, mem_k, mem_v):
    logits = jnp.einsum('bshd,bmhd->bhsm', q.astype(jnp.float32), mem_k.astype(jnp.float32))
    p = jax.nn.softmax(logits * q.shape[-1] ** -0.5, axis=-1)
    return jnp.einsum('bhsm,bmhd->bshd', p, mem_v.astype(jnp.float32)).astype(q.dtype)


def hybrid_layer(x, mem, positions, norm_pre, norm_post, w_in, b_igate, b_fgate, conv_q, conv_k,
                 gm_ln_g, gm_ln_b, gm_ws, gm_bs, mem_norm, w_mem_kv, w_up, w_out):
    b_, s_, _ = x.shape
    w = BRANCH_WIDTH
    heads = lambda t: t.reshape(t.shape[0], t.shape[1], N_HEADS, HEAD_DIM)
    flat = lambda t: t.reshape(b_, s_, w).astype(x.dtype)

    h = rms_norm(x, norm_pre)
    proj = h @ w_in
    split_points = [int(p) for p in np.cumsum(_in_sizes())[:-1]]
    (sb_q, sb_k, sb_v, sb_z,
     ml_q, ml_k, ml_v, ml_o, ml_z, ml_i, ml_f,
     gm_u, gm_v, gm_z,
     rt_q, rt_k, rt_v, rt_z,
     xa_q, xa_z, gates) = jnp.split(proj, split_points, axis=-1)

    y_sb = flat(stick_breaking(heads(sb_q), heads(sb_k), heads(sb_v)))
    q_ml = jax.nn.silu(causal_conv(ml_q, conv_q))
    k_ml = jax.nn.silu(causal_conv(ml_k, conv_k))
    h_ml = mlstm(heads(q_ml), heads(k_ml), heads(ml_v), ml_i + b_igate, ml_f + b_fgate)
    y_ml = flat(head_norm(h_ml)) * jax.nn.sigmoid(ml_o)
    y_gm = spatial_gating(jax.nn.gelu(gm_u), jax.nn.gelu(gm_v), gm_ln_g, gm_ln_b, gm_ws, gm_bs)
    y_rt = flat(head_norm(retention(rotary(heads(rt_q), positions), rotary(heads(rt_k), positions),
                                    heads(rt_v))))
    mkv = rms_norm(mem, mem_norm) @ w_mem_kv
    mem_k, mem_v = jnp.split(mkv, 2, axis=-1)
    y_xa = flat(memory_attention(heads(xa_q), heads(mem_k), heads(mem_v)))

    ys = jnp.stack([y_sb * jax.nn.silu(sb_z), y_ml * jax.nn.silu(ml_z), y_gm * jax.nn.silu(gm_z),
                    y_rt * jax.nn.silu(rt_z), y_xa * jax.nn.silu(xa_z)], axis=2)
    up = jnp.einsum('bsnw,nwd->bsnd', ys, w_up)
    merged = jnp.sum(jax.nn.sigmoid(gates.reshape(b_, s_, N_BRANCH, D_MODEL)) * up, axis=2)
    out = merged @ w_out
    return x + rms_norm(out, norm_post)


def setup_inputs(seed: int = 0) -> dict:
    key = jax.random.key(seed)
    ks = jax.random.split(key, 20)
    f32 = jnp.float32
    nrm = lambda k, shape, scale: jax.random.normal(k, shape, f32) * scale
    w = BRANCH_WIDTH
    d_in = sum(_in_sizes())
    x = nrm(ks[0], (BATCH, SEQ, D_MODEL), 1.0)
    mem = nrm(ks[1], (BATCH, N_MEM, D_MODEL), 1.0)
    offset = jax.random.randint(ks[2], (BATCH, 1), 0, 4096, dtype=jnp.int32)
    positions = offset + jnp.arange(SEQ, dtype=jnp.int32)[None, :]
    norm_pre = 1.0 + nrm(ks[3], (DEPTH, D_MODEL), 0.02)
    norm_post = 1.0 + nrm(ks[4], (DEPTH, D_MODEL), 0.02)
    w_in = nrm(ks[5], (DEPTH, D_MODEL, d_in), D_MODEL ** -0.5)
    b_igate = nrm(ks[6], (DEPTH, N_HEADS), 0.1)
    b_fgate = jnp.linspace(3.0, 6.0, N_HEADS, dtype=f32)[None, :] + nrm(ks[7], (DEPTH, N_HEADS), 0.1)
    conv_q = nrm(ks[8], (DEPTH, CONV_WIDTH, w), CONV_WIDTH ** -0.5)
    conv_k = nrm(ks[9], (DEPTH, CONV_WIDTH, w), CONV_WIDTH ** -0.5)
    gm_ln_g = 1.0 + nrm(ks[10], (DEPTH, w), 0.02)
    gm_ln_b = nrm(ks[11], (DEPTH, w), 0.02)
    gm_ws = nrm(ks[12], (DEPTH, GM_GROUPS, GMLP_BLOCK, GMLP_BLOCK), GMLP_BLOCK ** -0.5)
    gm_bs = 1.0 + nrm(ks[13], (DEPTH, GM_GROUPS, GMLP_BLOCK), 0.02)
    mem_norm = 1.0 + nrm(ks[14], (DEPTH, D_MODEL), 0.02)
    w_mem_kv = nrm(ks[15], (DEPTH, D_MODEL, 2 * w), D_MODEL ** -0.5)
    w_up = nrm(ks[16], (DEPTH, N_BRANCH, w, D_MODEL), w ** -0.5)
    w_out = nrm(ks[17], (DEPTH, D_MODEL, D_MODEL), D_MODEL ** -0.5)
    return {"x": x, "mem": mem, "positions": positions, "norm_pre": norm_pre, "norm_post": norm_post,
            "w_in": w_in, "b_igate": b_igate, "b_fgate": b_fgate, "conv_q": conv_q, "conv_k": conv_k,
            "gm_ln_g": gm_ln_g, "gm_ln_b": gm_ln_b, "gm_ws": gm_ws, "gm_bs": gm_bs,
            "mem_norm": mem_norm, "w_mem_kv": w_mem_kv, "w_up": w_up, "w_out": w_out}


def reference(x, mem, positions, norm_pre, norm_post, w_in, b_igate, b_fgate, conv_q, conv_k,
              gm_ln_g, gm_ln_b, gm_ws, gm_bs, mem_norm, w_mem_kv, w_up, w_out):
    for l in range(DEPTH):
        x = hybrid_layer(x, mem, positions, norm_pre[l], norm_post[l], w_in[l], b_igate[l], b_fgate[l],
                         conv_q[l], conv_k[l], gm_ln_g[l], gm_ln_b[l], gm_ws[l], gm_bs[l],
                         mem_norm[l], w_mem_kv[l], w_up[l], w_out[l])
    return x
```

```cpp
#include <hip/hip_runtime.h>
#include <hip/hip_cooperative_groups.h>
#include <cstdio>
namespace cg = cooperative_groups;
#ifndef ONE_LAUNCH
#define ONE_LAUNCH 0
#endif
namespace pg8 {
#define PG8_LAS __attribute__((address_space(3)))
typedef unsigned short bf16_t;
typedef short bf16x8 __attribute__((ext_vector_type(8)));
typedef float f32x4 __attribute__((ext_vector_type(4)));
typedef unsigned u32x4 __attribute__((ext_vector_type(4)));
constexpr int BM = 256, BK = 64, HALF = 128, HTB = HALF * BK * 2  , STAGE_BYTES = 8 * HTB, NXCD = 8, WGM = 8;

__host__ __device__ __forceinline__ int lds_byte(int r, int c) { const int st = (r >> 4) * 2 + (c >> 5), rr = r & 15, cc = c & 31, ob = rr * 64 + cc * 2; return st * 1024 + (ob ^ (((ob >> 9) & 1) << 5)); }
__host__ __device__ __forceinline__ void stage_rc(int b, int& R, int& C) { const int st = b / 1024, sb = b % 1024, swz = sb ^ (((sb >> 9) & 1) << 5); R = (st >> 1) * 16 + swz / 64; C = (st & 1) * 32 + (swz % 64) / 2; }
__host__ __device__ __forceinline__ int perm32(int rho) { const int n = rho >> 4, i = rho & 15; return 8 * (i >> 2) + 4 * n + (i & 3); }

struct Unit { int pm, pn; };
struct Gemm { const bf16_t* A; const bf16_t* Bt; int M, N, K; };

struct StaticOrder {
    int nM, nN, nwg, G, c;
    __host__ __device__ void init(int M, int N, int G_, int c_) { nM = M / BM; nN = N / BM; nwg = nM * nN; G = G_; c = c_; }
    __host__ __device__ bool next(int i, Unit& u) const {
        const long L = (long)i * G + c; if (L >= nwg) return false;
        int wgid = (int)L; { const int q = nwg / NXCD, r = nwg % NXCD, xcd = wgid % NXCD, off = wgid / NXCD; wgid = (xcd < r ? xcd * (q + 1) : r * (q + 1) + (xcd - r) * q) + off; }
        const int nig = WGM * nN, gid = wgid / nig, fm = gid * WGM, gsz = (nM - fm) < WGM ? (nM - fm) : WGM;
        u.pm = fm + ((wgid % nig) % gsz); u.pn = (wgid % nig) / gsz; return true;
    }
    __device__ __forceinline__ void a_ready(const Unit&) const {}
    __device__ __forceinline__ void done(const Unit&) const {}
};

typedef __bf16 bf16v2_t __attribute__((ext_vector_type(2)));
typedef float f32v2_t __attribute__((ext_vector_type(2)));
__device__ __forceinline__ unsigned cvt_pk_bf16(float lo, float hi) { const f32v2_t v = {lo, hi}; const bf16v2_t r = __builtin_convertvector(v, bf16v2_t); return __builtin_bit_cast(unsigned, r); }
template <class Epi, class Sched>
__device__ __forceinline__ void gemm_phase(PG8_LAS unsigned char* lds, const Gemm g, const Sched& S, const Epi& E, const int tid) {
    const int wid = __builtin_amdgcn_readfirstlane(tid >> 6), lane = tid & 63, wr = wid >> 2, wc = wid & 3, fr = lane & 15, fq = lane >> 4;
    const int K = g.K, nt = K / BK;
    unsigned voffA[2], voffB[2];
#pragma unroll
    for (int i = 0; i < 2; ++i) { int R, C; stage_rc(tid * 16 + i * 8192, R, C); const int Rb = Epi::PERM ? ((R & ~31) + perm32(R & 31)) : R;
        voffA[i] = (unsigned)(R * K + C) * 2u; voffB[i] = (unsigned)(Rb * K + C) * 2u; }
    const size_t kstep = (size_t)(BK * 2);
    const size_t hstep = (size_t)HALF * K * 2;
    const size_t tstep = 2 * hstep;
    const unsigned ldsw = (unsigned)wid * 1024u;
    const int aoff = lds_byte(wr * 64 + fr, fq * 8), boff = lds_byte(wc * 32 + fr, fq * 8);
#define PG8_SA(b, h) (((b) * 2 + (h)) * HTB)
#define PG8_SB(b, h) ((4 + (b) * 2 + (h)) * HTB)
#define PG8_STAGE(bufoff, gbase, voff) do { _Pragma("unroll") for (int _i = 0; _i < 2; ++_i) \
        __builtin_amdgcn_global_load_lds((const unsigned*)((const char*)(gbase) + (voff)[_i]), (PG8_LAS unsigned*)(lds + (bufoff) + ldsw + _i * 8192), 16, 0, 0); } while (0)
#define PG8_LDA(dst, b, h) do { _Pragma("unroll") for (int m = 0; m < 4; ++m) _Pragma("unroll") for (int k = 0; k < 2; ++k) dst[m][k] = *(const PG8_LAS bf16x8*)(lds + PG8_SA(b, h) + aoff + m * 2048 + k * 1024); } while (0)
#define PG8_LDB(dst, b, h) do { _Pragma("unroll") for (int n = 0; n < 2; ++n) _Pragma("unroll") for (int k = 0; k < 2; ++k) dst[n][k] = *(const PG8_LAS bf16x8*)(lds + PG8_SB(b, h) + boff + n * 2048 + k * 1024); } while (0)
#define PG8_MMA(ai, bj, At, Bt) do { __builtin_amdgcn_s_setprio(1); _Pragma("unroll") for (int m = 0; m < 4; ++m) _Pragma("unroll") for (int n = 0; n < 2; ++n) _Pragma("unroll") for (int k = 0; k < 2; ++k) \
        acc[ai][bj][m][n] = __builtin_amdgcn_mfma_f32_16x16x32_bf16(Bt[n][k], At[m][k], acc[ai][bj][m][n], 0, 0, 0); __builtin_amdgcn_s_setprio(0); } while (0)
#define PG8_WAIT_V(n) asm volatile("s_waitcnt vmcnt(" #n ")" ::: "memory")
#define PG8_WAIT_L(n) asm volatile("s_waitcnt lgkmcnt(" #n ")" ::: "memory")
#define PG8_BAR __builtin_amdgcn_s_barrier()
#define PG8_SCHED __builtin_amdgcn_sched_barrier(0)
    Unit cur, nxt; int ui = 0;
    if (!S.next(0, cur)) return;
    f32x4 acc[2][2][4][2];
#pragma unroll
    for (int a = 0; a < 2; ++a)
#pragma unroll
        for (int b = 0; b < 2; ++b)
#pragma unroll
            for (int m = 0; m < 4; ++m)
#pragma unroll
                for (int n = 0; n < 2; ++n) acc[a][b][m][n] = (f32x4){0.f, 0.f, 0.f, 0.f};
    bf16x8 At[4][2], B0[2][2], B1[2][2];
    const char* cA = (const char*)g.A + (size_t)cur.pm * tstep; const char* cB = (const char*)g.Bt + (size_t)cur.pn * tstep;
    S.a_ready(cur);
    PG8_STAGE(PG8_SB(0, 0), cB, voffB); PG8_STAGE(PG8_SA(0, 0), cA, voffA); PG8_STAGE(PG8_SB(0, 1), cB + hstep, voffB); PG8_STAGE(PG8_SA(0, 1), cA + hstep, voffA);
    if (wr == 1) PG8_BAR;
    PG8_WAIT_V(4); PG8_BAR;
    PG8_STAGE(PG8_SB(1, 0), cB + kstep, voffB); PG8_STAGE(PG8_SA(1, 0), cA + kstep, voffA); PG8_STAGE(PG8_SB(1, 1), cB + hstep + kstep, voffB);
    PG8_WAIT_V(6); PG8_BAR;
    for (;;) {
        const bool has_next = S.next(ui + 1, nxt);
        const char* nA = has_next ? (const char*)g.A + (size_t)nxt.pm * tstep : cA; const char* nB = has_next ? (const char*)g.Bt + (size_t)nxt.pn * tstep : cB;
        for (int t = 0; t < nt; t += 2) {
            const bool last = (t == nt - 2);
            const char* a1 = cA + (size_t)(t + 1) * kstep;
            const char* a2 = last ? nA : cA + (size_t)(t + 2) * kstep; const char* b2 = last ? nB : cB + (size_t)(t + 2) * kstep;
            const char* a3 = a2 + kstep; const char* b3 = b2 + kstep;
            if (last && has_next) S.a_ready(nxt);
            PG8_LDB(B0, 0, 0); PG8_SCHED; PG8_LDA(At, 0, 0); PG8_STAGE(PG8_SA(1, 1), a1 + hstep, voffA);
            PG8_WAIT_L(8); PG8_BAR; PG8_WAIT_L(0); PG8_MMA(0, 0, At, B0); PG8_BAR; PG8_SCHED;
            PG8_LDB(B1, 0, 1); PG8_STAGE(PG8_SB(0, 0), b2, voffB);
            PG8_BAR; PG8_WAIT_L(0); PG8_MMA(0, 1, At, B1); PG8_BAR;
            PG8_LDA(At, 0, 1); PG8_STAGE(PG8_SA(0, 0), a2, voffA);
            PG8_BAR; PG8_WAIT_L(0); PG8_MMA(1, 0, At, B0); PG8_BAR; PG8_SCHED;
            PG8_STAGE(PG8_SB(0, 1), b2 + hstep, voffB);
            PG8_WAIT_V(6); PG8_BAR; PG8_MMA(1, 1, At, B1); PG8_BAR;
            PG8_LDB(B0, 1, 0); PG8_SCHED; PG8_LDA(At, 1, 0); PG8_STAGE(PG8_SA(0, 1), a2 + hstep, voffA);
            PG8_WAIT_L(8); PG8_BAR; PG8_WAIT_L(0); PG8_MMA(0, 0, At, B0); PG8_BAR; PG8_SCHED;
            PG8_LDB(B1, 1, 1); PG8_STAGE(PG8_SB(1, 0), b3, voffB);
            PG8_BAR; PG8_WAIT_L(0); PG8_MMA(0, 1, At, B1); PG8_BAR;
            PG8_LDA(At, 1, 1); PG8_STAGE(PG8_SA(1, 0), a3, voffA);
            PG8_BAR; PG8_WAIT_L(0); PG8_MMA(1, 0, At, B0); PG8_BAR; PG8_SCHED;
            PG8_STAGE(PG8_SB(1, 1), b3 + hstep, voffB);
            PG8_WAIT_V(6); PG8_BAR; PG8_MMA(1, 1, At, B1); PG8_BAR;
        }
        if constexpr (!Epi::AFTER_DRAIN) { E(acc, cur, wr, wc, fr, fq); S.done(cur); }
        if (!has_next) break;
#pragma unroll
        for (int a = 0; a < 2; ++a)
#pragma unroll
            for (int b = 0; b < 2; ++b)
#pragma unroll
                for (int m = 0; m < 4; ++m)
#pragma unroll
                    for (int n = 0; n < 2; ++n) acc[a][b][m][n] = (f32x4){0.f, 0.f, 0.f, 0.f};
        cur = nxt; cA = nA; cB = nB; ++ui;
    }
    PG8_WAIT_V(0);
    if (wr == 0) PG8_BAR;
    PG8_BAR;
    if constexpr (Epi::AFTER_DRAIN) { E.fused(acc, cur, wr, wc, fr, fq, lds, wid, lane); S.done(cur); }
#undef PG8_SA
#undef PG8_SB
#undef PG8_STAGE
#undef PG8_LDA
#undef PG8_LDB
#undef PG8_MMA
#undef PG8_WAIT_V
#undef PG8_WAIT_L
#undef PG8_BAR
#undef PG8_SCHED
}
}

#define LAS __attribute__((address_space(3)))
typedef unsigned short u16;
typedef short bf16x8 __attribute__((ext_vector_type(8)));
typedef short s16x4 __attribute__((ext_vector_type(4)));
typedef float f32x4 __attribute__((ext_vector_type(4)));
typedef unsigned u32x4 __attribute__((ext_vector_type(4)));
typedef unsigned u32x2 __attribute__((ext_vector_type(2)));
using pg8::cvt_pk_bf16;

constexpr int S_ = 16384, DM = 1024, BW = 512, HD = 128, NCH = 256, DIN = 14344;
constexpr int NPROJ = 9216, NWIN = 14336;
constexpr float EPS = 1e-6f;
constexpr float QSCALE = 0.08838834764831845f;
constexpr int LDS_BYTES = 131072;

constexpr size_t OFF_WIN = 0;
constexpr size_t SZ_WIN = (size_t)NWIN * 1024 * 2;
constexpr size_t OFF_WUP = OFF_WIN + SZ_WIN;
constexpr size_t SZ_WUP = 5ull * 1024 * 512 * 2;
constexpr size_t OFF_WOUT = OFF_WUP + SZ_WUP;
constexpr size_t SZ_WSQ = 1024ull * 1024 * 2;
constexpr size_t OFF_WMKV = OFF_WOUT + SZ_WSQ;
constexpr size_t OFF_H = OFF_WMKV + SZ_WSQ;
constexpr size_t SZ_H = (size_t)S_ * 1024 * 2;
constexpr size_t OFF_MEMH = OFF_H + SZ_H;
constexpr size_t OFF_MKV = OFF_MEMH + 256 * 1024 * 2;
constexpr size_t OFF_IF = OFF_MKV + 256 * 1024 * 2;
constexpr size_t OFF_SC = OFF_IF + (size_t)S_ * 8 * 4;
constexpr size_t OFF_NST = OFF_SC + 3 * 4 * 256 * 4;
constexpr size_t OFF_PROJ = OFF_NST + 4 * 256 * 128 * 4;
constexpr size_t SZ_T = (size_t)S_ * 512 * 2;
constexpr size_t OFF_KV = OFF_PROJ + 18 * SZ_T;
constexpr size_t SZ_KV = 2ull * 4 * 256 * 128 * 128 * 2;
constexpr size_t WS_END = OFF_KV + SZ_KV;
constexpr size_t OFF_MERGED = OFF_PROJ + 0 * SZ_T;
constexpr size_t OFF_MSCR = OFF_PROJ + 4 * SZ_T;
constexpr size_t OFF_GSCR = OFF_PROJ + 9 * SZ_T;
constexpr size_t OFF_OUTF = OFF_KV;
static_assert(OFF_PROJ % 256 == 0 && OFF_KV % 256 == 0, "align");

enum { T_SBQ = 0, T_SBK, T_SBV, T_SBZ, T_MLQ, T_MLK, T_MLV, T_MLO, T_MLZ, T_GMU, T_GMV, T_GMZ, T_RTQ, T_RTK, T_RTV, T_RTZ, T_XAQ, T_XAZ };

__device__ const float INVF[64] = {
1.000000000e+00f, 8.659643531e-01f, 7.498942614e-01f, 6.493816376e-01f, 5.623413324e-01f, 4.869675338e-01f, 4.216965139e-01f, 3.651741147e-01f, 3.162277639e-01f, 2.738419771e-01f, 2.371373773e-01f, 2.053525001e-01f, 1.778279394e-01f, 1.539926529e-01f, 1.333521307e-01f, 1.154782027e-01f, 1.000000015e-01f, 8.659642935e-02f, 7.498941571e-02f, 6.493816525e-02f, 5.623413250e-02f, 4.869675264e-02f, 4.216965288e-02f, 3.651741147e-02f, 3.162277490e-02f, 2.738419734e-02f, 2.371373773e-02f, 2.053525113e-02f, 1.778279431e-02f, 1.539926510e-02f, 1.333521493e-02f, 1.154782064e-02f, 9.999999776e-03f, 8.659643121e-03f, 7.498941850e-03f, 6.493816152e-03f, 5.623413250e-03f, 4.869675264e-03f, 4.216964822e-03f, 3.651741194e-03f, 3.162277630e-03f, 2.738419687e-03f, 2.371373586e-03f, 2.053524833e-03f, 1.778279431e-03f, 1.539926510e-03f, 1.333521446e-03f, 1.154781901e-03f, 1.000000047e-03f, 8.659643354e-04f, 7.498942432e-04f, 6.493816618e-04f, 5.623413017e-04f, 4.869675322e-04f, 4.216965172e-04f, 3.651741426e-04f, 3.162277571e-04f, 2.738419571e-04f, 2.371373703e-04f, 2.053525095e-04f, 1.778279402e-04f, 1.539926452e-04f, 1.333521504e-04f, 1.154782003e-04f };
__device__ __forceinline__ float log_gamma(int h) { return h == 0 ? -3.174869716e-02f : h == 1 ? -1.574835740e-02f : h == 2 ? -7.843177766e-03f : -3.913899418e-03f; }

struct Params { const void* in[18]; float* out; unsigned char* ws; int ph_lo, ph_hi; };

__device__ __forceinline__ float bf_lo(unsigned w) { return __uint_as_float(w << 16); }
__device__ __forceinline__ float bf_hi(unsigned w) { return __uint_as_float(w & 0xffff0000u); }
__device__ __forceinline__ float bf2f(u16 b) { return __uint_as_float(((unsigned)b) << 16); }
__device__ __forceinline__ float fexp(float x) { return __expf(x); }
__device__ __forceinline__ float sigmoidf_(float x) { return 1.0f / (1.0f + __expf(-x)); }
__device__ __forceinline__ float siluf_(float x) { return x / (1.0f + __expf(-x)); }
__device__ __forceinline__ float softplusf_(float z) { return fmaxf(z, 0.f) + __logf(1.0f + __expf(-fabsf(z))); }
__device__ __forceinline__ float wave_sum(float v) {
#pragma unroll
    for (int o = 1; o < 64; o <<= 1) v += __shfl_xor(v, o);
    return v;
}
#define LDS_WAIT() asm volatile("s_waitcnt lgkmcnt(0)" ::: "memory")
#define MFMA16(a, b, c) __builtin_amdgcn_mfma_f32_16x16x32_bf16((a), (b), (c), 0, 0, 0)
__device__ __forceinline__ bf16x8 lfrag(const LAS u16* base, int row, int ld, int kofs) { return *(const LAS bf16x8*)(base + row * ld + kofs); }
__device__ __forceinline__ bf16x8 lfrag_slot(const LAS u16* base, int row, int ld, int kb, int quad) {
    const s16x4 lo = *(const LAS s16x4*)(base + row * ld + kb + quad * 4);
    const s16x4 hi = *(const LAS s16x4*)(base + row * ld + kb + 16 + quad * 4);
    bf16x8 r; r[0] = lo[0]; r[1] = lo[1]; r[2] = lo[2]; r[3] = lo[3]; r[4] = hi[0]; r[5] = hi[1]; r[6] = hi[2]; r[7] = hi[3]; return r;
}
__device__ __forceinline__ bf16x8 pack_p(const f32x4 a, const f32x4 b) {
    u32x4 w; w.x = cvt_pk_bf16(a[0], a[1]); w.y = cvt_pk_bf16(a[2], a[3]); w.z = cvt_pk_bf16(b[0], b[1]); w.w = cvt_pk_bf16(b[2], b[3]);
    return __builtin_bit_cast(bf16x8, w);
}
__device__ __forceinline__ float bfe(const u32x4 v, int e) { const unsigned w = v[e >> 1]; return (e & 1) ? bf_hi(w) : bf_lo(w); }
__device__ __forceinline__ void st_tr8(LAS u16* XT, int ld, int c0, int row, const float (&val)[8]) {
#pragma unroll
    for (int e = 0; e < 8; e += 2) { const unsigned w = cvt_pk_bf16(val[e], val[e + 1]); XT[(c0 + e) * ld + row] = (u16)(w & 0xffffu); XT[(c0 + e + 1) * ld + row] = (u16)(w >> 16); }
}
__device__ __forceinline__ void st_tr8_raw(LAS u16* XT, int ld, int c0, int row, const u32x4 v) {
#pragma unroll
    for (int e = 0; e < 4; ++e) { XT[(c0 + 2 * e) * ld + row] = (u16)(v[e] & 0xffffu); XT[(c0 + 2 * e + 1) * ld + row] = (u16)(v[e] >> 16); }
}

__device__ __forceinline__ float act_apply(float v, int mode) {
    if (mode == 0) return v;
    if (mode == 1) return v * QSCALE;
    if (mode == 2) return siluf_(v);
    if (mode == 3) return sigmoidf_(v);
    const float y = 1.5957691216057308f * (v + 0.044715f * v * v * v);
    return v * sigmoidf_(y);
}
struct EpiProj {
    static constexpr bool PERM = true, AFTER_DRAIN = false;
    u16* base; u16* mkv;
    __device__ __forceinline__ void operator()(const f32x4 (&acc)[2][2][4][2], const pg8::Unit& u, int wr, int wc, int fr, int fq) const {
        int mode = 0; u16* b = mkv; int colt = (u.pn - 70) * 256; int ldc = 1024; int pm = 0;
        if (u.pm < 64) {
            const int t = u.pn >> 1; colt = (u.pn & 1) * 256; b = base + (size_t)t * ((size_t)S_ * 512); ldc = 512; pm = u.pm;
            mode = (t == T_SBQ || t == T_XAQ) ? 1 : (t == T_SBZ || t == T_MLZ || t == T_GMZ || t == T_RTZ || t == T_XAZ) ? 2 : (t == T_MLO) ? 3 : (t == T_GMU || t == T_GMV) ? 4 : 0;
        }
        const int row0 = pm * 256 + wr * 64 + fr, col0 = colt + wc * 32 + 8 * fq;
#pragma unroll
        for (int ai = 0; ai < 2; ++ai)
#pragma unroll
            for (int m = 0; m < 4; ++m) { u16* rowp = b + (size_t)(row0 + ai * 128 + m * 16) * ldc + col0;
#pragma unroll
                for (int bj = 0; bj < 2; ++bj) { const f32x4 v0 = acc[ai][bj][m][0], v1 = acc[ai][bj][m][1];
                    u32x4 w; w.x = cvt_pk_bf16(act_apply(v0[0], mode), act_apply(v0[1], mode)); w.y = cvt_pk_bf16(act_apply(v0[2], mode), act_apply(v0[3], mode));
                    w.z = cvt_pk_bf16(act_apply(v1[0], mode), act_apply(v1[1], mode)); w.w = cvt_pk_bf16(act_apply(v1[2], mode), act_apply(v1[3], mode));
                    *(u32x4*)(rowp + bj * 128) = w; __builtin_amdgcn_sched_barrier(0); } }
    }
};
struct EpiGate {
    static constexpr bool PERM = true, AFTER_DRAIN = false;
    unsigned char* gsb; unsigned toff_;
    __device__ __forceinline__ void operator()(const f32x4 (&acc)[2][2][4][2], const pg8::Unit& u, int wr, int wc, int fr, int fq) const {
        unsigned toff = toff_; asm volatile("" : "+v"(toff));
#pragma unroll
        for (int ai = 0; ai < 2; ++ai)
#pragma unroll
            for (int m = 0; m < 4; ++m)
#pragma unroll
                for (int bj = 0; bj < 2; ++bj) { const int r = (ai * 4 + m) * 2 + bj; const f32x4 v0 = acc[ai][bj][m][0], v1 = acc[ai][bj][m][1];
                    u32x4 w; w.x = cvt_pk_bf16(sigmoidf_(v0[0]), sigmoidf_(v0[1])); w.y = cvt_pk_bf16(sigmoidf_(v0[2]), sigmoidf_(v0[3]));
                    w.z = cvt_pk_bf16(sigmoidf_(v1[0]), sigmoidf_(v1[1])); w.w = cvt_pk_bf16(sigmoidf_(v1[2]), sigmoidf_(v1[3]));
                    *(u32x4*)(gsb + (size_t)r * 8192 + toff) = w; }
    }
};
struct EpiUp {
    static constexpr bool PERM = true, AFTER_DRAIN = false;
    const unsigned char* gsb; unsigned char* msb; unsigned toff_; u16* merged; int nb;
    __device__ __forceinline__ void operator()(const f32x4 (&acc)[2][2][4][2], const pg8::Unit& u, int wr, int wc, int fr, int fq) const {
        unsigned toff = toff_; asm volatile("" : "+v"(toff));
        const int row0 = u.pm * 256 + wr * 64 + fr, col0 = u.pn * 256 + wc * 32 + 8 * fq;
#pragma unroll
        for (int ai = 0; ai < 2; ++ai)
#pragma unroll
            for (int m = 0; m < 4; ++m) {
#pragma unroll
                for (int bj = 0; bj < 2; ++bj) { const int r = (ai * 4 + m) * 2 + bj; const f32x4 v0 = acc[ai][bj][m][0], v1 = acc[ai][bj][m][1];
                    const u32x4 g = *(const u32x4*)(gsb + (size_t)r * 8192 + toff);
                    f32x4 o0, o1;
                    o0[0] = bf_lo(g.x) * v0[0]; o0[1] = bf_hi(g.x) * v0[1]; o0[2] = bf_lo(g.y) * v0[2]; o0[3] = bf_hi(g.y) * v0[3];
                    o1[0] = bf_lo(g.z) * v1[0]; o1[1] = bf_hi(g.z) * v1[1]; o1[2] = bf_lo(g.w) * v1[2]; o1[3] = bf_hi(g.w) * v1[3];
                    f32x4* mp = (f32x4*)(msb + (size_t)r * 16384 + 2 * toff);
                    if (nb > 0) { o0 += mp[0]; o1 += mp[1]; }
                    if (nb < 4) { mp[0] = o0; mp[1] = o1; }
                    else { u32x4 w; w.x = cvt_pk_bf16(o0[0], o0[1]); w.y = cvt_pk_bf16(o0[2], o0[3]); w.z = cvt_pk_bf16(o1[0], o1[1]); w.w = cvt_pk_bf16(o1[2], o1[3]);
                        *(u32x4*)(merged + (size_t)(row0 + ai * 128 + m * 16) * 1024 + col0 + bj * 128) = w; } }
                asm volatile("" ::: "memory"); }
    }
};
struct EpiF32 {
    static constexpr bool PERM = false, AFTER_DRAIN = false;
    float* C; int ldc;
    __device__ __forceinline__ void operator()(const f32x4 (&acc)[2][2][4][2], const pg8::Unit& u, int wr, int wc, int fr, int fq) const {
        const int row0 = u.pm * 256 + wr * 64 + fr, col0 = u.pn * 256 + wc * 32 + 4 * fq;
#pragma unroll
        for (int ai = 0; ai < 2; ++ai)
#pragma unroll
            for (int m = 0; m < 4; ++m) { float* rowp = C + (size_t)(row0 + ai * 128 + m * 16) * ldc + col0;
#pragma unroll
                for (int bj = 0; bj < 2; ++bj)
#pragma unroll
                    for (int n = 0; n < 2; ++n) *(f32x4*)(rowp + bj * 128 + n * 16) = acc[ai][bj][m][n]; }
    }
};
struct ProjOrder : pg8::StaticOrder {
    int nfull;
    __device__ __forceinline__ bool next(int i, pg8::Unit& u) const {
        if (i < nfull) return pg8::StaticOrder::next(i, u);
        if (i == nfull && c < 4) { u.pm = 64; u.pn = 70 + c; return true; }
        return false; }
};
struct OneUnit { int pm, pn, cnt;
    __device__ __forceinline__ bool next(int i, pg8::Unit& u) const { if (i >= cnt) return false; u.pm = pm; u.pn = pn; return true; }
    __device__ __forceinline__ void a_ready(const pg8::Unit&) const {}
    __device__ __forceinline__ void done(const pg8::Unit&) const {}
};

__device__ __forceinline__ void transpose_item(const float* W, int ldw, int c0, int k0, u16* WT, int K, int n0, LAS float* scr, int lane) {
#pragma unroll 8
    for (int i = 0; i < 32; ++i) { const int kk = 2 * i + (lane >> 5); scr[kk * 33 + (lane & 31)] = W[(size_t)(k0 + kk) * ldw + c0 + (lane & 31)]; }
    LDS_WAIT();
    const int c = lane & 7;
#pragma unroll
    for (int j = 0; j < 4; ++j) { const int n = (lane >> 3) + 8 * j; const LAS float* s = scr + (8 * c) * 33 + n;
        u32x4 o; o.x = cvt_pk_bf16(s[0 * 33], s[1 * 33]); o.y = cvt_pk_bf16(s[2 * 33], s[3 * 33]); o.z = cvt_pk_bf16(s[4 * 33], s[5 * 33]); o.w = cvt_pk_bf16(s[6 * 33], s[7 * 33]);
        *(u32x4*)(WT + (size_t)(n0 + n) * K + k0 + 8 * c) = o; }
    LDS_WAIT();
}
__device__ __forceinline__ void phase_prep(const Params& p, int l, LAS unsigned char* lds, const int tid, const int bid, const int nblk) {
    const int lane = tid & 63, wave = tid >> 6;
    unsigned char* ws = p.ws;
    const int gw = bid * 8 + wave, NGW = nblk * 8;
    if (l < 2) {
        LAS float* scr = (LAS float*)(lds + wave * 8448);
        const float* w_in = (const float*)p.in[5] + (size_t)l * 1024 * DIN;
        const float* w_mkv = (const float*)p.in[15] + (size_t)l * 1024 * 1024;
        const float* w_up = (const float*)p.in[16] + (size_t)l * 5 * 512 * 1024;
        const float* w_out = (const float*)p.in[17] + (size_t)l * 1024 * 1024;
        constexpr int I_IN = 16 * 448, I_UP = 5 * 256, I_SQ = 512;
        for (int it = gw; it < I_IN + I_UP + 2 * I_SQ; it += NGW) {
            int r = it;
            if (r < I_IN) { const int kb = r / 448, nb = r % 448, n0 = nb * 32; transpose_item(w_in, DIN, n0 + (n0 >= 4608 ? 8 : 0), kb * 64, (u16*)(ws + OFF_WIN), 1024, n0, scr, lane); continue; }
            r -= I_IN;
            if (r < I_UP) { const int n = r / 256, q = r % 256, kb = q / 32, nb = q % 32; transpose_item(w_up + (size_t)n * 512 * 1024, 1024, nb * 32, kb * 64, (u16*)(ws + OFF_WUP) + (size_t)n * 1024 * 512, 512, nb * 32, scr, lane); continue; }
            r -= I_UP;
            if (r < I_SQ) { const int kb = r / 32, nb = r % 32; transpose_item(w_out, 1024, nb * 32, kb * 64, (u16*)(ws + OFF_WOUT), 1024, nb * 32, scr, lane); continue; }
            r -= I_SQ;
            { const int kb = r / 32, nb = r % 32; transpose_item(w_mkv, 1024, nb * 32, kb * 64, (u16*)(ws + OFF_WMKV), 1024, nb * 32, scr, lane); }
        }
    }
    LAS float* w8 = (LAS float*)(lds + 73728);
    if (l < 2) {
        const float* w_in = (const float*)p.in[5] + (size_t)l * 1024 * DIN;
        for (int i = tid; i < 8192; i += 512) w8[i] = w_in[(size_t)(i >> 3) * DIN + 4608 + (i & 7)];
    }
    __syncthreads();
    const float* xin = (l <= 1) ? (const float*)p.in[0] : (const float*)p.out;
    const float* outf = (const float*)(ws + OFF_OUTF);
    const int nrows = S_ + (l < 2 ? 256 : 0);
    for (int row = gw; row < nrows; row += NGW) {
        if (row < S_) {
            f32x4 v[4];
            const f32x4* xr = (const f32x4*)(xin + (size_t)row * 1024) + lane;
#pragma unroll
            for (int j = 0; j < 4; ++j) v[j] = xr[64 * j];
            if (l > 0) {
                const f32x4* orow = (const f32x4*)(outf + (size_t)row * 1024) + lane; const f32x4* gp = (const f32x4*)((const float*)p.in[4] + (size_t)(l - 1) * 1024) + lane;
                f32x4 o[4]; float ss = 0.f;
#pragma unroll
                for (int j = 0; j < 4; ++j) { o[j] = orow[64 * j]; ss += (o[j][0] * o[j][0] + o[j][1] * o[j][1]) + (o[j][2] * o[j][2] + o[j][3] * o[j][3]); }
                const float rs = rsqrtf(wave_sum(ss) * (1.0f / 1024.0f) + EPS);
                f32x4* dst = (f32x4*)(p.out + (size_t)row * 1024) + lane;
#pragma unroll
                for (int j = 0; j < 4; ++j) { v[j] = v[j] + o[j] * rs * gp[64 * j]; dst[64 * j] = v[j]; }
            }
            if (l < 2) {
                float ss = 0.f;
#pragma unroll
                for (int j = 0; j < 4; ++j) ss += (v[j][0] * v[j][0] + v[j][1] * v[j][1]) + (v[j][2] * v[j][2] + v[j][3] * v[j][3]);
                const float rs = rsqrtf(wave_sum(ss) * (1.0f / 1024.0f) + EPS);
                const f32x4* gp = (const f32x4*)((const float*)p.in[3] + (size_t)l * 1024) + lane;
                u32x2* hrow = (u32x2*)((u16*)(ws + OFF_H) + (size_t)row * 1024) + lane;
                float g8[8];
#pragma unroll
                for (int q = 0; q < 8; ++q) g8[q] = 0.f;
#pragma unroll
                for (int j = 0; j < 4; ++j) { const f32x4 hv = v[j] * rs * gp[64 * j];
                    u32x2 w; w.x = cvt_pk_bf16(hv[0], hv[1]); w.y = cvt_pk_bf16(hv[2], hv[3]); hrow[64 * j] = w;
#pragma unroll
                    for (int i = 0; i < 4; ++i) { const int k = 4 * lane + 256 * j + i; const f32x4 wa = *(const LAS f32x4*)(w8 + k * 8), wb = *(const LAS f32x4*)(w8 + k * 8 + 4);
                        g8[0] += hv[i] * wa[0]; g8[1] += hv[i] * wa[1]; g8[2] += hv[i] * wa[2]; g8[3] += hv[i] * wa[3];
                        g8[4] += hv[i] * wb[0]; g8[5] += hv[i] * wb[1]; g8[6] += hv[i] * wb[2]; g8[7] += hv[i] * wb[3]; } }
#pragma unroll
                for (int q = 0; q < 8; ++q) g8[q] = wave_sum(g8[q]);
                if (lane < 8) { float val = g8[0];
#pragma unroll
                    for (int q = 1; q < 8; ++q) val = (lane == q) ? g8[q] : val;
                    const float bias = (lane < 4) ? ((const float*)p.in[6])[l * 4 + lane] : ((const float*)p.in[7])[l * 4 + lane - 4];
                    ((float*)(ws + OFF_IF))[(size_t)row * 8 + lane] = val + bias; }
            }
        } else {
            const int mr = row - S_;
            const f32x4* xr = (const f32x4*)((const float*)p.in[1] + (size_t)mr * 1024) + lane; const f32x4* gp = (const f32x4*)((const float*)p.in[14] + (size_t)l * 1024) + lane;
            f32x4 v[4]; float ss = 0.f;
#pragma unroll
            for (int j = 0; j < 4; ++j) { v[j] = xr[64 * j]; ss += (v[j][0] * v[j][0] + v[j][1] * v[j][1]) + (v[j][2] * v[j][2] + v[j][3] * v[j][3]); }
            const float rs = rsqrtf(wave_sum(ss) * (1.0f / 1024.0f) + EPS);
            u32x2* hrow = (u32x2*)((u16*)(ws + OFF_MEMH) + (size_t)mr * 1024) + lane;
#pragma unroll
            for (int j = 0; j < 4; ++j) { const f32x4 hv = v[j] * rs * gp[64 * j]; u32x2 w; w.x = cvt_pk_bf16(hv[0], hv[1]); w.y = cvt_pk_bf16(hv[2], hv[3]); hrow[64 * j] = w; }
        }
    }
}

__device__ __forceinline__ void sb_item(const u16* Q, const u16* Kg, const u16* Vg, u16* ZY, int qb, int h, LAS unsigned char* lds, const int tid) {
    const int lane = tid & 63, w = tid >> 6, fr = lane & 15, quad = lane >> 4;
    LAS u16* Qs = (LAS u16*)lds;
    LAS u16* Ks = Qs + 128 * 136;
    LAS u16* VT = Ks + 64 * 136;
    LAS int* flg = (LAS int*)(VT + 128 * 72);
    const int q0 = qb * 128;
    __syncthreads();
#pragma unroll
    for (int i = 0; i < 4; ++i) { const int ch = tid + i * 512, r = ch >> 4, c = ch & 15;
        *(LAS u32x4*)(Qs + r * 136 + c * 8) = *(const u32x4*)(Q + (size_t)(q0 + r) * 512 + h * 128 + c * 8); }
    if (tid < 8) flg[tid] = 0;
    f32x4 o[8];
#pragma unroll
    for (int i = 0; i < 8; ++i) o[i] = (f32x4){0.f, 0.f, 0.f, 0.f};
    float carry = 0.f;
    const int tq = q0 + w * 16 + fr;
    for (int kt = 2 * qb + 1; kt >= 0; --kt) {
        __syncthreads();
        int nd = 0;
#pragma unroll
        for (int i = 0; i < 8; ++i) nd += flg[i];
        if (nd == 8) break;
#pragma unroll
        for (int i = 0; i < 2; ++i) { const int ch = tid + i * 512, r = ch >> 4, c = ch & 15; const size_t go = (size_t)(kt * 64 + r) * 512 + h * 128 + c * 8;
            *(LAS u32x4*)(Ks + r * 136 + c * 8) = *(const u32x4*)(Kg + go);
            st_tr8_raw(VT, 72, c * 8, r, *(const u32x4*)(Vg + go)); }
        __syncthreads();
        f32x4 st[4];
#pragma unroll
        for (int i = 0; i < 4; ++i) st[i] = (f32x4){0.f, 0.f, 0.f, 0.f};
#pragma unroll
        for (int ks = 0; ks < 4; ++ks) { const bf16x8 qf = lfrag(Qs, w * 16 + fr, 136, ks * 32 + quad * 8);
#pragma unroll
            for (int mt = 0; mt < 4; ++mt) st[mt] = MFMA16(lfrag(Ks, mt * 16 + fr, 136, ks * 32 + quad * 8), qf, st[mt]); }
        f32x4 lk[4]; float tot[4], qsuf[4];
#pragma unroll
        for (int mt = 0; mt < 4; ++mt) { float gs = 0.f;
#pragma unroll
            for (int j = 0; j < 4; ++j) { const int key = kt * 64 + mt * 16 + quad * 4 + j; const float z = st[mt][j]; const float sp = softplusf_(z);
                const bool valid = key < tq; lk[mt][j] = valid ? -sp : 0.f; st[mt][j] = valid ? (z - sp) : -1e30f; gs += lk[mt][j]; }
            const float g1 = __shfl(gs, ((quad + 1) & 3) * 16 + fr), g2 = __shfl(gs, ((quad + 2) & 3) * 16 + fr), g3 = __shfl(gs, ((quad + 3) & 3) * 16 + fr);
            tot[mt] = gs + g1 + g2 + g3;
            qsuf[mt] = (quad < 3 ? g1 : 0.f) + (quad < 2 ? g2 : 0.f) + (quad < 1 ? g3 : 0.f); }
        float run = carry;
#pragma unroll
        for (int mt = 3; mt >= 0; --mt) { const float b3 = run + qsuf[mt], b2 = b3 + lk[mt][3], b1 = b2 + lk[mt][2], b0 = b1 + lk[mt][1];
            st[mt][3] = fexp(st[mt][3] + b3); st[mt][2] = fexp(st[mt][2] + b2); st[mt][1] = fexp(st[mt][1] + b1); st[mt][0] = fexp(st[mt][0] + b0);
            run += tot[mt]; }
        carry = run;
#pragma unroll
        for (int k2 = 0; k2 < 2; ++k2) { const bf16x8 pf = pack_p(st[2 * k2], st[2 * k2 + 1]);
#pragma unroll
            for (int mt = 0; mt < 8; ++mt) o[mt] = MFMA16(lfrag_slot(VT, mt * 16 + fr, 72, k2 * 32, quad), pf, o[mt]); }
        const int wd = __all(carry < -104.0f);
        if (lane == 0) flg[w] = wd ? 1 : 0;
    }
    u16* zr = ZY + (size_t)tq * 512 + h * 128 + quad * 4;
#pragma unroll
    for (int mt = 0; mt < 8; ++mt) { const u32x2 z = *(const u32x2*)(zr + mt * 16);
        u32x2 r; r.x = cvt_pk_bf16(o[mt][0] * bf_lo(z.x), o[mt][1] * bf_hi(z.x)); r.y = cvt_pk_bf16(o[mt][2] * bf_lo(z.y), o[mt][3] * bf_hi(z.y));
        *(u32x2*)(zr + mt * 16) = r; }
}

__device__ __forceinline__ void ml_chunk_gates(const float* IFg, int c, int h, int lane, float& bcum, float& ic, float& g) {
    const int t = c * 64 + lane;
    ic = IFg[(size_t)t * 8 + h]; const float fp = IFg[(size_t)t * 8 + 4 + h];
    float b = fminf(fp, 0.f) - __logf(1.0f + __expf(-fabsf(fp)));
#pragma unroll
    for (int o = 1; o < 64; o <<= 1) { const float n = __shfl_up(b, o); if (lane >= o) b += n; }
    float x = ic - b;
#pragma unroll
    for (int o = 1; o < 64; o <<= 1) { const float n = __shfl_up(x, o); if (lane >= o) x = fmaxf(x, n); }
    bcum = b; g = b + x;
}
__device__ __forceinline__ void rot_cs(int pos, int i, float& cs, float& sn) {
    const float ang = (float)pos * INVF[i];
    double rev = (double)ang * 0.15915494309189535; rev -= floor(rev);
    const float fr = (float)rev;
    sn = __builtin_amdgcn_sinf(fr); cs = __builtin_amdgcn_cosf(fr);
}
template <bool RT, bool TRANSPOSED>
__device__ __forceinline__ void stage_qk(const u16* X, const float* convw, const int* pos, int c, int h, float scale, const LAS float* scale_row, LAS u16* dst, const int tid) {
    if (!RT) {
#pragma unroll
        for (int i = 0; i < 2; ++i) { const int ch = tid + i * 512, l = ch >> 4, d0 = (ch & 15) * 8;
            float a[8];
#pragma unroll
            for (int e = 0; e < 8; ++e) a[e] = 0.f;
#pragma unroll
            for (int j = 0; j < 4; ++j) { const int tt = c * 64 + l - 3 + j;
                if (tt >= 0) { const u32x4 v = *(const u32x4*)(X + (size_t)tt * 512 + h * 128 + d0); const f32x4 w0 = *(const f32x4*)(convw + j * 512 + h * 128 + d0), w1 = *(const f32x4*)(convw + j * 512 + h * 128 + d0 + 4);
#pragma unroll
                    for (int e = 0; e < 4; ++e) { a[e] += w0[e] * bfe(v, e); a[4 + e] += w1[e] * bfe(v, 4 + e); } } }
            const float sr = scale * (scale_row ? scale_row[l] : 1.0f);
#pragma unroll
            for (int e = 0; e < 8; ++e) a[e] = siluf_(a[e]) * sr;
            if (TRANSPOSED) st_tr8(dst, 72, d0, l, a);
            else { u32x4 o; o.x = cvt_pk_bf16(a[0], a[1]); o.y = cvt_pk_bf16(a[2], a[3]); o.z = cvt_pk_bf16(a[4], a[5]); o.w = cvt_pk_bf16(a[6], a[7]); *(LAS u32x4*)(dst + l * 136 + d0) = o; } }
    } else {
        const int l = tid >> 3, d0 = (tid & 7) * 8; const int t = c * 64 + l; const int ps = pos[t];
        const u32x4 v1 = *(const u32x4*)(X + (size_t)t * 512 + h * 128 + d0), v2 = *(const u32x4*)(X + (size_t)t * 512 + h * 128 + 64 + d0);
        const float sr = scale * (scale_row ? scale_row[l] : 1.0f);
        float a[8], b[8];
#pragma unroll
        for (int e = 0; e < 8; ++e) { float cs, sn; rot_cs(ps, d0 + e, cs, sn); const float t1 = bfe(v1, e), t2 = bfe(v2, e); a[e] = (t1 * cs - t2 * sn) * sr; b[e] = (t1 * sn + t2 * cs) * sr; }
        if (TRANSPOSED) { st_tr8(dst, 72, d0, l, a); st_tr8(dst, 72, 64 + d0, l, b); }
        else { u32x4 o; o.x = cvt_pk_bf16(a[0], a[1]); o.y = cvt_pk_bf16(a[2], a[3]); o.z = cvt_pk_bf16(a[4], a[5]); o.w = cvt_pk_bf16(a[6], a[7]); *(LAS u32x4*)(dst + l * 136 + d0) = o;
               o.x = cvt_pk_bf16(b[0], b[1]); o.y = cvt_pk_bf16(b[2], b[3]); o.z = cvt_pk_bf16(b[4], b[5]); o.w = cvt_pk_bf16(b[6], b[7]); *(LAS u32x4*)(dst + l * 136 + 64 + d0) = o; }
    }
}
__device__ __forceinline__ void stage_vt(const u16* V, int c, int h, LAS u16* VT, const int tid) {
#pragma unroll
    for (int i = 0; i < 2; ++i) { const int ch = tid + i * 512, l = ch >> 4, d0 = (ch & 15) * 8;
        st_tr8_raw(VT, 72, d0, l, *(const u32x4*)(V + (size_t)(c * 64 + l) * 512 + h * 128 + d0)); }
}

template <bool RT>
__device__ __forceinline__ void kv1_item(const Params& p, int l, int c, int h, LAS unsigned char* lds, const int tid) {
    const int lane = tid & 63, w = tid >> 6, fr = lane & 15, quad = lane >> 4;
    unsigned char* ws = p.ws;
    LAS u16* KWT = (LAS u16*)lds;
    LAS u16* VT = KWT + 128 * 72;
    LAS float* wend = (LAS float*)(VT + 128 * 72);
    const u16* proj = (const u16*)(ws + OFF_PROJ);
    float* SC = (float*)(ws + OFF_SC);
    __syncthreads();
    if (!RT) { if (w == 0) { float bcum, ic, g; ml_chunk_gates((const float*)(ws + OFF_IF), c, h, lane, bcum, ic, g);
            const float bl = __shfl(bcum, 63), al = __shfl(g, 63);
            wend[lane] = fexp(bl - bcum + ic - al);
            if (lane == 0) { SC[h * 256 + c] = bl; SC[1024 + h * 256 + c] = al; } } }
    else { if (tid < 64) wend[tid] = fexp(log_gamma(h) * (float)(63 - tid)); }
    __syncthreads();
    if (!RT) stage_qk<false, true>(proj + (size_t)T_MLK * S_ * 512, (const float*)p.in[9] + (size_t)l * 2048, nullptr, c, h, QSCALE, wend, KWT, tid);
    else stage_qk<true, true>(proj + (size_t)T_RTK * S_ * 512, nullptr, (const int*)p.in[2], c, h, QSCALE, wend, KWT, tid);
    stage_vt(proj + (size_t)(RT ? T_RTV : T_MLV) * S_ * 512, c, h, VT, tid);
    __syncthreads();
    const int db = (w & 3) * 32, eh = (w >> 2) * 64;
    f32x4 acc[2][4];
#pragma unroll
    for (int a = 0; a < 2; ++a)
#pragma unroll
        for (int b = 0; b < 4; ++b) acc[a][b] = (f32x4){0.f, 0.f, 0.f, 0.f};
#pragma unroll
    for (int ks = 0; ks < 2; ++ks) { bf16x8 af[2], bfr[4];
#pragma unroll
        for (int a = 0; a < 2; ++a) af[a] = lfrag(KWT, db + a * 16 + fr, 72, ks * 32 + quad * 8);
#pragma unroll
        for (int b = 0; b < 4; ++b) bfr[b] = lfrag(VT, eh + b * 16 + fr, 72, ks * 32 + quad * 8);
#pragma unroll
        for (int a = 0; a < 2; ++a)
#pragma unroll
            for (int b = 0; b < 4; ++b) acc[a][b] = MFMA16(af[a], bfr[b], acc[a][b]); }
    u16* ST = (u16*)(ws + OFF_KV) + ((size_t)((RT ? 4 : 0) + h) * 256 + c) * 16384;
#pragma unroll
    for (int a = 0; a < 2; ++a)
#pragma unroll
        for (int b = 0; b < 4; ++b) { const int e = eh + b * 16 + fr, d = db + a * 16 + quad * 4;
            u32x2 r; r.x = cvt_pk_bf16(acc[a][b][0], acc[a][b][1]); r.y = cvt_pk_bf16(acc[a][b][2], acc[a][b][3]); *(u32x2*)(ST + e * 128 + d) = r; }
    if (!RT && tid < 128) { float s = 0.f;
#pragma unroll 8
        for (int i = 0; i < 64; ++i) s += bf2f(KWT[tid * 72 + i]);
        ((float*)(ws + OFF_NST))[((size_t)h * 256 + c) * 128 + tid] = s; }
}

__device__ __forceinline__ void scan_phase(const Params& p, const int tid, const int bid, const int nblk) {
    unsigned char* ws = p.ws;
    const float* SC = (const float*)(ws + OFF_SC);
    for (int it = bid; it < 129; it += nblk) {
        if (it < 128) {
            const int brh = it >> 4, part = it & 15, br = brh >> 2, h = brh & 3;
            unsigned* base = (unsigned*)(ws + OFF_KV) + (size_t)brh * 256 * 8192 + part * 512 + tid;
            float s0 = 0.f, s1 = 0.f, m = 0.f;
            const float cd = fexp(log_gamma(h) * 64.0f);
            for (int c0 = 0; c0 < 256; c0 += 8) {
                unsigned kv[8];
#pragma unroll
                for (int i = 0; i < 8; ++i) kv[i] = base[(size_t)(c0 + i) * 8192];
#pragma unroll
                for (int i = 0; i < 8; ++i) { const int c = c0 + i;
                    base[(size_t)c * 8192] = cvt_pk_bf16(s0, s1);
                    if (br == 0) { const float bl = SC[h * 256 + c], al = SC[1024 + h * 256 + c]; const float mn = fmaxf(bl + m, al);
                        const float dold = fexp(bl + m - mn), dloc = fexp(al - mn); s0 = dold * s0 + dloc * bf_lo(kv[i]); s1 = dold * s1 + dloc * bf_hi(kv[i]); m = mn; }
                    else { s0 = cd * s0 + bf_lo(kv[i]); s1 = cd * s1 + bf_hi(kv[i]); } }
            }
        } else {
            const int h = tid >> 7, d = tid & 127;
            float* NST = (float*)(ws + OFF_NST) + (size_t)h * 256 * 128 + d; float* MP = (float*)(ws + OFF_SC) + 2048 + h * 256;
            float n = 0.f, m = 0.f;
            for (int c = 0; c < 256; ++c) { const float bl = SC[h * 256 + c], al = SC[1024 + h * 256 + c]; const float nl = NST[c * 128];
                const float mn = fmaxf(bl + m, al); const float dold = fexp(bl + m - mn), dloc = fexp(al - mn);
                NST[c * 128] = n; if (d == 0) MP[c] = m;
                n = dold * n + dloc * nl; m = mn; }
        }
    }
}

template <bool RT>
__device__ __forceinline__ void out3_item(const Params& p, int l, int c, int h, LAS unsigned char* lds, const int tid) {
    const int lane = tid & 63, w = tid >> 6, fr = lane & 15, quad = lane >> 4;
    unsigned char* ws = p.ws;
    LAS u16* Qs = (LAS u16*)lds;
    LAS u16* Ks = Qs + 64 * 136;
    LAS u16* VT = Ks + 64 * 136;
    LAS u16* STs = VT + 128 * 72;
    LAS float* fs = (LAS float*)(STs + 128 * 136);
    LAS float* rowterm = fs;
    LAS float* colterm = fs + 64;
    LAS float* dinter = fs + 128;
    LAS float* emt = fs + 192;
    LAS float* nprev = fs + 256;
    LAS float* red = fs + 384;
    const u16* proj = (const u16*)(ws + OFF_PROJ);
    __syncthreads();
    if (!RT) {
        if (w == 0) { float bcum, ic, g; ml_chunk_gates((const float*)(ws + OFF_IF), c, h, lane, bcum, ic, g);
            const float mp = ((const float*)(ws + OFF_SC))[2048 + h * 256 + c];
            const float mt = fmaxf(bcum + mp, g);
            rowterm[lane] = bcum - mt; colterm[lane] = ic - bcum; dinter[lane] = fexp(bcum + mp - mt); emt[lane] = fexp(-mt); }
        if (tid >= 64 && tid < 192) nprev[tid - 64] = ((const float*)(ws + OFF_NST))[((size_t)h * 256 + c) * 128 + tid - 64];
        stage_qk<false, false>(proj + (size_t)T_MLQ * S_ * 512, (const float*)p.in[8] + (size_t)l * 2048, nullptr, c, h, 1.0f, nullptr, Qs, tid);
        stage_qk<false, false>(proj + (size_t)T_MLK * S_ * 512, (const float*)p.in[9] + (size_t)l * 2048, nullptr, c, h, QSCALE, nullptr, Ks, tid);
    } else {
        stage_qk<true, false>(proj + (size_t)T_RTQ * S_ * 512, nullptr, (const int*)p.in[2], c, h, 1.0f, nullptr, Qs, tid);
        stage_qk<true, false>(proj + (size_t)T_RTK * S_ * 512, nullptr, (const int*)p.in[2], c, h, QSCALE, nullptr, Ks, tid);
    }
    stage_vt(proj + (size_t)(RT ? T_RTV : T_MLV) * S_ * 512, c, h, VT, tid);
    { const u16* ST = (const u16*)(ws + OFF_KV) + ((size_t)((RT ? 4 : 0) + h) * 256 + c) * 16384;
#pragma unroll
      for (int i = 0; i < 4; ++i) { const int ch = tid + i * 512, e = ch >> 4, d0 = (ch & 15) * 8; *(LAS u32x4*)(STs + e * 136 + d0) = *(const u32x4*)(ST + e * 128 + d0); } }
    __syncthreads();
    const int tb = (w & 3) * 16, eh = (w >> 2) * 64;
    const int tl = tb + fr;
    f32x4 st[4];
#pragma unroll
    for (int i = 0; i < 4; ++i) st[i] = (f32x4){0.f, 0.f, 0.f, 0.f};
    f32x4 oe[4], oi[4];
#pragma unroll
    for (int i = 0; i < 4; ++i) { oe[i] = (f32x4){0.f, 0.f, 0.f, 0.f}; oi[i] = (f32x4){0.f, 0.f, 0.f, 0.f}; }
#pragma unroll
    for (int ks = 0; ks < 4; ++ks) { const bf16x8 qf = lfrag(Qs, tl, 136, ks * 32 + quad * 8);
#pragma unroll
        for (int mt = 0; mt < 4; ++mt) st[mt] = MFMA16(lfrag(Ks, mt * 16 + fr, 136, ks * 32 + quad * 8), qf, st[mt]);
#pragma unroll
        for (int mt = 0; mt < 4; ++mt) oe[mt] = MFMA16(lfrag(STs, eh + mt * 16 + fr, 136, ks * 32 + quad * 8), qf, oe[mt]); }
    float dsum = 0.f;
    const float lg = log_gamma(h);
    const float rt_ = RT ? 0.f : rowterm[tl];
#pragma unroll
    for (int mt = 0; mt < 4; ++mt)
#pragma unroll
        for (int j = 0; j < 4; ++j) { const int s = mt * 16 + quad * 4 + j; float dec;
            if (RT) dec = fexp(lg * fabsf((float)(tl - s)));
            else dec = (s <= tl) ? fexp(rt_ + colterm[s]) : 0.f;
            const float v = st[mt][j] * dec; st[mt][j] = v; dsum += v; }
#pragma unroll
    for (int k2 = 0; k2 < 2; ++k2) { const bf16x8 pf = pack_p(st[2 * k2], st[2 * k2 + 1]);
#pragma unroll
        for (int mt = 0; mt < 4; ++mt) oi[mt] = MFMA16(lfrag_slot(VT, eh + mt * 16 + fr, 72, k2 * 32, quad), pf, oi[mt]); }
    float cin, cden = 1.0f;
    if (!RT) {
        dsum += __shfl_xor(dsum, 16); dsum += __shfl_xor(dsum, 32);
        float qn = 0.f;
#pragma unroll 8
        for (int i = 0; i < 32; ++i) qn += bf2f(Qs[tl * 136 + quad * 32 + i]) * nprev[quad * 32 + i];
        qn += __shfl_xor(qn, 16); qn += __shfl_xor(qn, 32);
        cin = dinter[tl];
        const float den = cin * qn + dsum;
        cden = 1.0f / fmaxf(fabsf(den), emt[tl]);
    } else cin = fexp(lg * (float)(tl + 1));
    float s1 = 0.f, s2 = 0.f;
#pragma unroll
    for (int mt = 0; mt < 4; ++mt)
#pragma unroll
        for (int j = 0; j < 4; ++j) { const float v = (cin * oe[mt][j] + oi[mt][j]) * cden; oi[mt][j] = v; s1 += v; s2 += v * v; }
    s1 += __shfl_xor(s1, 16); s1 += __shfl_xor(s1, 32); s2 += __shfl_xor(s2, 16); s2 += __shfl_xor(s2, 32);
    if (quad == 0) { red[((w >> 2) * 64 + tl) * 2] = s1; red[((w >> 2) * 64 + tl) * 2 + 1] = s2; }
    __syncthreads();
    const float t1 = red[tl * 2] + red[(64 + tl) * 2], t2 = red[tl * 2 + 1] + red[(64 + tl) * 2 + 1];
    const float mu = t1 * (1.0f / 128.0f); const float var = fmaxf(t2 * (1.0f / 128.0f) - mu * mu, 0.f); const float rstd = rsqrtf(var + EPS);
    const size_t go = (size_t)(c * 64 + tl) * 512 + h * 128 + eh + quad * 4;
    u16* zr = (u16*)(ws + OFF_PROJ) + (size_t)(RT ? T_RTZ : T_MLZ) * S_ * 512 + go;
    const u16* orow = proj + (size_t)T_MLO * S_ * 512 + go;
#pragma unroll
    for (int mt = 0; mt < 4; ++mt) { const u32x2 z = *(const u32x2*)(zr + mt * 16);
        float g0 = bf_lo(z.x), g1 = bf_hi(z.x), g2 = bf_lo(z.y), g3 = bf_hi(z.y);
        if (!RT) { const u32x2 ov = *(const u32x2*)(orow + mt * 16); g0 *= bf_lo(ov.x); g1 *= bf_hi(ov.x); g2 *= bf_lo(ov.y); g3 *= bf_hi(ov.y); }
        u32x2 r; r.x = cvt_pk_bf16((oi[mt][0] - mu) * rstd * g0, (oi[mt][1] - mu) * rstd * g1); r.y = cvt_pk_bf16((oi[mt][2] - mu) * rstd * g2, (oi[mt][3] - mu) * rstd * g3);
        *(u32x2*)(zr + mt * 16) = r; }
}

__device__ __forceinline__ void gm_item(const Params& p, int l, int nb, int g, LAS unsigned char* lds, const int tid) {
    const int lane = tid & 63, w = tid >> 6, fr = lane & 15, quad = lane >> 4;
    unsigned char* ws = p.ws;
    LAS u16* Wm = (LAS u16*)lds;
    LAS u16* VNT = Wm + 128 * 136;
    LAS float* mu_s = (LAS float*)(VNT + 128 * 136);
    LAS float* rs_s = mu_s + 128;
    const u16* V = (const u16*)(ws + OFF_PROJ) + (size_t)T_GMV * S_ * 512 + (size_t)nb * 128 * 512;
    __syncthreads();
    { const int r = tid >> 2, part = tid & 3; float s1 = 0.f, s2 = 0.f;
#pragma unroll 4
      for (int i = 0; i < 16; ++i) { const u32x4 v = *(const u32x4*)(V + (size_t)r * 512 + part * 128 + i * 8);
#pragma unroll
          for (int e = 0; e < 8; ++e) { const float x = bfe(v, e); s1 += x; s2 += x * x; } }
      s1 += __shfl_xor(s1, 1); s1 += __shfl_xor(s1, 2); s2 += __shfl_xor(s2, 1); s2 += __shfl_xor(s2, 2);
      if (part == 0) { const float mu = s1 * (1.0f / 512.0f); const float var = fmaxf(s2 * (1.0f / 512.0f) - mu * mu, 0.f); mu_s[r] = mu; rs_s[r] = rsqrtf(var + EPS); } }
    { const float* wsrc = (const float*)p.in[12] + ((size_t)l * 4 + g) * 16384;
#pragma unroll
      for (int i = 0; i < 4; ++i) { const int ch = tid + i * 512, pr = ch >> 4, q0 = (ch & 15) * 8;
          f32x4 a = *(const f32x4*)(wsrc + pr * 128 + q0), b = *(const f32x4*)(wsrc + pr * 128 + q0 + 4);
          if (pr < 64 && q0 >= 64) { a = (f32x4){0.f, 0.f, 0.f, 0.f}; b = a; }
          u32x4 o; o.x = cvt_pk_bf16(a[0], a[1]); o.y = cvt_pk_bf16(a[2], a[3]); o.z = cvt_pk_bf16(b[0], b[1]); o.w = cvt_pk_bf16(b[2], b[3]);
          *(LAS u32x4*)(Wm + pr * 136 + q0) = o; } }
    __syncthreads();
    { const float* lng = (const float*)p.in[10] + l * 512 + g * 128; const float* lnb = (const float*)p.in[11] + l * 512 + g * 128;
#pragma unroll
      for (int i = 0; i < 4; ++i) { const int ch = tid + i * 512, q = ch >> 4, c0 = (ch & 15) * 8;
          const u32x4 v = *(const u32x4*)(V + (size_t)q * 512 + g * 128 + c0); const float mu = mu_s[q], rs = rs_s[q];
          float a[8];
#pragma unroll
          for (int e = 0; e < 8; ++e) a[e] = (bfe(v, e) - mu) * rs * lng[c0 + e] + lnb[c0 + e];
          st_tr8(VNT, 136, c0, q, a); } }
    __syncthreads();
    const int cb = (w & 3) * 32, ph = (w >> 2) * 64;
    f32x4 acc[2][4];
#pragma unroll
    for (int a = 0; a < 2; ++a)
#pragma unroll
        for (int b = 0; b < 4; ++b) acc[a][b] = (f32x4){0.f, 0.f, 0.f, 0.f};
#pragma unroll
    for (int ks = 0; ks < 4; ++ks) { bf16x8 af[2], bfr[4];
#pragma unroll
        for (int a = 0; a < 2; ++a) af[a] = lfrag(VNT, cb + a * 16 + fr, 136, ks * 32 + quad * 8);
#pragma unroll
        for (int b = 0; b < 4; ++b) bfr[b] = lfrag(Wm, ph + b * 16 + fr, 136, ks * 32 + quad * 8);
#pragma unroll
        for (int a = 0; a < 2; ++a)
#pragma unroll
            for (int b = 0; b < 4; ++b) acc[a][b] = MFMA16(af[a], bfr[b], acc[a][b]); }
    const float* bs = (const float*)p.in[13] + ((size_t)l * 4 + g) * 128;
#pragma unroll
    for (int b = 0; b < 4; ++b) { const int pl = ph + b * 16 + fr; const float bias = bs[pl];
#pragma unroll
        for (int a = 0; a < 2; ++a) { const size_t go = (size_t)(nb * 128 + pl) * 512 + g * 128 + cb + a * 16 + quad * 4;
            const u32x2 uv = *(const u32x2*)((const u16*)(ws + OFF_PROJ) + (size_t)T_GMU * S_ * 512 + go);
            u16* zr = (u16*)(ws + OFF_PROJ) + (size_t)T_GMZ * S_ * 512 + go; const u32x2 z = *(const u32x2*)zr;
            u32x2 r; r.x = cvt_pk_bf16(bf_lo(uv.x) * (acc[a][b][0] + bias) * bf_lo(z.x), bf_hi(uv.x) * (acc[a][b][1] + bias) * bf_hi(z.x));
            r.y = cvt_pk_bf16(bf_lo(uv.y) * (acc[a][b][2] + bias) * bf_lo(z.y), bf_hi(uv.y) * (acc[a][b][3] + bias) * bf_hi(z.y));
            *(u32x2*)zr = r; } }
}

__device__ __forceinline__ void xa_item(const Params& p, int rb, int h, LAS unsigned char* lds, const int tid) {
    const int lane = tid & 63, w = tid >> 6, fr = lane & 15, quad = lane >> 4;
    unsigned char* ws = p.ws;
    LAS u16* Qs = (LAS u16*)lds;
    LAS u16* KM = Qs + 128 * 136;
    LAS u16* VT = KM;
    const u16* Q = (const u16*)(ws + OFF_PROJ) + (size_t)T_XAQ * S_ * 512 + (size_t)rb * 128 * 512 + h * 128;
    const u16* MKV = (const u16*)(ws + OFF_MKV);
    __syncthreads();
#pragma unroll
    for (int i = 0; i < 4; ++i) { const int ch = tid + i * 512, r = ch >> 4, c = ch & 15; *(LAS u32x4*)(Qs + r * 136 + c * 8) = *(const u32x4*)(Q + (size_t)r * 512 + c * 8); }
#pragma unroll
    for (int i = 0; i < 8; ++i) { const int ch = tid + i * 512, r = ch >> 4, c = ch & 15; *(LAS u32x4*)(KM + r * 136 + c * 8) = *(const u32x4*)(MKV + (size_t)r * 1024 + h * 128 + c * 8); }
    __syncthreads();
    f32x4 st[16];
#pragma unroll
    for (int i = 0; i < 16; ++i) st[i] = (f32x4){0.f, 0.f, 0.f, 0.f};
#pragma unroll
    for (int ks = 0; ks < 4; ++ks) { const bf16x8 qf = lfrag(Qs, w * 16 + fr, 136, ks * 32 + quad * 8);
#pragma unroll
        for (int mt = 0; mt < 16; ++mt) st[mt] = MFMA16(lfrag(KM, mt * 16 + fr, 136, ks * 32 + quad * 8), qf, st[mt]); }
    float mx = -1e30f;
#pragma unroll
    for (int mt = 0; mt < 16; ++mt)
#pragma unroll
        for (int j = 0; j < 4; ++j) mx = fmaxf(mx, st[mt][j]);
    mx = fmaxf(mx, __shfl_xor(mx, 16)); mx = fmaxf(mx, __shfl_xor(mx, 32));
    float sum = 0.f;
#pragma unroll
    for (int mt = 0; mt < 16; ++mt)
#pragma unroll
        for (int j = 0; j < 4; ++j) { const float e = fexp(st[mt][j] - mx); st[mt][j] = e; sum += e; }
    sum += __shfl_xor(sum, 16); sum += __shfl_xor(sum, 32);
    __syncthreads();
#pragma unroll
    for (int i = 0; i < 8; ++i) { const int ch = tid + i * 512, r = ch >> 4, c = ch & 15; st_tr8_raw(VT, 264, c * 8, r, *(const u32x4*)(MKV + (size_t)r * 1024 + 512 + h * 128 + c * 8)); }
    __syncthreads();
    f32x4 o[8];
#pragma unroll
    for (int i = 0; i < 8; ++i) o[i] = (f32x4){0.f, 0.f, 0.f, 0.f};
#pragma unroll
    for (int k2 = 0; k2 < 8; ++k2) { const bf16x8 pf = pack_p(st[2 * k2], st[2 * k2 + 1]);
#pragma unroll
        for (int mt = 0; mt < 8; ++mt) o[mt] = MFMA16(lfrag_slot(VT, mt * 16 + fr, 264, k2 * 32, quad), pf, o[mt]); }
    const float inv = 1.0f / sum;
    u16* zr = (u16*)(ws + OFF_PROJ) + (size_t)T_XAZ * S_ * 512 + (size_t)(rb * 128 + w * 16 + fr) * 512 + h * 128 + quad * 4;
#pragma unroll
    for (int mt = 0; mt < 8; ++mt) { const u32x2 z = *(const u32x2*)(zr + mt * 16);
        u32x2 r; r.x = cvt_pk_bf16(o[mt][0] * inv * bf_lo(z.x), o[mt][1] * inv * bf_hi(z.x)); r.y = cvt_pk_bf16(o[mt][2] * inv * bf_lo(z.y), o[mt][3] * inv * bf_hi(z.y));
        *(u32x2*)(zr + mt * 16) = r; }
}

constexpr int N_PHASES = 15;
#ifndef IMASK
#define IMASK 31
#endif
#ifndef PMASK
#define PMASK 127
#endif
__global__ void __launch_bounds__(512) hybrid_fwd(Params p) {
    extern __shared__ __attribute__((aligned(16))) unsigned char lds_raw[];
    LAS unsigned char* lds = (LAS unsigned char*)lds_raw;
    for (int ph = p.ph_lo; ph < p.ph_hi; ++ph) {
        if (ph > p.ph_lo) cg::this_grid().sync();
        int tid = threadIdx.x, bid = blockIdx.x, nblk = gridDim.x; unsigned char* ws = p.ws;
        asm volatile("" : "+v"(tid), "+s"(bid), "+s"(nblk), "+s"(ws));
        Params q = p; q.ws = ws;
        if (ph == 14) { if (PMASK & 1) phase_prep(q, 2, lds, tid, bid, nblk); continue; }
        const int l = ph / 7, s = ph % 7;
        if (s == 0) { if (PMASK & 1) phase_prep(q, l, lds, tid, bid, nblk); }
        else if (s == 1) { if (PMASK & 2) {
            static_assert(OFF_MEMH == OFF_H + 64ull * 256 * 1024 * 2 && OFF_WMKV == OFF_WIN + 70ull * 256 * 1024 * 2, "the mem_kv GEMM rides the projection GEMM as tile (64, 70..73)");
            pg8::Gemm g{(const u16*)(ws + OFF_H), (const u16*)(ws + OFF_WIN), S_, NPROJ, 1024};
            ProjOrder so; so.init(S_, NPROJ, nblk, bid); so.nfull = (so.nwg - so.c + so.G - 1) / so.G;
            EpiProj E{(u16*)(ws + OFF_PROJ), (u16*)(ws + OFF_MKV)};
            pg8::gemm_phase<EpiProj, ProjOrder>(lds, g, so, E, tid);
        } } else if (s == 2) { if (PMASK & 4) { const int tid_ = tid;
            const u16* proj = (const u16*)(ws + OFF_PROJ);
            for (int it = bid; it < 3584; it += nblk) {
                int tid = tid_; asm volatile("" : "+v"(tid));
                if (it < 512) { if (IMASK & 1) sb_item(proj + (size_t)T_SBQ * S_ * 512, proj + (size_t)T_SBK * S_ * 512, proj + (size_t)T_SBV * S_ * 512, (u16*)(ws + OFF_PROJ) + (size_t)T_SBZ * S_ * 512, it >> 2, it & 3, lds, tid); }
                else if (it < 1536) { const int j = it - 512; if (IMASK & 2) kv1_item<false>(q, l, j >> 2, j & 3, lds, tid); }
                else if (it < 2560) { const int j = it - 1536; if (IMASK & 4) kv1_item<true>(q, l, j >> 2, j & 3, lds, tid); }
                else if (it < 3072) { const int j = it - 2560; if (IMASK & 8) gm_item(q, l, j >> 2, j & 3, lds, tid); }
                else { const int j = it - 3072; if (IMASK & 16) xa_item(q, j >> 2, j & 3, lds, tid); }
            }
        } } else if (s == 3) { if (PMASK & 8) scan_phase(q, tid, bid, nblk); }
        else if (s == 4) { if (PMASK & 16) { const int tid_ = tid;
            for (int it = bid; it < 2048; it += nblk) {
                int tid = tid_; asm volatile("" : "+v"(tid));
                if (it < 1024) out3_item<false>(q, l, it >> 2, it & 3, lds, tid);
                else { const int j = it - 1024; out3_item<true>(q, l, j >> 2, j & 3, lds, tid); }
            }
        } } else if (s == 5) { if (PMASK & 32) {
            pg8::StaticOrder so; so.init(S_, 1024, nblk, bid);
            pg8::Unit u;
            unsigned char* gsb = ws + OFF_GSCR + (size_t)bid * (16 * 8192);
            unsigned char* msb = ws + OFF_MSCR + (size_t)bid * (16 * 16384);

            for (int i = 0; so.next(i, u); ++i) {
                OneUnit ou{u.pm, u.pn, p.ph_hi > 1000 ? 2 : 1};
                for (int n = 0; n < 5; ++n) {
                    int tid2 = tid; asm volatile("" : "+v"(tid2));
                    const int tz = (n == 0) ? T_SBZ : (n == 1) ? T_MLZ : (n == 2) ? T_GMZ : (n == 3) ? T_RTZ : T_XAZ;
                    { const u16* Ap = (const u16*)(ws + OFF_H); const u16* Bp = (const u16*)(ws + OFF_WIN) + (size_t)(NPROJ + n * 1024) * 1024;
                      asm volatile("" : "+s"(Ap), "+s"(Bp));
                      pg8::Gemm g{Ap, Bp, S_, 1024, 1024};
                      EpiGate E{gsb, (unsigned)tid2 * 16u};
#ifndef NO_GATE
 pg8::gemm_phase<EpiGate, OneUnit>(lds, g, ou, E, tid2);
#endif
 }
                    { const u16* Ap = (const u16*)(ws + OFF_PROJ) + (size_t)tz * S_ * 512; const u16* Bp = (const u16*)(ws + OFF_WUP) + (size_t)n * 1024 * 512;
                      asm volatile("" : "+s"(Ap), "+s"(Bp));
                      pg8::Gemm g{Ap, Bp, S_, 1024, 512};
                      EpiUp E{gsb, msb, (unsigned)tid2 * 16u, (u16*)(ws + OFF_MERGED), n};
#ifndef NO_UP
 pg8::gemm_phase<EpiUp, OneUnit>(lds, g, ou, E, tid2);
#endif
 }
                }
            }
        } } else { if (PMASK & 64) {
            pg8::Gemm g{(const u16*)(ws + OFF_MERGED), (const u16*)(ws + OFF_WOUT), S_, 1024, 1024};
            pg8::StaticOrder so; so.init(S_, 1024, nblk, bid);
            EpiF32 E{(float*)(ws + OFF_OUTF), 1024};
            pg8::gemm_phase<EpiF32, pg8::StaticOrder>(lds, g, so, E, tid);
        } }
    }
}

#ifdef DBG_K
__global__ void dbg_dump(const unsigned* ws, float* out, size_t nwords, int n) {
    for (int i = blockIdx.x * blockDim.x + threadIdx.x; i < n; i += gridDim.x * blockDim.x) {
        unsigned s = 0; for (size_t k = i; k < nwords; k += (size_t)n) s += ws[k] * 2654435761u + (ws[k] >> 16);
        out[i] = (float)(s & 0xFFFFFu); }
}
#endif
extern "C" void kernel_launch(void* const* d_in, const int* in_sizes, int n_in, void* d_out, int out_size, void* d_ws, size_t ws_size, hipStream_t stream) {
    static int grid = 0;
    if (grid == 0) {
        if (n_in != 18 || out_size != S_ * DM || ws_size < WS_END) { fprintf(stderr, "kernel_launch: unexpected shapes / workspace (%d inputs, out %d, ws %zu < %zu)\n", n_in, out_size, ws_size, (size_t)WS_END); grid = -1; return; }
        int dev = 0, cus = 0, per_cu = 0;
        (void)hipGetDevice(&dev); (void)hipDeviceGetAttribute(&cus, hipDeviceAttributeMultiprocessorCount, dev);
        if (hipFuncSetAttribute((const void*)hybrid_fwd, hipFuncAttributeMaxDynamicSharedMemorySize, LDS_BYTES) != hipSuccess) { fprintf(stderr, "kernel_launch: hipFuncSetAttribute failed\n"); grid = -1; return; }
        if (hipOccupancyMaxActiveBlocksPerMultiprocessor(&per_cu, (const void*)hybrid_fwd, 512, LDS_BYTES) != hipSuccess || per_cu < 1) per_cu = 1;
        (void)hipGetLastError();
        grid = cus * per_cu; if (grid > 256) grid = 256; if (grid < 4) grid = 4;
    }
    if (grid < 0) return;
    Params p{};
    for (int i = 0; i < 18; ++i) p.in[i] = d_in[i];
    p.out = (float*)d_out; p.ws = (unsigned char*)d_ws;
#if ONE_LAUNCH
    p.ph_lo = 0; p.ph_hi = N_PHASES;
    void* args[] = {&p};
    hipError_t e = hipLaunchCooperativeKernel((const void*)hybrid_fwd, dim3(grid), dim3(512), args, LDS_BYTES, stream);
    if (e != hipSuccess) fprintf(stderr, "cooperative launch failed: %s (grid %d)\n", hipGetErrorString(e), grid);
#else
#ifdef DBG_K
    for (int ph = 0; ph < DBG_K; ++ph) { p.ph_lo = ph; p.ph_hi = ph + 1; hipLaunchKernelGGL(hybrid_fwd, dim3(grid), dim3(512), LDS_BYTES, stream, p); }
    hipLaunchKernelGGL(dbg_dump, dim3(2048), dim3(256), 0, stream, (const unsigned*)d_ws, (float*)d_out, (size_t)(WS_END / 4), out_size);
#else
    for (int ph = 0; ph < N_PHASES; ++ph) { p.ph_lo = ph; p.ph_hi = ph + 1; hipLaunchKernelGGL(hybrid_fwd, dim3(grid), dim3(512), LDS_BYTES, stream, p); }
#endif
#endif
}
```

```cpp
#include <hip/hip_runtime.h>
#include <hip/hip_cooperative_groups.h>
#include <cstdio>
namespace cg = cooperative_groups;
#ifndef ONE_LAUNCH
#define ONE_LAUNCH 1
#endif
namespace pg8 {
#define PG8_LAS __attribute__((address_space(3)))
typedef unsigned short bf16_t;
typedef short bf16x8 __attribute__((ext_vector_type(8)));
typedef float f32x4 __attribute__((ext_vector_type(4)));
typedef unsigned u32x4 __attribute__((ext_vector_type(4)));
constexpr int BM = 256, BK = 64, HALF = 128, HTB = HALF * BK * 2  , STAGE_BYTES = 8 * HTB, NXCD = 8, WGM = 8;

__host__ __device__ __forceinline__ int lds_byte(int r, int c) { const int st = (r >> 4) * 2 + (c >> 5), rr = r & 15, cc = c & 31, ob = rr * 64 + cc * 2; return st * 1024 + (ob ^ (((ob >> 9) & 1) << 5)); }
__host__ __device__ __forceinline__ void stage_rc(int b, int& R, int& C) { const int st = b / 1024, sb = b % 1024, swz = sb ^ (((sb >> 9) & 1) << 5); R = (st >> 1) * 16 + swz / 64; C = (st & 1) * 32 + (swz % 64) / 2; }
__host__ __device__ __forceinline__ int perm32(int rho) { const int n = rho >> 4, i = rho & 15; return 8 * (i >> 2) + 4 * n + (i & 3); }

struct Unit { int pm, pn, n; };
struct Gemm { const bf16_t* A; const bf16_t* Bt; int M, N, K; };

struct StaticOrder {
    int nM, nN, nwg, G, c;
    __host__ __device__ __forceinline__ void init(int M, int N, int G_, int c_) { nM = M / BM; nN = N / BM; nwg = nM * nN; G = G_; c = c_; }
    __host__ __device__ __forceinline__ bool next(int i, Unit& u) const {
        const long L = (long)i * G + c; if (L >= nwg) return false;
        int wgid = (int)L; { const int q = nwg / NXCD, r = nwg % NXCD, xcd = wgid % NXCD, off = wgid / NXCD; wgid = (xcd < r ? xcd * (q + 1) : r * (q + 1) + (xcd - r) * q) + off; }
        const int nig = WGM * nN, gid = wgid / nig, fm = gid * WGM, gsz = (nM - fm) < WGM ? (nM - fm) : WGM;
        u.pm = fm + ((wgid % nig) % gsz); u.pn = (wgid % nig) / gsz; return true;
    }
    __device__ __forceinline__ void a_ready(const Unit&) const {}
    __device__ __forceinline__ void done(const Unit&) const {}
    __device__ __forceinline__ const char* abase(const Gemm& g, const Unit& u, size_t tstep) const { return (const char*)g.A + (size_t)u.pm * tstep; }
    __device__ __forceinline__ const char* bbase(const Gemm& g, const Unit& u, size_t tstep) const { return (const char*)g.Bt + (size_t)u.pn * tstep; }
};

typedef __bf16 bf16v2_t __attribute__((ext_vector_type(2)));
typedef float f32v2_t __attribute__((ext_vector_type(2)));
__device__ __forceinline__ unsigned cvt_pk_bf16(float lo, float hi) { const f32v2_t v = {lo, hi}; const bf16v2_t r = __builtin_convertvector(v, bf16v2_t); return __builtin_bit_cast(unsigned, r); }
template <class Epi, class Sched, bool ALIGN_EPI = true, bool SP2 = true>
__device__ __forceinline__ void gemm_phase(PG8_LAS unsigned char* lds, const Gemm g, const Sched& S, const Epi& E, const int tid) {
    const int wid = __builtin_amdgcn_readfirstlane(tid >> 6), lane = tid & 63, wr = wid >> 2, wc = wid & 3, fr = lane & 15, fq = lane >> 4;
    const int K = g.K, nt = K / BK;
    unsigned voffA[2], voffB[2];
#pragma unroll
    for (int i = 0; i < 2; ++i) { int R, C; stage_rc(tid * 16 + i * 8192, R, C); const int Rb = Epi::PERM ? ((R & ~31) + perm32(R & 31)) : R;
        voffA[i] = (unsigned)(R * K + C) * 2u; voffB[i] = (unsigned)(Rb * K + C) * 2u; }
    const size_t kstep = (size_t)(BK * 2);
    const size_t hstep = (size_t)HALF * K * 2;
    const size_t tstep = 2 * hstep;
    const unsigned ldsw = (unsigned)wid * 1024u;
    const int aoff = lds_byte(wr * 64 + fr, fq * 8), boff = lds_byte(wc * 32 + fr, fq * 8);
#define PG8_SA(b, h) (((b) * 2 + (h)) * HTB)
#define PG8_SB(b, h) ((4 + (b) * 2 + (h)) * HTB)
#define PG8_STAGE(bufoff, gbase, voff) do { _Pragma("unroll") for (int _i = 0; _i < 2; ++_i) \
        __builtin_amdgcn_global_load_lds((const unsigned*)((const char*)(gbase) + (voff)[_i]), (PG8_LAS unsigned*)(lds + (bufoff) + ldsw + _i * 8192), 16, 0, 0); } while (0)
#define PG8_LDA(dst, b, h) do { _Pragma("unroll") for (int m = 0; m < 4; ++m) _Pragma("unroll") for (int k = 0; k < 2; ++k) dst[m][k] = *(const PG8_LAS bf16x8*)(lds + PG8_SA(b, h) + aoff + m * 2048 + k * 1024); } while (0)
#define PG8_LDB(dst, b, h) do { _Pragma("unroll") for (int n = 0; n < 2; ++n) _Pragma("unroll") for (int k = 0; k < 2; ++k) dst[n][k] = *(const PG8_LAS bf16x8*)(lds + PG8_SB(b, h) + boff + n * 2048 + k * 1024); } while (0)
#define PG8_MMA(ai, bj, At, Bt) do { __builtin_amdgcn_s_setprio(1); _Pragma("unroll") for (int m = 0; m < 4; ++m) _Pragma("unroll") for (int n = 0; n < 2; ++n) _Pragma("unroll") for (int k = 0; k < 2; ++k) \
        acc[ai][bj][m][n] = __builtin_amdgcn_mfma_f32_16x16x32_bf16(Bt[n][k], At[m][k], acc[ai][bj][m][n], 0, 0, 0); __builtin_amdgcn_s_setprio(0); } while (0)
#define PG8_WAIT_V(n) asm volatile("s_waitcnt vmcnt(" #n ")" ::: "memory")
#define PG8_WAIT_L(n) asm volatile("s_waitcnt lgkmcnt(" #n ")" ::: "memory")
#define PG8_BAR __builtin_amdgcn_s_barrier()
#define PG8_SCHED __builtin_amdgcn_sched_barrier(0)
    Unit cur, nxt; int ui = 0;
    if (!S.next(0, cur)) return;
    f32x4 acc[2][2][4][2];
#pragma unroll
    for (int a = 0; a < 2; ++a)
#pragma unroll
        for (int b = 0; b < 2; ++b)
#pragma unroll
            for (int m = 0; m < 4; ++m)
#pragma unroll
                for (int n = 0; n < 2; ++n) acc[a][b][m][n] = (f32x4){0.f, 0.f, 0.f, 0.f};
    bf16x8 At[4][2], B0[2][2], B1[2][2];
    const char* cA = S.abase(g, cur, tstep); const char* cB = S.bbase(g, cur, tstep);
    S.a_ready(cur);
    if constexpr (SP2) {
        PG8_STAGE(PG8_SB(0, 0), cB, voffB); PG8_STAGE(PG8_SB(0, 1), cB + hstep, voffB); PG8_STAGE(PG8_SA(0, 0), cA, voffA); PG8_STAGE(PG8_SA(0, 1), cA + hstep, voffA);
        if (wr == 1) PG8_BAR;
        PG8_WAIT_V(2); PG8_BAR;
        PG8_STAGE(PG8_SB(1, 0), cB + kstep, voffB); PG8_STAGE(PG8_SA(1, 0), cA + kstep, voffA); PG8_STAGE(PG8_SB(1, 1), cB + hstep + kstep, voffB);
        PG8_WAIT_V(6); PG8_BAR;
    } else {
        PG8_STAGE(PG8_SB(0, 0), cB, voffB); PG8_STAGE(PG8_SA(0, 0), cA, voffA); PG8_STAGE(PG8_SB(0, 1), cB + hstep, voffB); PG8_STAGE(PG8_SA(0, 1), cA + hstep, voffA);
        if (wr == 1) PG8_BAR;
        PG8_WAIT_V(4); PG8_BAR;
        PG8_STAGE(PG8_SB(1, 0), cB + kstep, voffB); PG8_STAGE(PG8_SA(1, 0), cA + kstep, voffA); PG8_STAGE(PG8_SB(1, 1), cB + hstep + kstep, voffB);
        PG8_WAIT_V(6); PG8_BAR;
    }
    for (;;) {
        const bool has_next = S.next(ui + 1, nxt);
        const char* nA = has_next ? S.abase(g, nxt, tstep) : cA; const char* nB = has_next ? S.bbase(g, nxt, tstep) : cB;
        for (int t = 0; t < nt; t += 2) {
            const bool last = (t == nt - 2);
            const char* a1 = cA + (size_t)(t + 1) * kstep;
            const char* a2 = last ? nA : cA + (size_t)(t + 2) * kstep; const char* b2 = last ? nB : cB + (size_t)(t + 2) * kstep;
            const char* a3 = a2 + kstep; const char* b3 = b2 + kstep;
            if (last && has_next) S.a_ready(nxt);
            if constexpr (SP2) {
            PG8_LDB(B0, 0, 0); PG8_LDB(B1, 0, 1); PG8_SCHED; PG8_LDA(At, 0, 0); PG8_STAGE(PG8_SA(1, 1), a1 + hstep, voffA);
            PG8_WAIT_V(8); PG8_WAIT_L(0); PG8_BAR; PG8_MMA(0, 0, At, B0); PG8_MMA(0, 1, At, B1); PG8_BAR; PG8_SCHED;
            PG8_LDA(At, 0, 1); PG8_STAGE(PG8_SB(0, 0), b2, voffB); PG8_STAGE(PG8_SB(0, 1), b2 + hstep, voffB); PG8_STAGE(PG8_SA(0, 0), a2, voffA);
            PG8_WAIT_V(8); PG8_WAIT_L(0); PG8_BAR; PG8_MMA(1, 0, At, B0); PG8_MMA(1, 1, At, B1); PG8_BAR; PG8_SCHED;
            PG8_LDB(B0, 1, 0); PG8_LDB(B1, 1, 1); PG8_SCHED; PG8_LDA(At, 1, 0); PG8_STAGE(PG8_SA(0, 1), a2 + hstep, voffA);
            PG8_WAIT_V(8); PG8_WAIT_L(0); PG8_BAR; PG8_MMA(0, 0, At, B0); PG8_MMA(0, 1, At, B1); PG8_BAR; PG8_SCHED;
            PG8_LDA(At, 1, 1); PG8_STAGE(PG8_SB(1, 0), b3, voffB); PG8_STAGE(PG8_SB(1, 1), b3 + hstep, voffB); PG8_STAGE(PG8_SA(1, 0), a3, voffA);
            PG8_WAIT_V(8); PG8_WAIT_L(0); PG8_BAR; PG8_MMA(1, 0, At, B0); PG8_MMA(1, 1, At, B1); PG8_BAR; PG8_SCHED;
            } else {
            PG8_LDB(B0, 0, 0); PG8_SCHED; PG8_LDA(At, 0, 0); PG8_STAGE(PG8_SA(1, 1), a1 + hstep, voffA);
            PG8_WAIT_L(8); PG8_BAR; PG8_WAIT_L(0); PG8_MMA(0, 0, At, B0); PG8_BAR; PG8_SCHED;
            PG8_LDB(B1, 0, 1); PG8_STAGE(PG8_SB(0, 0), b2, voffB);
            PG8_BAR; PG8_WAIT_L(0); PG8_MMA(0, 1, At, B1); PG8_BAR;
            PG8_LDA(At, 0, 1); PG8_STAGE(PG8_SA(0, 0), a2, voffA);
            PG8_BAR; PG8_WAIT_L(0); PG8_MMA(1, 0, At, B0); PG8_BAR; PG8_SCHED;
            PG8_STAGE(PG8_SB(0, 1), b2 + hstep, voffB);
            PG8_WAIT_V(6); PG8_BAR; PG8_MMA(1, 1, At, B1); PG8_BAR;
            PG8_LDB(B0, 1, 0); PG8_SCHED; PG8_LDA(At, 1, 0); PG8_STAGE(PG8_SA(0, 1), a2 + hstep, voffA);
            PG8_WAIT_L(8); PG8_BAR; PG8_WAIT_L(0); PG8_MMA(0, 0, At, B0); PG8_BAR; PG8_SCHED;
            PG8_LDB(B1, 1, 1); PG8_STAGE(PG8_SB(1, 0), b3, voffB);
            PG8_BAR; PG8_WAIT_L(0); PG8_MMA(0, 1, At, B1); PG8_BAR;
            PG8_LDA(At, 1, 1); PG8_STAGE(PG8_SA(1, 0), a3, voffA);
            PG8_BAR; PG8_WAIT_L(0); PG8_MMA(1, 0, At, B0); PG8_BAR; PG8_SCHED;
            PG8_STAGE(PG8_SB(1, 1), b3 + hstep, voffB);
            PG8_WAIT_V(6); PG8_BAR; PG8_MMA(1, 1, At, B1); PG8_BAR;
            }
        }
        if constexpr (ALIGN_EPI) { if (wr == 0) PG8_BAR; }
        if constexpr (!Epi::AFTER_DRAIN) { E(acc, cur, wr, wc, fr, fq); S.done(cur); }
        if (!has_next) break;
        bool zero_acc = true;
        if constexpr (Epi::KEEPS) zero_acc = !E.keep(cur);
        if (zero_acc) {
#pragma unroll
        for (int a = 0; a < 2; ++a)
#pragma unroll
            for (int b = 0; b < 2; ++b)
#pragma unroll
                for (int m = 0; m < 4; ++m)
#pragma unroll
                    for (int n = 0; n < 2; ++n) acc[a][b][m][n] = (f32x4){0.f, 0.f, 0.f, 0.f};
        }
        cur = nxt; cA = nA; cB = nB; ++ui;
        if constexpr (ALIGN_EPI) { if (wr == 1) PG8_BAR; }
    }
    PG8_WAIT_V(0);
    if constexpr (!ALIGN_EPI) { if (wr == 0) PG8_BAR; }
    PG8_BAR;
    if constexpr (Epi::AFTER_DRAIN) { E.fused(acc, cur, wr, wc, fr, fq, lds, wid, lane); S.done(cur); }
#undef PG8_SA
#undef PG8_SB
#undef PG8_STAGE
#undef PG8_LDA
#undef PG8_LDB
#undef PG8_MMA
#undef PG8_WAIT_V
#undef PG8_WAIT_L
#undef PG8_BAR
#undef PG8_SCHED
}
}

#define LAS __attribute__((address_space(3)))
typedef unsigned short u16;
typedef short bf16x8 __attribute__((ext_vector_type(8)));
typedef short s16x4 __attribute__((ext_vector_type(4)));
typedef float f32x4 __attribute__((ext_vector_type(4)));
typedef unsigned u32x4 __attribute__((ext_vector_type(4)));
typedef unsigned u32x2 __attribute__((ext_vector_type(2)));
using pg8::cvt_pk_bf16;

constexpr int S_ = 16384, DM = 1024, BW = 512, HD = 128, NCH = 256, DIN = 14344;
constexpr int NPROJ = 9216, NWIN = 14336;
constexpr float EPS = 1e-6f;
constexpr float QSCALE = 0.08838834764831845f;
constexpr int LDS_BYTES = 147456, LDS_CTL = LDS_BYTES - 64;

constexpr size_t OFF_WIN = 0;
constexpr size_t SZ_WIN = (size_t)NWIN * 1024 * 2;
constexpr size_t OFF_WUP = OFF_WIN + SZ_WIN;
constexpr size_t SZ_WUP = 5ull * 1024 * 512 * 2;
constexpr size_t OFF_WOUT = OFF_WUP + SZ_WUP;
constexpr size_t SZ_WSQ = 1024ull * 1024 * 2;
constexpr size_t OFF_WMKV = OFF_WOUT + SZ_WSQ;
constexpr size_t OFF_H = OFF_WMKV + SZ_WSQ;
constexpr size_t SZ_H = (size_t)S_ * 1024 * 2;
constexpr size_t OFF_MEMH = OFF_H + SZ_H;
constexpr size_t OFF_MKV = OFF_MEMH + 256 * 1024 * 2;
constexpr size_t OFF_IF = OFF_MKV + 256 * 1024 * 2 + 512 * 256 * 2;
constexpr size_t OFF_SC = OFF_IF + (size_t)S_ * 8 * 4;
constexpr size_t OFF_NST = OFF_SC + 3 * 4 * 256 * 4;
constexpr size_t OFF_PROJ = OFF_NST + 4 * 256 * 128 * 4;
constexpr size_t SZ_T = (size_t)S_ * 512 * 2;
constexpr size_t OFF_KV = OFF_PROJ + 18 * SZ_T;
constexpr size_t SZ_KV = 2ull * 4 * 256 * 128 * 128 * 2;
constexpr size_t OFF_BAR = OFF_KV + SZ_KV;
constexpr size_t OFF_GATES = OFF_BAR + 16384;
constexpr size_t WS_END = OFF_GATES + 4ull * 16384 * 2 * 4;
constexpr int LDS_CONV = 98304;
constexpr size_t OFF_MERGED = OFF_KV;
constexpr size_t OFF_MSCR = OFF_PROJ + 4 * SZ_T;
constexpr size_t OFF_GSCR = OFF_PROJ + 9 * SZ_T;
constexpr size_t OFF_OUTF = OFF_PROJ + 4 * SZ_T;
static_assert(OFF_PROJ % 256 == 0 && OFF_KV % 256 == 0, "align");

enum { T_SBQ = 0, T_SBK, T_SBV, T_SBZ, T_MLQ, T_MLK, T_MLV, T_MLO, T_MLZ, T_GMU, T_GMV, T_GMZ, T_RTQ, T_RTK, T_RTV, T_RTZ, T_XAQ, T_XAZ };

__device__ const float INVF[64] = {
1.000000000e+00f, 8.659643531e-01f, 7.498942614e-01f, 6.493816376e-01f, 5.623413324e-01f, 4.869675338e-01f, 4.216965139e-01f, 3.651741147e-01f, 3.162277639e-01f, 2.738419771e-01f, 2.371373773e-01f, 2.053525001e-01f, 1.778279394e-01f, 1.539926529e-01f, 1.333521307e-01f, 1.154782027e-01f, 1.000000015e-01f, 8.659642935e-02f, 7.498941571e-02f, 6.493816525e-02f, 5.623413250e-02f, 4.869675264e-02f, 4.216965288e-02f, 3.651741147e-02f, 3.162277490e-02f, 2.738419734e-02f, 2.371373773e-02f, 2.053525113e-02f, 1.778279431e-02f, 1.539926510e-02f, 1.333521493e-02f, 1.154782064e-02f, 9.999999776e-03f, 8.659643121e-03f, 7.498941850e-03f, 6.493816152e-03f, 5.623413250e-03f, 4.869675264e-03f, 4.216964822e-03f, 3.651741194e-03f, 3.162277630e-03f, 2.738419687e-03f, 2.371373586e-03f, 2.053524833e-03f, 1.778279431e-03f, 1.539926510e-03f, 1.333521446e-03f, 1.154781901e-03f, 1.000000047e-03f, 8.659643354e-04f, 7.498942432e-04f, 6.493816618e-04f, 5.623413017e-04f, 4.869675322e-04f, 4.216965172e-04f, 3.651741426e-04f, 3.162277571e-04f, 2.738419571e-04f, 2.371373703e-04f, 2.053525095e-04f, 1.778279402e-04f, 1.539926452e-04f, 1.333521504e-04f, 1.154782003e-04f };
__device__ __forceinline__ float log_gamma(int h) { return h == 0 ? -3.174869716e-02f : h == 1 ? -1.574835740e-02f : h == 2 ? -7.843177766e-03f : -3.913899418e-03f; }

struct Params { const void* in[18]; float* out; unsigned char* ws; int ph_lo, ph_hi; };

__device__ __forceinline__ float bf_lo(unsigned w) { return __uint_as_float(w << 16); }
__device__ __forceinline__ float bf_hi(unsigned w) { return __uint_as_float(w & 0xffff0000u); }
__device__ __forceinline__ float bf2f(u16 b) { return __uint_as_float(((unsigned)b) << 16); }
__device__ __forceinline__ float fexp(float x) { return __expf(x); }
__device__ __forceinline__ float sigmoidf_(float x) { return __builtin_amdgcn_rcpf(1.0f + __expf(-x)); }
__device__ __forceinline__ float siluf_(float x) { return x * __builtin_amdgcn_rcpf(1.0f + __expf(-x)); }
__device__ __forceinline__ float geluf_(float v) { return v * sigmoidf_(1.5957691216057308f * (v + 0.044715f * v * v * v)); }
__device__ __forceinline__ float softplusf_(float z) { return fmaxf(z, 0.f) + __logf(1.0f + __expf(-fabsf(z))); }
__device__ __forceinline__ float wave_sum(float v) {
#pragma unroll
    for (int o = 1; o < 64; o <<= 1) v += __shfl_xor(v, o);
    return v;
}
#define LDS_WAIT() asm volatile("s_waitcnt lgkmcnt(0)" ::: "memory")
#define MFMA16(a, b, c) __builtin_amdgcn_mfma_f32_16x16x32_bf16((a), (b), (c), 0, 0, 0)
__device__ __forceinline__ bf16x8 lfrag(const LAS u16* base, int row, int ld, int kofs) { return *(const LAS bf16x8*)(base + row * ld + kofs); }
__device__ __forceinline__ bf16x8 lfrag_slot(const LAS u16* base, int row, int ld, int kb, int quad) {
    const s16x4 lo = *(const LAS s16x4*)(base + row * ld + kb + quad * 4);
    const s16x4 hi = *(const LAS s16x4*)(base + row * ld + kb + 16 + quad * 4);
    bf16x8 r; r[0] = lo[0]; r[1] = lo[1]; r[2] = lo[2]; r[3] = lo[3]; r[4] = hi[0]; r[5] = hi[1]; r[6] = hi[2]; r[7] = hi[3]; return r;
}
__device__ __forceinline__ bf16x8 pack_p(const f32x4 a, const f32x4 b) {
    u32x4 w; w.x = cvt_pk_bf16(a[0], a[1]); w.y = cvt_pk_bf16(a[2], a[3]); w.z = cvt_pk_bf16(b[0], b[1]); w.w = cvt_pk_bf16(b[2], b[3]);
    return __builtin_bit_cast(bf16x8, w);
}
__device__ __forceinline__ float bfe(const u32x4 v, int e) { const unsigned w = v[e >> 1]; return (e & 1) ? bf_hi(w) : bf_lo(w); }
__device__ __forceinline__ void st_tr8(LAS u16* XT, int ld, int c0, int row, const float (&val)[8]) {
#pragma unroll
    for (int e = 0; e < 8; e += 2) { const unsigned w = cvt_pk_bf16(val[e], val[e + 1]); XT[(c0 + e) * ld + row] = (u16)(w & 0xffffu); XT[(c0 + e + 1) * ld + row] = (u16)(w >> 16); }
}
__device__ __forceinline__ void st_vt_pair(LAS u16* VT, int ld, int ch, const u32x4 v) {
    const int pr = ch >> 4, tok = (ch & 15) * 4;
    u32x2 c0, c1;
    c0.x = __builtin_amdgcn_perm(v.y, v.x, 0x05040100u); c0.y = __builtin_amdgcn_perm(v.w, v.z, 0x05040100u);
    c1.x = __builtin_amdgcn_perm(v.y, v.x, 0x07060302u); c1.y = __builtin_amdgcn_perm(v.w, v.z, 0x07060302u);
    *(LAS u32x2*)(VT + (2 * pr) * ld + tok) = c0; *(LAS u32x2*)(VT + (2 * pr + 1) * ld + tok) = c1;
}
__device__ __forceinline__ void st_tr8_raw(LAS u16* XT, int ld, int c0, int row, const u32x4 v) {
#pragma unroll
    for (int e = 0; e < 4; ++e) { XT[(c0 + 2 * e) * ld + row] = (u16)(v[e] & 0xffffu); XT[(c0 + 2 * e + 1) * ld + row] = (u16)(v[e] >> 16); }
}
#include <cstdint>
#include <cstdlib>
#include <vector>

#define XB_TMO      128
#define XB_XCNT(j)  (256  + 64 * (j))
#define XB_XSUB(j)  (1280 + 64 * (j))
#define XB_XGEN(j)  (2304 + 64 * (j))
#define XB_TOP      3328
#define XB_TOPGEN   3392
#define XCD_BAR_WORDS 3456
#define XB_SPIN_CAP (1u << 18)

__device__ __forceinline__ unsigned xb_ld(unsigned* p)              { return __hip_atomic_load(p, __ATOMIC_RELAXED, __HIP_MEMORY_SCOPE_AGENT); }
__device__ __forceinline__ unsigned xb_add(unsigned* p, unsigned v) { return __hip_atomic_fetch_add(p, v, __ATOMIC_RELAXED, __HIP_MEMORY_SCOPE_AGENT); }
__device__ __forceinline__ unsigned xb_xcc_id() { return (unsigned)__builtin_amdgcn_s_getreg((3 << 11) | 20) & 0xFu; }
#define XB_SPIN(cond, bar) do { unsigned _sp = 0; while (cond) { __builtin_amdgcn_s_sleep(1); \
    if ((++_sp & 255u) == 0u) { if (xb_ld(&(bar)[XB_TMO])) break; if (_sp > XB_SPIN_CAP) { atomicAdd(&(bar)[XB_TMO], 1u); break; } } } } while (0)

struct XcdBarrier {
    unsigned* bar; unsigned x;
    volatile LAS unsigned* st;
};

__device__ __forceinline__ XcdBarrier xcd_barrier_post(unsigned* bar, volatile LAS unsigned* st) {
    XcdBarrier b; b.bar = bar; b.x = xb_xcc_id(); b.st = st;
    if (threadIdx.x == 0) (void)xb_add(&bar[XB_XCNT(b.x)], 1u);
    return b;
}
__device__ __forceinline__ void xcd_barrier_complete(unsigned* bar, unsigned x, unsigned& nloc, unsigned& nx) {
    const unsigned G = gridDim.x * gridDim.y * gridDim.z;
    unsigned sum, cnt, mine, sp = 0u;
    for (;;) {
        sum = 0u; cnt = 0u; mine = 0u;
#pragma unroll
        for (unsigned j = 0; j < 16; ++j) { const unsigned c = xb_ld(&bar[XB_XCNT(j)]); sum += c; cnt += (c > 0u) ? 1u : 0u; mine = (j == x) ? c : mine; }
        if (sum == G) break;
        __builtin_amdgcn_s_sleep(1);
        if ((++sp & 255u) == 0u) { if (xb_ld(&bar[XB_TMO])) break; if (sp > XB_SPIN_CAP) { atomicAdd(&bar[XB_TMO], 1u); break; } }
    }
    nloc = mine > 0u ? mine : 1u; nx = cnt > 0u ? cnt : 1u;
}

__device__ __forceinline__ void xcd_barrier(const XcdBarrier& b) {
    asm volatile("s_waitcnt vmcnt(0)" ::: "memory");
    __syncthreads();
    if (threadIdx.x == 0) {
        unsigned* bar = b.bar;
        __builtin_amdgcn_s_waitcnt(0);
        unsigned nloc = b.st[0], nx = b.st[1];
        if (nloc == 0u) { xcd_barrier_complete(bar, b.x, nloc, nx); b.st[0] = nloc; b.st[1] = nx; }
        const unsigned old = xb_add(&bar[XB_XSUB(b.x)], 1u);
        const unsigned gen = old / nloc;
        if (old + 1u == (gen + 1u) * nloc) {
            __builtin_amdgcn_fence(__ATOMIC_RELEASE, "agent");
            asm volatile("s_waitcnt vmcnt(0)" ::: "memory");
            const unsigned og = xb_add(&bar[XB_TOP], 1u);
            const unsigned tg = og / nx;
            if (og + 1u == (tg + 1u) * nx) xb_add(&bar[XB_TOPGEN], 1u);
            else XB_SPIN(xb_ld(&bar[XB_TOPGEN]) == tg, bar);
            __builtin_amdgcn_fence(__ATOMIC_ACQUIRE, "agent");
            xb_add(&bar[XB_XGEN(b.x)], 1u);
            asm volatile("s_waitcnt vmcnt(0)" ::: "memory");
        } else {
            XB_SPIN(xb_ld(&bar[XB_XGEN(b.x)]) == gen, bar);
            __builtin_amdgcn_fence(__ATOMIC_ACQUIRE, "agent");
            asm volatile("s_waitcnt vmcnt(0)" ::: "memory");
        }
    }
    __syncthreads();
}

__device__ __forceinline__ float act_apply(float v, int mode) {
    if (mode == 0) return v;
    if (mode == 1) return v * QSCALE;
    if (mode == 2) return v * (QSCALE * 1.4426950408889634f);
    if (mode == 3) return sigmoidf_(v);
    const float y = 1.5957691216057308f * (v + 0.044715f * v * v * v);
    return v * sigmoidf_(y);
}
struct EpiProj {
    static constexpr bool PERM = true, AFTER_DRAIN = false, KEEPS = false;
    u16* base; u16* mkv;
    __device__ __forceinline__ void operator()(const f32x4 (&acc)[2][2][4][2], const pg8::Unit& u, int wr, int wc, int fr, int fq) const {
        int mode = 0; u16* b = mkv; int colt = (u.pn - 70) * 256; int ldc = 1024; int pm = 0;
        if (u.pm < 64) {
            const int t = u.pn >> 1; colt = (u.pn & 1) * 256; b = base + (size_t)t * ((size_t)S_ * 512); ldc = 512; pm = u.pm;
            mode = (t == T_SBQ) ? 2 : (t == T_XAQ) ? 1 : 0;
        }
        const int row0 = pm * 256 + wr * 64 + fr, col0 = colt + wc * 32 + 8 * fq;
        if (u.pm >= 64 && u.pn >= 72) {
#pragma unroll
            for (int ai = 0; ai < 2; ++ai)
#pragma unroll
                for (int m = 0; m < 4; ++m) { const int r = row0 + ai * 128 + m * 16;
#pragma unroll
                    for (int bj = 0; bj < 2; ++bj) { const int cv = col0 + bj * 128 - 512; u16* tp = mkv + 256 * 1024 + (size_t)cv * 256 + r;
                        const f32x4 v0 = acc[ai][bj][m][0], v1 = acc[ai][bj][m][1];
                        const unsigned w0 = cvt_pk_bf16(v0[0], v0[1]), w1 = cvt_pk_bf16(v0[2], v0[3]), w2 = cvt_pk_bf16(v1[0], v1[1]), w3 = cvt_pk_bf16(v1[2], v1[3]);
                        tp[0] = (u16)(w0 & 0xffffu); tp[256] = (u16)(w0 >> 16); tp[512] = (u16)(w1 & 0xffffu); tp[768] = (u16)(w1 >> 16);
                        tp[1024] = (u16)(w2 & 0xffffu); tp[1280] = (u16)(w2 >> 16); tp[1536] = (u16)(w3 & 0xffffu); tp[1792] = (u16)(w3 >> 16); } }
            return;
        }
        if (u.pm < 64 && ((u.pn >> 1) == T_SBV || (u.pn >> 1) == T_MLV || (u.pn >> 1) == T_RTV)) {
#pragma unroll
            for (int ai = 0; ai < 2; ++ai)
#pragma unroll
                for (int m = 0; m < 4; ++m) { const int r = row0 + ai * 128 + m * 16;
#pragma unroll
                    for (int bj = 0; bj < 2; ++bj) { const int c = col0 + bj * 128; unsigned* tp = (unsigned*)(b + ((size_t)((r >> 6) * 4 + (c >> 7))) * 8192 + (size_t)((c & 127) >> 1) * 128 + (r & 63) * 2);
                        const f32x4 v0 = acc[ai][bj][m][0], v1 = acc[ai][bj][m][1];
                        tp[0] = cvt_pk_bf16(v0[0], v0[1]); tp[64] = cvt_pk_bf16(v0[2], v0[3]); tp[128] = cvt_pk_bf16(v1[0], v1[1]); tp[192] = cvt_pk_bf16(v1[2], v1[3]); } }
            return;
        }
#pragma unroll
        for (int ai = 0; ai < 2; ++ai)
#pragma unroll
            for (int m = 0; m < 4; ++m) { u16* rowp = b + (size_t)(row0 + ai * 128 + m * 16) * ldc + col0;
#pragma unroll
                for (int bj = 0; bj < 2; ++bj) { const f32x4 v0 = acc[ai][bj][m][0], v1 = acc[ai][bj][m][1];
                    u32x4 w; w.x = cvt_pk_bf16(act_apply(v0[0], mode), act_apply(v0[1], mode)); w.y = cvt_pk_bf16(act_apply(v0[2], mode), act_apply(v0[3], mode));
                    w.z = cvt_pk_bf16(act_apply(v1[0], mode), act_apply(v1[1], mode)); w.w = cvt_pk_bf16(act_apply(v1[2], mode), act_apply(v1[3], mode));
                    *(u32x4*)(rowp + bj * 128) = w; __builtin_amdgcn_sched_barrier(0); } }
    }
};
__device__ __forceinline__ int eslot(int n) { return n == 0 ? T_SBQ : n == 1 ? T_MLQ : n == 2 ? T_MLV : n == 3 ? T_GMU : T_RTQ; }
__device__ __forceinline__ int yslot(int n) { return n == 0 ? T_SBZ : n == 1 ? T_MLZ : n == 2 ? T_GMZ : n == 3 ? T_RTZ : T_XAZ; }
struct EpiGateE {
    static constexpr bool PERM = true, AFTER_DRAIN = false, KEEPS = false;
    u16* proj;
    __device__ __forceinline__ void operator()(const f32x4 (&acc)[2][2][4][2], const pg8::Unit& u, int wr, int wc, int fr, int fq) const {
        const int n = u.pn >> 2; u16* b = proj + (size_t)eslot(n) * ((size_t)S_ * 512);
        const int row0 = u.pm * 256 + wr * 64 + fr, col0 = (u.pn & 3) * 256 + wc * 32 + 8 * fq;
#pragma unroll
        for (int ai = 0; ai < 2; ++ai)
#pragma unroll
            for (int m = 0; m < 4; ++m) { u16* rowp = b + (size_t)(row0 + ai * 128 + m * 16) * 1024 + col0;
#pragma unroll
                for (int bj = 0; bj < 2; ++bj) { const f32x4 v0 = acc[ai][bj][m][0], v1 = acc[ai][bj][m][1];
                    float e[8];
#pragma unroll
                    for (int i = 0; i < 4; ++i) { e[i] = fminf(1.0f + __expf(-v0[i]), 1e30f); e[4 + i] = fminf(1.0f + __expf(-v1[i]), 1e30f); }
                    u32x4 w; w.x = cvt_pk_bf16(e[0], e[1]); w.y = cvt_pk_bf16(e[2], e[3]); w.z = cvt_pk_bf16(e[4], e[5]); w.w = cvt_pk_bf16(e[6], e[7]);
                    *(u32x4*)(rowp + bj * 128) = w; } }
    }
};
struct EpiMerge {
    static constexpr bool PERM = true, AFTER_DRAIN = false, KEEPS = true;
    const u16* proj; u16* merged;
    __device__ __forceinline__ bool keep(const pg8::Unit& u) const { return u.n < 4; }
    __device__ __forceinline__ void operator()(f32x4 (&acc)[2][2][4][2], const pg8::Unit& u, int wr, int wc, int fr, int fq) const {
        const int n = u.n; const bool last = (n == 4);
        const u16* e0 = proj + (size_t)eslot(n) * ((size_t)S_ * 512); const u16* e1 = proj + (size_t)eslot(last ? 4 : n + 1) * ((size_t)S_ * 512);
        const int row0 = u.pm * 256 + wr * 64 + fr, col0 = u.pn * 256 + wc * 32 + 8 * fq;
#pragma unroll
        for (int ai = 0; ai < 2; ++ai) {
            u32x4 a[4][2], b[4][2];
#pragma unroll
            for (int m = 0; m < 4; ++m)
#pragma unroll
                for (int bj = 0; bj < 2; ++bj) { const size_t ro = (size_t)(row0 + ai * 128 + m * 16) * 1024 + col0 + bj * 128;
                    a[m][bj] = *(const u32x4*)(e0 + ro); b[m][bj] = *(const u32x4*)(e1 + ro); }
#pragma unroll
            for (int m = 0; m < 4; ++m)
#pragma unroll
                for (int bj = 0; bj < 2; ++bj) {
                    float f[8];
#pragma unroll
                    for (int i = 0; i < 8; ++i) { f[i] = __builtin_amdgcn_rcpf(bfe(a[m][bj], i)); if (!last) f[i] *= bfe(b[m][bj], i); }
#pragma unroll
                    for (int i = 0; i < 4; ++i) { acc[ai][bj][m][0][i] *= f[i]; acc[ai][bj][m][1][i] *= f[4 + i]; }
                    if (last) { const f32x4 v0 = acc[ai][bj][m][0], v1 = acc[ai][bj][m][1];
                        u32x4 w; w.x = cvt_pk_bf16(v0[0], v0[1]); w.y = cvt_pk_bf16(v0[2], v0[3]); w.z = cvt_pk_bf16(v1[0], v1[1]); w.w = cvt_pk_bf16(v1[2], v1[3]);
                        *(u32x4*)(merged + (size_t)(row0 + ai * 128 + m * 16) * 1024 + col0 + bj * 128) = w; } }
            asm volatile("" ::: "memory"); }
    }
};
struct UpOrder : pg8::StaticOrder {
    __device__ __forceinline__ bool next(int i, pg8::Unit& u) const { const int ti = i / 5; if (!pg8::StaticOrder::next(ti, u)) return false; u.n = i - ti * 5; return true; }
    __device__ __forceinline__ const char* abase(const pg8::Gemm& g, const pg8::Unit& u, size_t tstep) const { return (const char*)g.A + (size_t)yslot(u.n) * SZ_T + (size_t)u.pm * tstep; }
    __device__ __forceinline__ const char* bbase(const pg8::Gemm& g, const pg8::Unit& u, size_t tstep) const { return (const char*)g.Bt + ((size_t)u.n * 1024 + (size_t)u.pn * 256) * 1024; }
};
struct EpiF32 {
    static constexpr bool PERM = false, AFTER_DRAIN = false, KEEPS = false;
    float* C; int ldc;
    __device__ __forceinline__ void operator()(const f32x4 (&acc)[2][2][4][2], const pg8::Unit& u, int wr, int wc, int fr, int fq) const {
        const int row0 = u.pm * 256 + wr * 64 + fr, col0 = u.pn * 256 + wc * 32 + 4 * fq;
#pragma unroll
        for (int ai = 0; ai < 2; ++ai)
#pragma unroll
            for (int m = 0; m < 4; ++m) { float* rowp = C + (size_t)(row0 + ai * 128 + m * 16) * ldc + col0;
#pragma unroll
                for (int bj = 0; bj < 2; ++bj)
#pragma unroll
                    for (int n = 0; n < 2; ++n) *(f32x4*)(rowp + bj * 128 + n * 16) = acc[ai][bj][m][n]; }
    }
};
struct ProjOrder : pg8::StaticOrder {
    int nfull;
    __device__ __forceinline__ bool next(int i, pg8::Unit& u) const {
        if (i < nfull) return pg8::StaticOrder::next(i, u);
        if (i == nfull && c < 4) { u.pm = 64; u.pn = 70 + c; return true; }
        return false; }
};
struct OneUnit { int pm, pn, cnt;
    __device__ __forceinline__ const char* abase(const pg8::Gemm& g, const pg8::Unit& u, size_t tstep) const { return (const char*)g.A + (size_t)u.pm * tstep; }
    __device__ __forceinline__ const char* bbase(const pg8::Gemm& g, const pg8::Unit& u, size_t tstep) const { return (const char*)g.Bt + (size_t)u.pn * tstep; }
    __device__ __forceinline__ bool next(int i, pg8::Unit& u) const { if (i >= cnt) return false; u.pm = pm; u.pn = pn; return true; }
    __device__ __forceinline__ void a_ready(const pg8::Unit&) const {}
    __device__ __forceinline__ void done(const pg8::Unit&) const {}
};

__device__ __forceinline__ void transpose_item(const float* W, int ldw, int c0, int k0, u16* WT, int K, int n0, LAS float* scr, int lane) {
    f32x4 tv[8];
#pragma unroll
    for (int i = 0; i < 8; ++i) { const int kk = 8 * i + (lane >> 3); tv[i] = *(const f32x4*)(W + (size_t)(k0 + kk) * ldw + c0 + (lane & 7) * 4); }
#pragma unroll
    for (int i = 0; i < 8; ++i) { const int kk = 8 * i + (lane >> 3); LAS float* d = scr + kk * 33 + (lane & 7) * 4; d[0] = tv[i][0]; d[1] = tv[i][1]; d[2] = tv[i][2]; d[3] = tv[i][3]; }
    LDS_WAIT();
    const int c = lane & 7;
#pragma unroll
    for (int j = 0; j < 4; ++j) { const int n = (lane >> 3) + 8 * j; const LAS float* s = scr + (8 * c) * 33 + n;
        u32x4 o; o.x = cvt_pk_bf16(s[0 * 33], s[1 * 33]); o.y = cvt_pk_bf16(s[2 * 33], s[3 * 33]); o.z = cvt_pk_bf16(s[4 * 33], s[5 * 33]); o.w = cvt_pk_bf16(s[6 * 33], s[7 * 33]);
        *(u32x4*)(WT + (size_t)(n0 + n) * K + k0 + 8 * c) = o; }
    LDS_WAIT();
}
__device__ __forceinline__ void phase_prep(const Params& p, int l, LAS unsigned char* lds, const int tid, const int bid, const int nblk) {
    const int lane = tid & 63, wave = tid >> 6;
    unsigned char* ws = p.ws;
    const int gw = bid * 8 + wave, NGW = nblk * 8;
    if (l < 2) {
        LAS float* scr = (LAS float*)(lds + wave * 8448);
        const float* w_in = (const float*)p.in[5] + (size_t)l * 1024 * DIN;
        const float* w_mkv = (const float*)p.in[15] + (size_t)l * 1024 * 1024;
        const float* w_up = (const float*)p.in[16] + (size_t)l * 5 * 512 * 1024;
        const float* w_out = (const float*)p.in[17] + (size_t)l * 1024 * 1024;
        constexpr int I_IN = 16 * 448, I_UP = 5 * 256, I_SQ = 512;
        for (int it = gw; it < I_IN + I_UP + 2 * I_SQ; it += NGW) {
            int r = it;
            if (r < I_IN) { const int kb = r / 448, nb = r % 448, n0 = nb * 32; transpose_item(w_in, DIN, n0 + (n0 >= 4608 ? 8 : 0), kb * 64, (u16*)(ws + OFF_WIN), 1024, n0, scr, lane); continue; }
            r -= I_IN;
            if (r < I_UP) { const int n = r / 256, q = r % 256, kb = q / 32, nb = q % 32; transpose_item(w_up + (size_t)n * 512 * 1024, 1024, nb * 32, kb * 64, (u16*)(ws + OFF_WUP) + (size_t)n * 1024 * 512, 512, nb * 32, scr, lane); continue; }
            r -= I_UP;
            if (r < I_SQ) { const int kb = r / 32, nb = r % 32; transpose_item(w_out, 1024, nb * 32, kb * 64, (u16*)(ws + OFF_WOUT), 1024, nb * 32, scr, lane); continue; }
            r -= I_SQ;
            { const int kb = r / 32, nb = r % 32; transpose_item(w_mkv, 1024, nb * 32, kb * 64, (u16*)(ws + OFF_WMKV), 1024, nb * 32, scr, lane); }
        }
    }
    LAS float* w8 = (LAS float*)(lds + 73728);
    if (l < 2) {
        const float* w_in = (const float*)p.in[5] + (size_t)l * 1024 * DIN;
        for (int i = tid; i < 8192; i += 512) w8[i] = w_in[(size_t)(i >> 3) * DIN + 4608 + (i & 7)];
    }
    __syncthreads();
    const float* xin = (l <= 1) ? (const float*)p.in[0] : (const float*)p.out;
    const float* outf = (const float*)(ws + OFF_OUTF);
    const int nrows = S_ + (l < 2 ? 256 : 0);
    for (int row = gw; row < nrows; row += NGW) {
        if (row < S_) {
            f32x4 v[4];
            const f32x4* xr = (const f32x4*)(xin + (size_t)row * 1024) + lane;
#pragma unroll
            for (int j = 0; j < 4; ++j) v[j] = xr[64 * j];
            if (l > 0) {
                const f32x4* orow = (const f32x4*)(outf + (size_t)row * 1024) + lane; const f32x4* gp = (const f32x4*)((const float*)p.in[4] + (size_t)(l - 1) * 1024) + lane;
                f32x4 o[4]; float ss = 0.f;
#pragma unroll
                for (int j = 0; j < 4; ++j) { o[j] = orow[64 * j]; ss += (o[j][0] * o[j][0] + o[j][1] * o[j][1]) + (o[j][2] * o[j][2] + o[j][3] * o[j][3]); }
                const float rs = rsqrtf(wave_sum(ss) * (1.0f / 1024.0f) + EPS);
                f32x4* dst = (f32x4*)(p.out + (size_t)row * 1024) + lane;
#pragma unroll
                for (int j = 0; j < 4; ++j) { v[j] = v[j] + o[j] * rs * gp[64 * j]; dst[64 * j] = v[j]; }
            }
            if (l < 2) {
                float ss = 0.f;
#pragma unroll
                for (int j = 0; j < 4; ++j) ss += (v[j][0] * v[j][0] + v[j][1] * v[j][1]) + (v[j][2] * v[j][2] + v[j][3] * v[j][3]);
                const float rs = rsqrtf(wave_sum(ss) * (1.0f / 1024.0f) + EPS);
                const f32x4* gp = (const f32x4*)((const float*)p.in[3] + (size_t)l * 1024) + lane;
                u32x2* hrow = (u32x2*)((u16*)(ws + OFF_H) + (size_t)row * 1024) + lane;
                float g8[8];
#pragma unroll
                for (int q = 0; q < 8; ++q) g8[q] = 0.f;
#pragma unroll
                for (int j = 0; j < 4; ++j) { const f32x4 hv = v[j] * rs * gp[64 * j];
                    u32x2 w; w.x = cvt_pk_bf16(hv[0], hv[1]); w.y = cvt_pk_bf16(hv[2], hv[3]); hrow[64 * j] = w;
#pragma unroll
                    for (int i = 0; i < 4; ++i) { const int k = 4 * lane + 256 * j + i; const f32x4 wa = *(const LAS f32x4*)(w8 + k * 8), wb = *(const LAS f32x4*)(w8 + k * 8 + 4);
                        g8[0] += hv[i] * wa[0]; g8[1] += hv[i] * wa[1]; g8[2] += hv[i] * wa[2]; g8[3] += hv[i] * wa[3];
                        g8[4] += hv[i] * wb[0]; g8[5] += hv[i] * wb[1]; g8[6] += hv[i] * wb[2]; g8[7] += hv[i] * wb[3]; } }
#pragma unroll
                for (int q = 0; q < 8; ++q) g8[q] = wave_sum(g8[q]);
                if (lane < 8) { float val = g8[0];
#pragma unroll
                    for (int q = 1; q < 8; ++q) val = (lane == q) ? g8[q] : val;
                    const float bias = (lane < 4) ? ((const float*)p.in[6])[l * 4 + lane] : ((const float*)p.in[7])[l * 4 + lane - 4];
                    ((float*)(ws + OFF_IF))[(size_t)row * 8 + lane] = val + bias; }
            }
        } else {
            const int mr = row - S_;
            const f32x4* xr = (const f32x4*)((const float*)p.in[1] + (size_t)mr * 1024) + lane; const f32x4* gp = (const f32x4*)((const float*)p.in[14] + (size_t)l * 1024) + lane;
            f32x4 v[4]; float ss = 0.f;
#pragma unroll
            for (int j = 0; j < 4; ++j) { v[j] = xr[64 * j]; ss += (v[j][0] * v[j][0] + v[j][1] * v[j][1]) + (v[j][2] * v[j][2] + v[j][3] * v[j][3]); }
            const float rs = rsqrtf(wave_sum(ss) * (1.0f / 1024.0f) + EPS);
            u32x2* hrow = (u32x2*)((u16*)(ws + OFF_MEMH) + (size_t)mr * 1024) + lane;
#pragma unroll
            for (int j = 0; j < 4; ++j) { const f32x4 hv = v[j] * rs * gp[64 * j]; u32x2 w; w.x = cvt_pk_bf16(hv[0], hv[1]); w.y = cvt_pk_bf16(hv[2], hv[3]); hrow[64 * j] = w; }
        }
    }
}

__device__ __forceinline__ void sb_item(const u16* Q, const u16* Kg, const u16* Vg, const u16* ZY, u16* ZW, int qb, int h, LAS unsigned char* lds, const int tid) {
    const int lane = tid & 63, w = tid >> 6, fr = lane & 15, quad = lane >> 4;
    LAS u16* Qs = (LAS u16*)lds;
    LAS u16* Ks = Qs + 128 * 136;
    LAS u16* VT = Ks + 64 * 136;
    LAS int* flg = (LAS int*)(VT + 128 * 72);
    const int q0 = qb * 128;
    u32x4 qpre[4];
#pragma unroll
    for (int i = 0; i < 4; ++i) { const int ch = tid + i * 512, r = ch >> 4, c = ch & 15; qpre[i] = *(const u32x4*)(Q + (size_t)(q0 + r) * 512 + h * 128 + c * 8); }
    u32x4 kreg[2], vreg[2];
#pragma unroll
    for (int i = 0; i < 2; ++i) { const int ch = tid + i * 512, r = ch >> 4, c = ch & 15, c2 = w + 8 * i; const int kt = 2 * qb + 1;
        kreg[i] = *(const u32x4*)(Kg + (size_t)(kt * 64 + r) * 512 + h * 128 + c * 8);
        vreg[i] = *(const u32x4*)(Vg + (size_t)(kt * 4 + h) * 8192 + (size_t)ch * 8); (void)c2; }
    __syncthreads();
#pragma unroll
    for (int i = 0; i < 4; ++i) { const int ch = tid + i * 512, r = ch >> 4, c = ch & 15; *(LAS u32x4*)(Qs + r * 136 + c * 8) = qpre[i]; }
    if (tid < 8) flg[tid] = 0;
    f32x4 o[8];
#pragma unroll
    for (int i = 0; i < 8; ++i) o[i] = (f32x4){0.f, 0.f, 0.f, 0.f};
    float carry = 0.f; int wdone = 0;
    const int tq = q0 + w * 16 + fr;
    for (int kt = 2 * qb + 1; kt >= 0; --kt) {
        __syncthreads();
        int nd = 0;
#pragma unroll
        for (int i = 0; i < 8; ++i) nd += flg[i];
        if (nd == 8) break;
#pragma unroll
        for (int i = 0; i < 2; ++i) { const int ch = tid + i * 512, r = ch >> 4, c = ch & 15;
            *(LAS u32x4*)(Ks + r * 136 + c * 8) = kreg[i];
            st_vt_pair(VT, 72, ch, vreg[i]); }
        __syncthreads();
        if (kt > 0) {
#pragma unroll
            for (int i = 0; i < 2; ++i) { const int ch = tid + i * 512, r = ch >> 4, c = ch & 15, c2 = w + 8 * i;
                kreg[i] = *(const u32x4*)(Kg + (size_t)((kt - 1) * 64 + r) * 512 + h * 128 + c * 8);
                vreg[i] = *(const u32x4*)(Vg + (size_t)((kt - 1) * 4 + h) * 8192 + (size_t)ch * 8); (void)c2; } }
        const int wq0 = q0 + w * 16;
        if (!wdone && kt * 64 < wq0 + 15) {
        const bool full = (kt * 64 + 63 < wq0);
        f32x4 st[4];
#pragma unroll
        for (int i = 0; i < 4; ++i) st[i] = (f32x4){0.f, 0.f, 0.f, 0.f};
#pragma unroll
        for (int ks = 0; ks < 4; ++ks) { const bf16x8 qf = lfrag(Qs, w * 16 + fr, 136, ks * 32 + quad * 8);
#pragma unroll
            for (int mt = 0; mt < 4; ++mt) st[mt] = MFMA16(lfrag(Ks, mt * 16 + fr, 136, ks * 32 + quad * 8), qf, st[mt]); }
        float run = carry; int dead = 0;
#pragma unroll
        for (int mt = 3; mt >= 0; --mt) {
            const int kb = kt * 64 + mt * 16;
            if (dead || kb >= wq0 + 16) { st[mt] = (f32x4){0.f, 0.f, 0.f, 0.f}; }
            else {
                const bool mfull = full || (kb + 15 < wq0);
                float l[4], ls[4], gs = 0.f;
#pragma unroll
                for (int j = 0; j < 4; ++j) { const float zc = __builtin_amdgcn_fmed3f(st[mt][j], -115.0f, 115.0f);
                    const float sp = __builtin_amdgcn_logf(1.0f + __builtin_amdgcn_exp2f(zc));
                    l[j] = -sp; ls[j] = zc - sp;
                    if (!mfull) { const bool valid = (kb + quad * 4 + j) < tq; l[j] = valid ? l[j] : 0.f; ls[j] = valid ? ls[j] : -1e30f; }
                    gs += l[j]; }
                const float g1 = __shfl(gs, ((quad + 1) & 3) * 16 + fr), g2 = __shfl(gs, ((quad + 2) & 3) * 16 + fr), g3 = __shfl(gs, ((quad + 3) & 3) * 16 + fr);
                const float qsuf = (quad < 3 ? g1 : 0.f) + (quad < 2 ? g2 : 0.f) + (quad < 1 ? g3 : 0.f);
                const float b3 = run + qsuf, b2 = b3 + l[3], b1 = b2 + l[2], b0 = b1 + l[1];
                st[mt][3] = __builtin_amdgcn_exp2f(ls[3] + b3); st[mt][2] = __builtin_amdgcn_exp2f(ls[2] + b2); st[mt][1] = __builtin_amdgcn_exp2f(ls[1] + b1); st[mt][0] = __builtin_amdgcn_exp2f(ls[0] + b0);
                run += gs + g1 + g2 + g3;
                dead = __all(run < -151.0f);
            }
        }
        carry = run;
#pragma unroll
        for (int k2 = 0; k2 < 2; ++k2) { const bf16x8 pf = pack_p(st[2 * k2], st[2 * k2 + 1]);
#pragma unroll
            for (int mt = 0; mt < 8; ++mt) o[mt] = MFMA16(lfrag_slot(VT, mt * 16 + fr, 72, k2 * 32, quad), pf, o[mt]); }
        wdone = __all(carry < -151.0f);
        if (lane == 0) flg[w] = wdone ? 1 : 0;
        }
    }
    const u16* zr = ZY + (size_t)tq * 512 + h * 128 + quad * 4; u16* zw = ZW + (size_t)tq * 512 + h * 128 + quad * 4;
#pragma unroll
    for (int mt = 0; mt < 8; ++mt) { const u32x2 z = *(const u32x2*)(zr + mt * 16);
        u32x2 r; r.x = cvt_pk_bf16(o[mt][0] * siluf_(bf_lo(z.x)), o[mt][1] * siluf_(bf_hi(z.x))); r.y = cvt_pk_bf16(o[mt][2] * siluf_(bf_lo(z.y)), o[mt][3] * siluf_(bf_hi(z.y)));
        *(u32x2*)(zw + mt * 16) = r; }
}

__device__ __forceinline__ void ml_chunk_gates(const float ic, const float fp, int lane, float& bcum, float& g) {
    float b = fminf(fp, 0.f) - __logf(1.0f + __expf(-fabsf(fp)));
#pragma unroll
    for (int o = 1; o < 64; o <<= 1) { const float n = __shfl_up(b, o); if (lane >= o) b += n; }
    float x = ic - b;
#pragma unroll
    for (int o = 1; o < 64; o <<= 1) { const float n = __shfl_up(x, o); if (lane >= o) x = fmaxf(x, n); }
    bcum = b; g = b + x;
}
__device__ __forceinline__ void rot_cs(int pos, int i, float& cs, float& sn) {
    const float ang = (float)pos * INVF[i];
    double rev = (double)ang * 0.15915494309189535; rev -= floor(rev);
    const float fr = (float)rev;
    sn = __builtin_amdgcn_sinf(fr); cs = __builtin_amdgcn_cosf(fr);
}
template <bool RT, bool TRANSPOSED>
__device__ __forceinline__ void stage_qk(const u16* X, const float* convw, const int* pos, int c, int h, float scale, const LAS float* scale_row, LAS u16* dst, const int tid) {
    if (!RT) {
#pragma unroll
        for (int i = 0; i < 2; ++i) { const int ch = tid + i * 512; const int l = TRANSPOSED ? (tid & 63) : (ch >> 4), d0 = TRANSPOSED ? ((tid >> 6) + 8 * i) * 8 : (ch & 15) * 8;
            float a[8];
#pragma unroll
            for (int e = 0; e < 8; ++e) a[e] = 0.f;
#pragma unroll
            for (int j = 0; j < 4; ++j) { const int tt = c * 64 + l - 3 + j;
                if (tt >= 0) { const u32x4 v = *(const u32x4*)(X + (size_t)tt * 512 + h * 128 + d0); const f32x4 w0 = *(const f32x4*)(convw + j * 512 + h * 128 + d0), w1 = *(const f32x4*)(convw + j * 512 + h * 128 + d0 + 4);
#pragma unroll
                    for (int e = 0; e < 4; ++e) { a[e] += w0[e] * bfe(v, e); a[4 + e] += w1[e] * bfe(v, 4 + e); } } }
            const float sr = scale * (scale_row ? scale_row[l] : 1.0f);
#pragma unroll
            for (int e = 0; e < 8; ++e) a[e] = siluf_(a[e]) * sr;
            if (TRANSPOSED) st_tr8(dst, 72, d0, l, a);
            else { u32x4 o; o.x = cvt_pk_bf16(a[0], a[1]); o.y = cvt_pk_bf16(a[2], a[3]); o.z = cvt_pk_bf16(a[4], a[5]); o.w = cvt_pk_bf16(a[6], a[7]); *(LAS u32x4*)(dst + l * 136 + d0) = o; } }
    } else {
        const int l = TRANSPOSED ? (tid & 63) : (tid >> 3), d0 = TRANSPOSED ? (tid >> 6) * 8 : (tid & 7) * 8; const int t = c * 64 + l; const int ps = pos[t];
        const u32x4 v1 = *(const u32x4*)(X + (size_t)t * 512 + h * 128 + d0), v2 = *(const u32x4*)(X + (size_t)t * 512 + h * 128 + 64 + d0);
        const float sr = scale * (scale_row ? scale_row[l] : 1.0f);
        float a[8], b[8];
#pragma unroll
        for (int e = 0; e < 8; ++e) { float cs, sn; rot_cs(ps, d0 + e, cs, sn); const float t1 = bfe(v1, e), t2 = bfe(v2, e); a[e] = (t1 * cs - t2 * sn) * sr; b[e] = (t1 * sn + t2 * cs) * sr; }
        if (TRANSPOSED) { st_tr8(dst, 72, d0, l, a); st_tr8(dst, 72, 64 + d0, l, b); }
        else { u32x4 o; o.x = cvt_pk_bf16(a[0], a[1]); o.y = cvt_pk_bf16(a[2], a[3]); o.z = cvt_pk_bf16(a[4], a[5]); o.w = cvt_pk_bf16(a[6], a[7]); *(LAS u32x4*)(dst + l * 136 + d0) = o;
               o.x = cvt_pk_bf16(b[0], b[1]); o.y = cvt_pk_bf16(b[2], b[3]); o.z = cvt_pk_bf16(b[4], b[5]); o.w = cvt_pk_bf16(b[6], b[7]); *(LAS u32x4*)(dst + l * 136 + 64 + d0) = o; }
    }
}
__device__ __forceinline__ void stage_vt(const u16* V, int c, int h, LAS u16* VT, const int tid) {
#pragma unroll
    for (int i = 0; i < 2; ++i) { const int l = tid & 63, d0 = ((tid >> 6) + 8 * i) * 8;
        st_tr8_raw(VT, 72, d0, l, *(const u32x4*)(V + (size_t)(c * 64 + l) * 512 + h * 128 + d0)); }
}

template <bool RT>
__device__ __forceinline__ void kv1_item(const Params& p, int l, int c, int h, LAS unsigned char* lds, const int tid) {
    const int lane = tid & 63, w = tid >> 6, fr = lane & 15, quad = lane >> 4;
    unsigned char* ws = p.ws;
    LAS u16* KWT = (LAS u16*)lds;
    LAS u16* VT = KWT + 128 * 72;
    LAS float* wend = (LAS float*)(VT + 128 * 72);
    const u16* proj = (const u16*)(ws + OFF_PROJ);
    float* SC = (float*)(ws + OFF_SC);
    float ic = 0.f, fpv = 0.f;
    if (!RT && w == 0) { const float* IFg = (const float*)(ws + OFF_IF) + (size_t)(c * 64 + lane) * 8; ic = IFg[h]; fpv = IFg[4 + h]; }
    u32x4 vpre[2];
#pragma unroll
    for (int i = 0; i < 2; ++i) vpre[i] = *(const u32x4*)(proj + (size_t)(RT ? T_RTV : T_MLV) * S_ * 512 + (size_t)(c * 4 + h) * 8192 + (size_t)(tid + i * 512) * 8);
    u32x4 kpre[2][4]; int kpos = 0;
    { const int l_ = tid & 63; const u16* Kb = proj + (size_t)(RT ? T_RTK : T_MLK) * S_ * 512;
      if (!RT) {
#pragma unroll
        for (int i = 0; i < 2; ++i) { const int d0 = ((tid >> 6) + 8 * i) * 8;
#pragma unroll
            for (int j = 0; j < 4; ++j) { const int tt = c * 64 + l_ - 3 + j; kpre[i][j] = (tt >= 0) ? *(const u32x4*)(Kb + (size_t)tt * 512 + h * 128 + d0) : (u32x4){0u, 0u, 0u, 0u}; } }
      } else { const int d0 = (tid >> 6) * 8, t = c * 64 + l_; kpos = ((const int*)p.in[2])[t];
        kpre[0][0] = *(const u32x4*)(Kb + (size_t)t * 512 + h * 128 + d0); kpre[0][1] = *(const u32x4*)(Kb + (size_t)t * 512 + h * 128 + 64 + d0); } }
    __syncthreads();
    if (!RT) { if (w == 0) { float bcum, g; ml_chunk_gates(ic, fpv, lane, bcum, g);
            const float bl = __shfl(bcum, 63), al = __shfl(g, 63);
            wend[lane] = fexp(bl - bcum + ic - al);
            *(float2*)((float*)(ws + OFF_GATES) + ((size_t)h * S_ + c * 64 + lane) * 2) = make_float2(bcum, g);
            if (lane == 0) { SC[h * 256 + c] = bl; SC[1024 + h * 256 + c] = al; } } }
    else { if (tid < 64) wend[tid] = fexp(log_gamma(h) * (float)(63 - tid)); }
    __syncthreads();
    { const int l_ = tid & 63; const float sr = QSCALE * wend[l_];
      if (!RT) { const LAS float* convw = (const LAS float*)(lds + LDS_CONV) + 2048;
#pragma unroll
        for (int i = 0; i < 2; ++i) { const int d0 = ((tid >> 6) + 8 * i) * 8; float a[8];
#pragma unroll
            for (int e = 0; e < 8; ++e) a[e] = 0.f;
#pragma unroll
            for (int j = 0; j < 4; ++j) { const f32x4 w0 = *(const LAS f32x4*)(convw + j * 512 + h * 128 + d0), w1 = *(const LAS f32x4*)(convw + j * 512 + h * 128 + d0 + 4);
#pragma unroll
                for (int e = 0; e < 4; ++e) { a[e] += w0[e] * bfe(kpre[i][j], e); a[4 + e] += w1[e] * bfe(kpre[i][j], 4 + e); } }
#pragma unroll
            for (int e = 0; e < 8; ++e) a[e] = siluf_(a[e]) * sr;
            st_tr8(KWT, 72, d0, l_, a); }
      } else { const int d0 = (tid >> 6) * 8; float a[8], b[8];
#pragma unroll
        for (int e = 0; e < 8; ++e) { float cs, sn; rot_cs(kpos, d0 + e, cs, sn); const float t1 = bfe(kpre[0][0], e), t2 = bfe(kpre[0][1], e); a[e] = (t1 * cs - t2 * sn) * sr; b[e] = (t1 * sn + t2 * cs) * sr; }
        st_tr8(KWT, 72, d0, l_, a); st_tr8(KWT, 72, 64 + d0, l_, b); } }
#pragma unroll
    for (int i = 0; i < 2; ++i) st_vt_pair(VT, 72, tid + i * 512, vpre[i]);
    __syncthreads();
    const int db = (w & 3) * 32, eh = (w >> 2) * 64;
    f32x4 acc[2][4];
#pragma unroll
    for (int a = 0; a < 2; ++a)
#pragma unroll
        for (int b = 0; b < 4; ++b) acc[a][b] = (f32x4){0.f, 0.f, 0.f, 0.f};
#pragma unroll
    for (int ks = 0; ks < 2; ++ks) { bf16x8 af[2], bfr[4];
#pragma unroll
        for (int a = 0; a < 2; ++a) af[a] = lfrag(KWT, db + a * 16 + fr, 72, ks * 32 + quad * 8);
#pragma unroll
        for (int b = 0; b < 4; ++b) bfr[b] = lfrag(VT, eh + b * 16 + fr, 72, ks * 32 + quad * 8);
#pragma unroll
        for (int a = 0; a < 2; ++a)
#pragma unroll
            for (int b = 0; b < 4; ++b) acc[a][b] = MFMA16(af[a], bfr[b], acc[a][b]); }
    u16* ST = (u16*)(ws + OFF_KV) + ((size_t)((RT ? 4 : 0) + h) * 256 + c) * 16384;
#pragma unroll
    for (int a = 0; a < 2; ++a)
#pragma unroll
        for (int b = 0; b < 4; ++b) { const int e = eh + b * 16 + fr, d = db + a * 16 + quad * 4;
            u32x2 r; r.x = cvt_pk_bf16(acc[a][b][0], acc[a][b][1]); r.y = cvt_pk_bf16(acc[a][b][2], acc[a][b][3]); *(u32x2*)(ST + e * 128 + d) = r; }
    if (!RT && tid < 128) { float s = 0.f;
#pragma unroll 8
        for (int i = 0; i < 64; ++i) s += bf2f(KWT[tid * 72 + i]);
        ((float*)(ws + OFF_NST))[((size_t)h * 256 + c) * 128 + tid] = s; }
}

__device__ __forceinline__ void scan_item(const Params& p, LAS unsigned char* lds, const int tid, const int it, const bool dummy) {
    unsigned char* ws = p.ws;
    const float* SC = (const float*)(ws + OFF_SC);
    LAS float* do_s = (LAS float*)lds;
    LAS float* dl_s = do_s + 1024;
    LAS float* mp_s = dl_s + 1024;
    LAS float* bl_s = mp_s + 1024;
    LAS float* al_s = bl_s + 1024;
    __syncthreads();
    for (int i = tid; i < 2048; i += 512) bl_s[i] = SC[i];
    __syncthreads();
    if (tid < 4) { float m = 0.f;
        for (int c0 = 0; c0 < 256; c0 += 16) { float bl[16], al[16], mo[16];
#pragma unroll
            for (int i = 0; i < 16; ++i) { bl[i] = bl_s[tid * 256 + c0 + i]; al[i] = al_s[tid * 256 + c0 + i]; }
#pragma unroll
            for (int i = 0; i < 16; ++i) { mo[i] = m; m = fmaxf(bl[i] + m, al[i]); }
#pragma unroll
            for (int i = 0; i < 16; ++i) { const float mn = fmaxf(bl[i] + mo[i], al[i]);
                do_s[tid * 256 + c0 + i] = fexp(bl[i] + mo[i] - mn); dl_s[tid * 256 + c0 + i] = fexp(al[i] - mn); mp_s[tid * 256 + c0 + i] = mo[i]; } } }
    __syncthreads();
    {
        if (it < 128) {
            const int brh = it >> 4, part = it & 15, br = brh >> 2, h = brh & 3;
            unsigned* base = (unsigned*)(ws + OFF_KV) + (size_t)brh * 256 * 8192 + part * 512 + tid;
            unsigned* wbase = dummy ? (unsigned*)p.out + (size_t)brh * 256 * 8192 + part * 512 + tid : base;
            float s0 = 0.f, s1 = 0.f;
            const float cd = fexp(log_gamma(h) * 64.0f);
            for (int c0 = 0; c0 < 256; c0 += 32) {
                unsigned kv[32];
#pragma unroll
                for (int i = 0; i < 32; ++i) kv[i] = base[(size_t)(c0 + i) * 8192];
#pragma unroll
                for (int i = 0; i < 32; ++i) { const int c = c0 + i;
                    wbase[(size_t)c * 8192] = cvt_pk_bf16(s0, s1);
                    const float dold = (br == 0) ? do_s[h * 256 + c] : cd, dloc = (br == 0) ? dl_s[h * 256 + c] : 1.0f;
                    s0 = dold * s0 + dloc * bf_lo(kv[i]); s1 = dold * s1 + dloc * bf_hi(kv[i]); }
            }
        } else {
            const int h = tid >> 7, d = tid & 127;
            float* NST = (float*)(ws + OFF_NST) + (size_t)h * 256 * 128 + d; float* MP = (float*)(ws + OFF_SC) + 2048;
            for (int i = tid; i < 1024; i += 512) MP[i] = mp_s[i];
            float n = 0.f;
            for (int c0 = 0; c0 < 256; c0 += 16) {
                float nl[16];
#pragma unroll
                for (int i = 0; i < 16; ++i) nl[i] = NST[(c0 + i) * 128];
#pragma unroll
                for (int i = 0; i < 16; ++i) { const int c = c0 + i; if (!dummy) NST[c * 128] = n; n = do_s[h * 256 + c] * n + dl_s[h * 256 + c] * nl[i]; }
            }
        }
    }
}

template <bool RT>
__device__ __forceinline__ void out3_item(const Params& p, int l, int c, int h, LAS unsigned char* lds, const int tid, u16* zwb, const int nc, const int nh) {
    const int lane = tid & 63, w = tid >> 6, fr = lane & 15, quad = lane >> 4;
    unsigned char* ws = p.ws;
    LAS u16* Qs = (LAS u16*)lds;
    LAS u16* Ks = Qs + 64 * 136;
    LAS u16* VT = Ks + 64 * 136;
    LAS u16* STs = VT + 128 * 72;
    LAS float* fs = (LAS float*)(STs + 128 * 136);
    LAS float* rowterm = fs;
    LAS float* colterm = fs + 64;
    LAS float* dinter = fs + 128;
    LAS float* emt = fs + 192;
    LAS float* nprev = fs + 256;
    LAS float* red = fs + 384;
    const u16* proj = (const u16*)(ws + OFF_PROJ);
    float ic = 0.f, mp = 0.f, npv = 0.f;
    float2 bg = make_float2(0.f, 0.f);
    if (!RT) { if (w == 0) { const float* IFg = (const float*)(ws + OFF_IF) + (size_t)(c * 64 + lane) * 8; ic = IFg[h]; mp = ((const float*)(ws + OFF_SC))[2048 + h * 256 + c];
            bg = *(const float2*)((const float*)(ws + OFF_GATES) + ((size_t)h * S_ + c * 64 + lane) * 2); }
        if (tid >= 64 && tid < 192) npv = ((const float*)(ws + OFF_NST))[((size_t)h * 256 + c) * 128 + tid - 64]; }
    u32x4 vpre[2], spre[4];
#pragma unroll
    for (int i = 0; i < 2; ++i) vpre[i] = *(const u32x4*)(proj + (size_t)(RT ? T_RTV : T_MLV) * S_ * 512 + (size_t)(c * 4 + h) * 8192 + (size_t)(tid + i * 512) * 8);
    u32x4 qraw[2][4], kraw[2][4]; int ppos = 0;
    { const u16* Qb = proj + (size_t)(RT ? T_RTQ : T_MLQ) * S_ * 512; const u16* Kb = proj + (size_t)(RT ? T_RTK : T_MLK) * S_ * 512;
      if (!RT) {
        const int l0 = (tid >> 4) * 2, d0 = (tid & 15) * 8;
#pragma unroll
        for (int j = 0; j < 5; ++j) { const int tt = c * 64 + l0 - 3 + j; const size_t go_ = (size_t)tt * 512 + h * 128 + d0;
            qraw[j >> 2][j & 3] = (tt >= 0) ? *(const u32x4*)(Qb + go_) : (u32x4){0u, 0u, 0u, 0u}; kraw[j >> 2][j & 3] = (tt >= 0) ? *(const u32x4*)(Kb + go_) : (u32x4){0u, 0u, 0u, 0u}; }
      } else { const int l_ = tid >> 3, d0 = (tid & 7) * 8, t = c * 64 + l_; ppos = ((const int*)p.in[2])[t]; const size_t go_ = (size_t)t * 512 + h * 128 + d0;
        qraw[0][0] = *(const u32x4*)(Qb + go_); qraw[0][1] = *(const u32x4*)(Qb + go_ + 64); kraw[0][0] = *(const u32x4*)(Kb + go_); kraw[0][1] = *(const u32x4*)(Kb + go_ + 64); } }
    { const u16* ST = (const u16*)(ws + OFF_KV) + ((size_t)((RT ? 4 : 0) + h) * 256 + c) * 16384;
#pragma unroll
      for (int i = 0; i < 4; ++i) { const int ch = tid + i * 512; spre[i] = *(const u32x4*)(ST + (ch >> 4) * 128 + (ch & 15) * 8); } }
    __syncthreads();
    if (!RT) {
        if (w == 0) { const float bcum = bg.x, g = bg.y;
            const float mt = fmaxf(bcum + mp, g);
            rowterm[lane] = bcum - mt; colterm[lane] = ic - bcum; dinter[lane] = fexp(bcum + mp - mt); emt[lane] = fexp(-mt); }
        if (tid >= 64 && tid < 192) nprev[tid - 64] = npv;
        const LAS float* cwq = (const LAS float*)(lds + LDS_CONV); const LAS float* cwk = cwq + 2048;
        const int l0 = (tid >> 4) * 2, d0 = (tid & 15) * 8;
        f32x4 wq[4][2], wk[4][2];
#pragma unroll
        for (int j = 0; j < 4; ++j) { wq[j][0] = *(const LAS f32x4*)(cwq + j * 512 + h * 128 + d0); wq[j][1] = *(const LAS f32x4*)(cwq + j * 512 + h * 128 + d0 + 4);
            wk[j][0] = *(const LAS f32x4*)(cwk + j * 512 + h * 128 + d0); wk[j][1] = *(const LAS f32x4*)(cwk + j * 512 + h * 128 + d0 + 4); }
#pragma unroll
        for (int i = 0; i < 2; ++i) { const int l_ = l0 + i; float a[8], b[8];
#pragma unroll
            for (int e = 0; e < 8; ++e) { a[e] = 0.f; b[e] = 0.f; }
#pragma unroll
            for (int j = 0; j < 4; ++j) { const u32x4 qv = qraw[(i + j) >> 2][(i + j) & 3], kv = kraw[(i + j) >> 2][(i + j) & 3];
#pragma unroll
                for (int e = 0; e < 4; ++e) { a[e] += wq[j][0][e] * bfe(qv, e); a[4 + e] += wq[j][1][e] * bfe(qv, 4 + e); b[e] += wk[j][0][e] * bfe(kv, e); b[4 + e] += wk[j][1][e] * bfe(kv, 4 + e); } }
#pragma unroll
            for (int e = 0; e < 8; ++e) { a[e] = siluf_(a[e]); b[e] = siluf_(b[e]) * QSCALE; }
            u32x4 o; o.x = cvt_pk_bf16(a[0], a[1]); o.y = cvt_pk_bf16(a[2], a[3]); o.z = cvt_pk_bf16(a[4], a[5]); o.w = cvt_pk_bf16(a[6], a[7]); *(LAS u32x4*)(Qs + l_ * 136 + d0) = o;
            o.x = cvt_pk_bf16(b[0], b[1]); o.y = cvt_pk_bf16(b[2], b[3]); o.z = cvt_pk_bf16(b[4], b[5]); o.w = cvt_pk_bf16(b[6], b[7]); *(LAS u32x4*)(Ks + l_ * 136 + d0) = o; }
    } else {
        const int l_ = tid >> 3, d0 = (tid & 7) * 8; float a[8], b[8], a2[8], b2[8];
#pragma unroll
        for (int e = 0; e < 8; ++e) { float cs, sn; rot_cs(ppos, d0 + e, cs, sn);
            const float q1 = bfe(qraw[0][0], e), q2 = bfe(qraw[0][1], e), k1 = bfe(kraw[0][0], e), k2 = bfe(kraw[0][1], e);
            a[e] = q1 * cs - q2 * sn; a2[e] = q1 * sn + q2 * cs; b[e] = (k1 * cs - k2 * sn) * QSCALE; b2[e] = (k1 * sn + k2 * cs) * QSCALE; }
        u32x4 o; o.x = cvt_pk_bf16(a[0], a[1]); o.y = cvt_pk_bf16(a[2], a[3]); o.z = cvt_pk_bf16(a[4], a[5]); o.w = cvt_pk_bf16(a[6], a[7]); *(LAS u32x4*)(Qs + l_ * 136 + d0) = o;
        o.x = cvt_pk_bf16(a2[0], a2[1]); o.y = cvt_pk_bf16(a2[2], a2[3]); o.z = cvt_pk_bf16(a2[4], a2[5]); o.w = cvt_pk_bf16(a2[6], a2[7]); *(LAS u32x4*)(Qs + l_ * 136 + 64 + d0) = o;
        o.x = cvt_pk_bf16(b[0], b[1]); o.y = cvt_pk_bf16(b[2], b[3]); o.z = cvt_pk_bf16(b[4], b[5]); o.w = cvt_pk_bf16(b[6], b[7]); *(LAS u32x4*)(Ks + l_ * 136 + d0) = o;
        o.x = cvt_pk_bf16(b2[0], b2[1]); o.y = cvt_pk_bf16(b2[2], b2[3]); o.z = cvt_pk_bf16(b2[4], b2[5]); o.w = cvt_pk_bf16(b2[6], b2[7]); *(LAS u32x4*)(Ks + l_ * 136 + 64 + d0) = o;
    }
#pragma unroll
    for (int i = 0; i < 2; ++i) st_vt_pair(VT, 72, tid + i * 512, vpre[i]);
#pragma unroll
    for (int i = 0; i < 4; ++i) { const int ch = tid + i * 512; *(LAS u32x4*)(STs + (ch >> 4) * 136 + (ch & 15) * 8) = spre[i]; }
    __syncthreads();
    const int tb = (w & 3) * 16, eh = (w >> 2) * 64;
    const int tl = tb + fr;
    const size_t go = (size_t)(c * 64 + tl) * 512 + h * 128 + eh + quad * 4;
    const u16* zr = (const u16*)(ws + OFF_PROJ) + (size_t)(RT ? T_RTZ : T_MLZ) * S_ * 512 + go; u16* zw = zwb + go;
    const u16* orow = proj + (size_t)T_MLO * S_ * 512 + go;
    u32x2 zpre[4], opre[4];
#pragma unroll
    for (int mt = 0; mt < 4; ++mt) { zpre[mt] = *(const u32x2*)(zr + mt * 16); if (!RT) opre[mt] = *(const u32x2*)(orow + mt * 16); else opre[mt] = zpre[mt]; }
    f32x4 st[4];
#pragma unroll
    for (int i = 0; i < 4; ++i) st[i] = (f32x4){0.f, 0.f, 0.f, 0.f};
    f32x4 oe[4], oi[4];
#pragma unroll
    for (int i = 0; i < 4; ++i) { oe[i] = (f32x4){0.f, 0.f, 0.f, 0.f}; oi[i] = (f32x4){0.f, 0.f, 0.f, 0.f}; }
#pragma unroll
    for (int ks = 0; ks < 4; ++ks) { const bf16x8 qf = lfrag(Qs, tl, 136, ks * 32 + quad * 8);
#pragma unroll
        for (int mt = 0; mt < 4; ++mt) st[mt] = MFMA16(lfrag(Ks, mt * 16 + fr, 136, ks * 32 + quad * 8), qf, st[mt]);
#pragma unroll
        for (int mt = 0; mt < 4; ++mt) oe[mt] = MFMA16(lfrag(STs, eh + mt * 16 + fr, 136, ks * 32 + quad * 8), qf, oe[mt]); }
    float dsum = 0.f;
    const float lg = log_gamma(h);
    const float rt_ = RT ? 0.f : rowterm[tl];
#pragma unroll
    for (int mt = 0; mt < 4; ++mt)
#pragma unroll
        for (int j = 0; j < 4; ++j) { const int s = mt * 16 + quad * 4 + j; float dec;
            if (RT) dec = fexp(lg * fabsf((float)(tl - s)));
            else dec = (s <= tl) ? fexp(rt_ + colterm[s]) : 0.f;
            const float v = st[mt][j] * dec; st[mt][j] = v; dsum += v; }
#pragma unroll
    for (int k2 = 0; k2 < 2; ++k2) { const bf16x8 pf = pack_p(st[2 * k2], st[2 * k2 + 1]);
#pragma unroll
        for (int mt = 0; mt < 4; ++mt) oi[mt] = MFMA16(lfrag_slot(VT, eh + mt * 16 + fr, 72, k2 * 32, quad), pf, oi[mt]); }
    float cin, cden = 1.0f;
    if (!RT) {
        dsum += __shfl_xor(dsum, 16); dsum += __shfl_xor(dsum, 32);
        float qn = 0.f;
#pragma unroll 8
        for (int i = 0; i < 32; ++i) qn += bf2f(Qs[tl * 136 + quad * 32 + i]) * nprev[quad * 32 + i];
        qn += __shfl_xor(qn, 16); qn += __shfl_xor(qn, 32);
        cin = dinter[tl];
        const float den = cin * qn + dsum;
        cden = 1.0f / fmaxf(fabsf(den), emt[tl]);
    } else cin = fexp(lg * (float)(tl + 1));
    float s1 = 0.f, s2 = 0.f;
#pragma unroll
    for (int mt = 0; mt < 4; ++mt)
#pragma unroll
        for (int j = 0; j < 4; ++j) { const float v = (cin * oe[mt][j] + oi[mt][j]) * cden; oi[mt][j] = v; s1 += v; s2 += v * v; }
    s1 += __shfl_xor(s1, 16); s1 += __shfl_xor(s1, 32); s2 += __shfl_xor(s2, 16); s2 += __shfl_xor(s2, 32);
    if (quad == 0) { red[((w >> 2) * 64 + tl) * 2] = s1; red[((w >> 2) * 64 + tl) * 2 + 1] = s2; }
    __syncthreads();
    const float t1 = red[tl * 2] + red[(64 + tl) * 2], t2 = red[tl * 2 + 1] + red[(64 + tl) * 2 + 1];
    const float mu = t1 * (1.0f / 128.0f); const float var = fmaxf(t2 * (1.0f / 128.0f) - mu * mu, 0.f); const float rstd = rsqrtf(var + EPS);
#pragma unroll
    for (int mt = 0; mt < 4; ++mt) { const u32x2 z = zpre[mt];
        float g0 = siluf_(bf_lo(z.x)), g1 = siluf_(bf_hi(z.x)), g2 = siluf_(bf_lo(z.y)), g3 = siluf_(bf_hi(z.y));
        if (!RT) { const u32x2 ov = opre[mt]; g0 *= sigmoidf_(bf_lo(ov.x)); g1 *= sigmoidf_(bf_hi(ov.x)); g2 *= sigmoidf_(bf_lo(ov.y)); g3 *= sigmoidf_(bf_hi(ov.y)); }
        u32x2 r; r.x = cvt_pk_bf16((oi[mt][0] - mu) * rstd * g0, (oi[mt][1] - mu) * rstd * g1); r.y = cvt_pk_bf16((oi[mt][2] - mu) * rstd * g2, (oi[mt][3] - mu) * rstd * g3);
        *(u32x2*)(zw + mt * 16) = r; }
}

__device__ __forceinline__ void gm_item(const Params& p, int l, int nb, LAS unsigned char* lds, const int tid, u16* zwb) {
    const int lane = tid & 63, w = tid >> 6, fr = lane & 15, quad = lane >> 4;
    unsigned char* ws = p.ws;
    LAS u16* Wm = (LAS u16*)lds;
    LAS u16* VNT = Wm + 128 * 136;
    LAS float* mu_s = (LAS float*)(VNT + 128 * 136);
    LAS float* rs_s = mu_s + 128;
    const u16* V = (const u16*)(ws + OFF_PROJ) + (size_t)T_GMV * S_ * 512 + (size_t)nb * 128 * 512;
    __syncthreads();
    { const int r = tid >> 2, part = tid & 3; float s1 = 0.f, s2 = 0.f;
#pragma unroll 8
      for (int i = 0; i < 16; ++i) { const u32x4 v = *(const u32x4*)(V + (size_t)r * 512 + part * 128 + i * 8);
#pragma unroll
          for (int e = 0; e < 8; ++e) { const float x = geluf_(bfe(v, e)); s1 += x; s2 += x * x; } }
      s1 += __shfl_xor(s1, 1); s1 += __shfl_xor(s1, 2); s2 += __shfl_xor(s2, 1); s2 += __shfl_xor(s2, 2);
      if (part == 0) { const float mu = s1 * (1.0f / 512.0f); const float var = fmaxf(s2 * (1.0f / 512.0f) - mu * mu, 0.f); mu_s[r] = mu; rs_s[r] = rsqrtf(var + EPS); } }
    for (int g = 0; g < 4; ++g) {
    if (g) __syncthreads();
    { const float* wsrc = (const float*)p.in[12] + ((size_t)l * 4 + g) * 16384;
#pragma unroll
      for (int i = 0; i < 4; ++i) { const int ch = tid + i * 512, pr = ch >> 4, q0 = (ch & 15) * 8;
          f32x4 a = *(const f32x4*)(wsrc + pr * 128 + q0), b = *(const f32x4*)(wsrc + pr * 128 + q0 + 4);
          if (pr < 64 && q0 >= 64) { a = (f32x4){0.f, 0.f, 0.f, 0.f}; b = a; }
          u32x4 o; o.x = cvt_pk_bf16(a[0], a[1]); o.y = cvt_pk_bf16(a[2], a[3]); o.z = cvt_pk_bf16(b[0], b[1]); o.w = cvt_pk_bf16(b[2], b[3]);
          *(LAS u32x4*)(Wm + pr * 136 + q0) = o; } }
    __syncthreads();
    { const float* lng = (const float*)p.in[10] + l * 512 + g * 128; const float* lnb = (const float*)p.in[11] + l * 512 + g * 128;
#pragma unroll
      for (int i = 0; i < 4; ++i) { const int q = lane + 64 * (i & 1), c0 = (w + 8 * (i >> 1)) * 8;
          const u32x4 v = *(const u32x4*)(V + (size_t)q * 512 + g * 128 + c0); const float mu = mu_s[q], rs = rs_s[q];
          float a[8];
#pragma unroll
          for (int e = 0; e < 8; ++e) a[e] = (geluf_(bfe(v, e)) - mu) * rs * lng[c0 + e] + lnb[c0 + e];
          st_tr8(VNT, 136, c0, q, a); } }
    __syncthreads();
    const int cb = (w & 3) * 32, ph = (w >> 2) * 64;
    u32x2 upre[4][2], zpre[4][2];
#pragma unroll
    for (int b = 0; b < 4; ++b)
#pragma unroll
        for (int a = 0; a < 2; ++a) { const size_t go = (size_t)(nb * 128 + ph + b * 16 + fr) * 512 + g * 128 + cb + a * 16 + quad * 4;
            upre[b][a] = *(const u32x2*)((const u16*)(ws + OFF_PROJ) + (size_t)T_GMU * S_ * 512 + go); zpre[b][a] = *(const u32x2*)((const u16*)(ws + OFF_PROJ) + (size_t)T_GMZ * S_ * 512 + go); }
    f32x4 acc[2][4];
#pragma unroll
    for (int a = 0; a < 2; ++a)
#pragma unroll
        for (int b = 0; b < 4; ++b) acc[a][b] = (f32x4){0.f, 0.f, 0.f, 0.f};
#pragma unroll
    for (int ks = 0; ks < 4; ++ks) { bf16x8 af[2], bfr[4];
#pragma unroll
        for (int a = 0; a < 2; ++a) af[a] = lfrag(VNT, cb + a * 16 + fr, 136, ks * 32 + quad * 8);
#pragma unroll
        for (int b = 0; b < 4; ++b) bfr[b] = lfrag(Wm, ph + b * 16 + fr, 136, ks * 32 + quad * 8);
#pragma unroll
        for (int a = 0; a < 2; ++a)
#pragma unroll
            for (int b = 0; b < 4; ++b) acc[a][b] = MFMA16(af[a], bfr[b], acc[a][b]); }
    const float* bs = (const float*)p.in[13] + ((size_t)l * 4 + g) * 128;
#pragma unroll
    for (int b = 0; b < 4; ++b) { const int pl = ph + b * 16 + fr; const float bias = bs[pl];
#pragma unroll
        for (int a = 0; a < 2; ++a) { const size_t go = (size_t)(nb * 128 + pl) * 512 + g * 128 + cb + a * 16 + quad * 4;
            const u32x2 uv = upre[b][a], z = zpre[b][a];
            u32x2 r; r.x = cvt_pk_bf16(geluf_(bf_lo(uv.x)) * (acc[a][b][0] + bias) * siluf_(bf_lo(z.x)), geluf_(bf_hi(uv.x)) * (acc[a][b][1] + bias) * siluf_(bf_hi(z.x)));
            r.y = cvt_pk_bf16(geluf_(bf_lo(uv.y)) * (acc[a][b][2] + bias) * siluf_(bf_lo(z.y)), geluf_(bf_hi(uv.y)) * (acc[a][b][3] + bias) * siluf_(bf_hi(z.y)));
            *(u32x2*)(zwb + go) = r; } }
    }
}

__device__ __forceinline__ void xa_item(const Params& p, int sb5, int h, LAS unsigned char* lds, const int tid, u16* zwb) {
    const int lane = tid & 63, w = tid >> 6, fr = lane & 15, quad = lane >> 4;
    unsigned char* ws = p.ws;
    LAS u16* KM = (LAS u16*)lds;
    LAS u16* VT = KM + 256 * 136;
    const u16* MKV = (const u16*)(ws + OFF_MKV);
    u32x4 kpre[8], vpre[8];
#pragma unroll
    for (int i = 0; i < 8; ++i) { const int ch = tid + i * 512, r = ch >> 4, c = ch & 15; kpre[i] = *(const u32x4*)(MKV + (size_t)r * 1024 + h * 128 + c * 8); }
#pragma unroll
    for (int i = 0; i < 8; ++i) { const int ch = tid + i * 512; vpre[i] = *(const u32x4*)(MKV + 256 * 1024 + (size_t)(h * 128 + (ch >> 5)) * 256 + (ch & 31) * 8); }
    __syncthreads();
#pragma unroll
    for (int i = 0; i < 8; ++i) { const int ch = tid + i * 512, r = ch >> 4, c = ch & 15; *(LAS u32x4*)(KM + r * 136 + c * 8) = kpre[i]; }
#pragma unroll
    for (int i = 0; i < 8; ++i) { const int ch = tid + i * 512; *(LAS u32x4*)(VT + (ch >> 5) * 264 + (ch & 31) * 8) = vpre[i]; }
    __syncthreads();
#pragma unroll 1
    for (int sub = 0; sub < 4; ++sub) {
        int row = (sb5 * 4 + sub) * 128 + w * 16 + fr;
        asm volatile("" : "+v"(row));
        const u16* Qr = (const u16*)(ws + OFF_PROJ) + (size_t)T_XAQ * S_ * 512 + (size_t)row * 512 + h * 128 + quad * 8;
        bf16x8 qf[4];
#pragma unroll
        for (int ks = 0; ks < 4; ++ks) qf[ks] = *(const bf16x8*)(Qr + ks * 32);
        const size_t zo = (size_t)row * 512 + h * 128 + quad * 4;
        const u16* zr = (const u16*)(ws + OFF_PROJ) + (size_t)T_XAZ * S_ * 512 + zo; u16* zw = zwb + zo;
        u32x2 zpre[8];
#pragma unroll
        for (int mt = 0; mt < 8; ++mt) zpre[mt] = *(const u32x2*)(zr + mt * 16);
        f32x4 st[16];
#pragma unroll
        for (int i = 0; i < 16; ++i) st[i] = (f32x4){0.f, 0.f, 0.f, 0.f};
#pragma unroll
        for (int ks = 0; ks < 4; ++ks) {
#pragma unroll
            for (int mt = 0; mt < 16; ++mt) st[mt] = MFMA16(lfrag(KM, mt * 16 + fr, 136, ks * 32 + quad * 8), qf[ks], st[mt]); }
        float mx = -1e30f;
#pragma unroll
        for (int mt = 0; mt < 16; ++mt)
#pragma unroll
            for (int j = 0; j < 4; ++j) mx = fmaxf(mx, st[mt][j]);
        mx = fmaxf(mx, __shfl_xor(mx, 16)); mx = fmaxf(mx, __shfl_xor(mx, 32));
        float sum = 0.f;
#pragma unroll
        for (int mt = 0; mt < 16; ++mt)
#pragma unroll
            for (int j = 0; j < 4; ++j) { const float e = fexp(st[mt][j] - mx); st[mt][j] = e; sum += e; }
        sum += __shfl_xor(sum, 16); sum += __shfl_xor(sum, 32);
        f32x4 o[8];
#pragma unroll
        for (int i = 0; i < 8; ++i) o[i] = (f32x4){0.f, 0.f, 0.f, 0.f};
#pragma unroll
        for (int k2 = 0; k2 < 8; ++k2) { const bf16x8 pf = pack_p(st[2 * k2], st[2 * k2 + 1]);
#pragma unroll
            for (int mt = 0; mt < 8; ++mt) o[mt] = MFMA16(lfrag_slot(VT, mt * 16 + fr, 264, k2 * 32, quad), pf, o[mt]); }
        const float inv = 1.0f / sum;
#pragma unroll
        for (int mt = 0; mt < 8; ++mt) { const u32x2 z = zpre[mt];
            u32x2 r; r.x = cvt_pk_bf16(o[mt][0] * inv * siluf_(bf_lo(z.x)), o[mt][1] * inv * siluf_(bf_hi(z.x))); r.y = cvt_pk_bf16(o[mt][2] * inv * siluf_(bf_lo(z.y)), o[mt][3] * inv * siluf_(bf_hi(z.y)));
            *(u32x2*)(zw + mt * 16) = r; }
    }
}

__device__ __forceinline__ int q_pop(unsigned* ctr, LAS int* slot, const int tid) {
    __syncthreads();
    if (tid == 0) *slot = (int)__hip_atomic_fetch_add(ctr, 1u, __ATOMIC_RELAXED, __HIP_MEMORY_SCOPE_AGENT);
    __syncthreads();
    return *slot;
}
constexpr int N_PHASES = 17;
#ifdef DUP_MASK
#define DUPREP rep
#else
#define DUPREP 0
#endif
#ifndef P3MASK
#define P3MASK 15
#endif
#ifndef DUPSEL
#define DUPSEL 15
#endif
#ifndef DUP_PHMAX
#define DUP_PHMAX 16
#endif
#ifndef IMASK
#define IMASK 31
#endif
#ifndef PMASK
#define PMASK 127
#endif
__global__ void __launch_bounds__(512) hybrid_fwd(Params p) {
    extern __shared__ __attribute__((aligned(16))) unsigned char lds_raw[];
    LAS unsigned char* lds = (LAS unsigned char*)lds_raw;
    volatile LAS unsigned* xst = (volatile LAS unsigned*)(lds + LDS_CTL);
    LAS int* qslot = (LAS int*)(lds + LDS_CTL + 32);
    if (p.ph_hi - p.ph_lo > 2) { if (threadIdx.x < 4) xst[threadIdx.x] = 0u; __syncthreads();
        const XcdBarrier b0 = xcd_barrier_post((unsigned*)(p.ws + OFF_BAR), xst); if (threadIdx.x == 0) xst[2] = b0.x; }
    for (int ph = p.ph_lo; ph < p.ph_hi; ++ph) {
        if (ph > p.ph_lo) { if (p.ph_hi > 1000) cg::this_grid().sync();
            else { size_t boff = OFF_BAR; asm volatile("" : "+s"(boff)); unsigned* barp = (unsigned*)(p.ws + boff); XcdBarrier xb;     xb.bar = barp; xb.x = xst[2]; xb.st = xst; xcd_barrier(xb); } }
#ifdef DUP_MASK
        for (int rep = 0; rep < ((ph < DUP_PHMAX) ? 1 + ((DUP_MASK >> (ph % 8)) & 1) : 1); ++rep) { if (rep) __syncthreads();
#endif
        int tid = threadIdx.x, bid = blockIdx.x, nblk = gridDim.x; unsigned char* ws = p.ws;
        size_t wso = 0; asm volatile("" : "+v"(tid), "+s"(bid), "+s"(nblk), "+s"(wso)); ws = p.ws + wso;
        Params q = p; q.ws = ws;
#ifdef DUP_MASK
        const bool dummy = (rep == 0) && (((DUP_MASK >> (ph % 8)) & 1) != 0) && ph < DUP_PHMAX;
#else
        const bool dummy = false;
#endif
#define ZW(T) (dummy ? (u16*)p.out : (u16*)(ws + OFF_PROJ) + (size_t)(T) * S_ * 512)
        if (ph == 16) { if (PMASK & 1) phase_prep(q, 2, lds, tid, bid, nblk); continue; }
        const int l = ph / 8, s = ph % 8;
        if (s == 0) { if (PMASK & 1) phase_prep(q, l, lds, tid, bid, nblk); }
        else if (s == 1) { if (PMASK & 2) {
            pg8::Gemm g{(const u16*)(ws + OFF_H), (const u16*)(ws + OFF_WIN), S_, NPROJ, 1024};
            pg8::StaticOrder so; so.init(S_, NPROJ, nblk, bid);
            EpiProj E{(u16*)(ws + OFF_PROJ), (u16*)(ws + OFF_MKV)};
            pg8::gemm_phase<EpiProj, pg8::StaticOrder>(lds, g, so, E, tid);
        } } else if (s == 2) { if (PMASK & 4) { const int tid_ = tid;
            static_assert(OFF_MEMH == OFF_H + 64ull * 256 * 1024 * 2 && OFF_WMKV == OFF_WIN + 70ull * 256 * 1024 * 2, "the mem_kv GEMM addresses MEMH / WMKV as tile (64, 70..73) of the projection GEMM");
            unsigned* ctr = (unsigned*)(ws + OFF_BAR) + XCD_BAR_WORDS + 64 * (2 * l + 4 * DUPREP);
            { LAS float* cw = (LAS float*)(lds + LDS_CONV); const float* cq = (const float*)p.in[8] + (size_t)l * 2048; const float* ck = (const float*)p.in[9] + (size_t)l * 2048;
              for (int i = tid_; i < 2048; i += 512) { cw[i] = cq[i]; cw[2048 + i] = ck[i]; } }
            int it = q_pop(ctr, qslot, tid_);
            while (it < 4 + 2048) {
                int tid = tid_; asm volatile("" : "+v"(tid));
                unsigned nxt = 0; if (tid_ == 0) nxt = __hip_atomic_fetch_add(ctr, 1u, __ATOMIC_RELAXED, __HIP_MEMORY_SCOPE_AGENT);
                if (it < 4) { pg8::Gemm g{(const u16*)(ws + OFF_H), (const u16*)(ws + OFF_WIN), S_, NPROJ, 1024}; OneUnit ou{64, 70 + it, p.ph_hi > 1000 ? 2 : 1};
                    EpiProj E{(u16*)(ws + OFF_PROJ), (u16*)(ws + OFF_MKV)}; pg8::gemm_phase<EpiProj, OneUnit>(lds, g, ou, E, tid);
                    { LAS float* cw = (LAS float*)(lds + LDS_CONV); const float* cq = (const float*)p.in[8] + (size_t)l * 2048; const float* ck = (const float*)p.in[9] + (size_t)l * 2048;
                      for (int i = tid_; i < 2048; i += 512) { cw[i] = cq[i]; cw[2048 + i] = ck[i]; } } }
                else if (it < 4 + 1024) { const int j = it - 4; kv1_item<false>(q, l, j >> 2, j & 3, lds, tid); }
                else { const int j = it - 4 - 1024; kv1_item<true>(q, l, j >> 2, j & 3, lds, tid); }
                __syncthreads(); if (tid_ == 0) *qslot = (int)nxt; __syncthreads(); it = *qslot;
            }
        } } else if (s == 3) { if (PMASK & 8) { const int tid_ = tid;
            const u16* proj = (const u16*)(ws + OFF_PROJ);
            unsigned* ctr = (unsigned*)(ws + OFF_BAR) + XCD_BAR_WORDS + 64 * (2 * l + 1 + 4 * DUPREP);
            int it = q_pop(ctr, qslot, tid_);
            while (it < 129 + 128 + 512 + 128) {
                int tid = tid_; asm volatile("" : "+v"(tid));
                unsigned nxt = 0; if (tid_ == 0) nxt = __hip_atomic_fetch_add(ctr, 1u, __ATOMIC_RELAXED, __HIP_MEMORY_SCOPE_AGENT);
                if (it < 129) { if ((P3MASK & 1) && (!dummy || (DUPSEL & 1))) scan_item(q, lds, tid, it, dummy); }
                else if (it < 129 + 128) { const int j = it - 129; if ((P3MASK & 8) && (!dummy || (DUPSEL & 8))) xa_item(q, j >> 2, j & 3, lds, tid, ZW(T_XAZ)); }
                else if (it < 129 + 256) { if ((P3MASK & 2) && (!dummy || (DUPSEL & 2))) gm_item(q, l, it - 257, lds, tid, ZW(T_GMZ)); }
                else { const int j = it - 385; if ((P3MASK & 4) && (!dummy || (DUPSEL & 4))) sb_item(proj + (size_t)T_SBQ * S_ * 512, proj + (size_t)T_SBK * S_ * 512, proj + (size_t)T_SBV * S_ * 512, proj + (size_t)T_SBZ * S_ * 512, ZW(T_SBZ), j >> 2, j & 3, lds, tid); }
                __syncthreads(); if (tid_ == 0) *qslot = (int)nxt; __syncthreads(); it = *qslot;
            }
        } }
        else if (s == 4) { if (PMASK & 16) { const int tid_ = tid;
            { LAS float* cw = (LAS float*)(lds + LDS_CONV); const float* cq = (const float*)p.in[8] + (size_t)l * 2048; const float* ck = (const float*)p.in[9] + (size_t)l * 2048;
              for (int i = tid_; i < 2048; i += 512) { cw[i] = cq[i]; cw[2048 + i] = ck[i]; } __syncthreads(); }
            for (int it = bid; it < 2048; it += nblk) {
                int tid = tid_; asm volatile("" : "+v"(tid));
                const int itn = it + nblk; const bool same = (itn < 2048) && ((itn < 1024) == (it < 1024)); const int jn = itn < 1024 ? itn : itn - 1024;
                if (it < 1024) { if (!dummy || (DUPSEL & 1)) out3_item<false>(q, l, it >> 2, it & 3, lds, tid, ZW(T_MLZ), same ? (jn >> 2) : -1, jn & 3); }
                else { const int j = it - 1024; if (!dummy || (DUPSEL & 2)) out3_item<true>(q, l, j >> 2, j & 3, lds, tid, ZW(T_RTZ), same ? (jn >> 2) : -1, jn & 3); }
            }
        } } else if (s == 5) { if (PMASK & 32) {
            pg8::Gemm g{(const u16*)(ws + OFF_H), (const u16*)(ws + OFF_WIN) + (size_t)NPROJ * 1024, S_, 5120, 1024};
            pg8::StaticOrder so; so.init(S_, 5120, nblk, bid);
            EpiGateE E{(u16*)(ws + OFF_PROJ)};
            pg8::gemm_phase<EpiGateE, pg8::StaticOrder>(lds, g, so, E, tid);
        } } else if (s == 6) { if (PMASK & 32) {
            pg8::Gemm g{(const u16*)(ws + OFF_PROJ), (const u16*)(ws + OFF_WUP), S_, 1024, 512};
            UpOrder so; so.init(S_, 1024, nblk, bid);
            EpiMerge E{(const u16*)(ws + OFF_PROJ), (u16*)(ws + OFF_MERGED)};
            pg8::gemm_phase<EpiMerge, UpOrder>(lds, g, so, E, tid);
        } } else { if (PMASK & 64) {
            pg8::Gemm g{(const u16*)(ws + OFF_MERGED), (const u16*)(ws + OFF_WOUT), S_, 1024, 1024};
            pg8::StaticOrder so; so.init(S_, 1024, nblk, bid);
            EpiF32 E{(float*)(ws + OFF_OUTF), 1024};
            pg8::gemm_phase<EpiF32, pg8::StaticOrder>(lds, g, so, E, tid);
        } }
#ifdef DUP_MASK
        }
#endif
    }
}

#ifdef DBG_K
__global__ void dbg_dump(const unsigned* ws, float* out, size_t nwords, int n) {
    for (int i = blockIdx.x * blockDim.x + threadIdx.x; i < n; i += gridDim.x * blockDim.x) {
        unsigned s = 0; for (size_t k = i; k < nwords; k += (size_t)n) s += ws[k] * 2654435761u + (ws[k] >> 16);
        out[i] = (float)(s & 0xFFFFFu); }
}
#endif
extern "C" void kernel_launch(void* const* d_in, const int* in_sizes, int n_in, void* d_out, int out_size, void* d_ws, size_t ws_size, hipStream_t stream) {
    static int grid = 0;
    if (grid == 0) {
        if (n_in != 18 || out_size != S_ * DM || ws_size < WS_END) { fprintf(stderr, "kernel_launch: unexpected shapes / workspace (%d inputs, out %d, ws %zu < %zu)\n", n_in, out_size, ws_size, (size_t)WS_END); grid = -1; return; }
        int dev = 0, cus = 0, per_cu = 0;
        (void)hipGetDevice(&dev); (void)hipDeviceGetAttribute(&cus, hipDeviceAttributeMultiprocessorCount, dev);
        if (hipFuncSetAttribute((const void*)hybrid_fwd, hipFuncAttributeMaxDynamicSharedMemorySize, LDS_BYTES) != hipSuccess) { fprintf(stderr, "kernel_launch: hipFuncSetAttribute failed\n"); grid = -1; return; }
        if (hipOccupancyMaxActiveBlocksPerMultiprocessor(&per_cu, (const void*)hybrid_fwd, 512, LDS_BYTES) != hipSuccess || per_cu < 1) per_cu = 1;
        (void)hipGetLastError();
        grid = cus * per_cu; if (grid > 256) grid = 256; if (grid < 4) grid = 4;
    }
    if (grid < 0) return;
    (void)hipMemsetAsync((unsigned char*)d_ws + OFF_BAR, 0, 16384, stream);
    Params p{};
    for (int i = 0; i < 18; ++i) p.in[i] = d_in[i];
    p.out = (float*)d_out; p.ws = (unsigned char*)d_ws;
#if ONE_LAUNCH
    p.ph_lo = 0; p.ph_hi = N_PHASES;
    void* args[] = {&p};
    hipError_t e = hipLaunchCooperativeKernel((const void*)hybrid_fwd, dim3(grid), dim3(512), args, LDS_BYTES, stream);
    if (e != hipSuccess) fprintf(stderr, "cooperative launch failed: %s (grid %d)\n", hipGetErrorString(e), grid);
#else
#ifdef DBG_K
    for (int ph = 0; ph < DBG_K; ++ph) { p.ph_lo = ph; p.ph_hi = ph + 1; hipLaunchKernelGGL(hybrid_fwd, dim3(grid), dim3(512), LDS_BYTES, stream, p); }
    hipLaunchKernelGGL(dbg_dump, dim3(2048), dim3(256), 0, stream, (const unsigned*)d_ws, (float*)d_out, (size_t)(WS_END / 4), out_size);
#else
    for (int ph = 0; ph < N_PHASES; ++ph) { p.ph_lo = ph; p.ph_hi = ph + 1; hipLaunchKernelGGL(hybrid_fwd, dim3(grid), dim3(512), LDS_BYTES, stream, p); }
#endif
#endif
}
```

```cpp
#include <hip/hip_runtime.h>
#include <hip/hip_cooperative_groups.h>
#include <cstdio>
namespace cg = cooperative_groups;
#ifndef ONE_LAUNCH
#define ONE_LAUNCH 1
#endif
namespace pg8 {
#define PG8_LAS __attribute__((address_space(3)))
typedef unsigned short bf16_t;
typedef short bf16x8 __attribute__((ext_vector_type(8)));
typedef float f32x4 __attribute__((ext_vector_type(4)));
typedef unsigned u32x4 __attribute__((ext_vector_type(4)));
constexpr int BM = 256, BK = 64, HALF = 128, HTB = HALF * BK * 2  , STAGE_BYTES = 8 * HTB, NXCD = 8, WGM = 8;

__host__ __device__ __forceinline__ int lds_byte(int r, int c) { const int st = (r >> 4) * 2 + (c >> 5), rr = r & 15, cc = c & 31, ob = rr * 64 + cc * 2; return st * 1024 + (ob ^ (((ob >> 9) & 1) << 5)); }
__host__ __device__ __forceinline__ void stage_rc(int b, int& R, int& C) { const int st = b / 1024, sb = b % 1024, swz = sb ^ (((sb >> 9) & 1) << 5); R = (st >> 1) * 16 + swz / 64; C = (st & 1) * 32 + (swz % 64) / 2; }
__host__ __device__ __forceinline__ int perm32(int rho) { const int n = rho >> 4, i = rho & 15; return 8 * (i >> 2) + 4 * n + (i & 3); }

struct Unit { int pm, pn, n; };
struct Gemm { const bf16_t* A; const bf16_t* Bt; int M, N, K; };

struct StaticOrder {
    int nM, nN, nwg, G, c;
    __host__ __device__ __forceinline__ void init(int M, int N, int G_, int c_) { nM = M / BM; nN = N / BM; nwg = nM * nN; G = G_; c = c_; }
    __host__ __device__ __forceinline__ bool next(int i, Unit& u) const {
        const long L = (long)i * G + c; if (L >= nwg) return false;
        int wgid = (int)L; { const int q = nwg / NXCD, r = nwg % NXCD, xcd = wgid % NXCD, off = wgid / NXCD; wgid = (xcd < r ? xcd * (q + 1) : r * (q + 1) + (xcd - r) * q) + off; }
        const int nig = WGM * nN, gid = wgid / nig, fm = gid * WGM, gsz = (nM - fm) < WGM ? (nM - fm) : WGM;
        u.pm = fm + ((wgid % nig) % gsz); u.pn = (wgid % nig) / gsz; return true;
    }
    __device__ __forceinline__ void a_ready(const Unit&) const {}
    __device__ __forceinline__ void done(const Unit&) const {}
    __device__ __forceinline__ const char* abase(const Gemm& g, const Unit& u, size_t tstep) const { return (const char*)g.A + (size_t)u.pm * tstep; }
    __device__ __forceinline__ const char* bbase(const Gemm& g, const Unit& u, size_t tstep) const { return (const char*)g.Bt + (size_t)u.pn * tstep; }
};

typedef __bf16 bf16v2_t __attribute__((ext_vector_type(2)));
typedef float f32v2_t __attribute__((ext_vector_type(2)));
__device__ __forceinline__ unsigned cvt_pk_bf16(float lo, float hi) { const f32v2_t v = {lo, hi}; const bf16v2_t r = __builtin_convertvector(v, bf16v2_t); return __builtin_bit_cast(unsigned, r); }
template <class Epi, class Sched, bool ALIGN_EPI = true, bool SP2 = true>
__device__ __forceinline__ void gemm_phase(PG8_LAS unsigned char* lds, const Gemm g, const Sched& S, const Epi& E, const int tid) {
    const int wid = __builtin_amdgcn_readfirstlane(tid >> 6), lane = tid & 63, wr = wid >> 2, wc = wid & 3, fr = lane & 15, fq = lane >> 4;
    const int K = g.K, nt = K / BK;
    unsigned voffA[2], voffB[2];
#pragma unroll
    for (int i = 0; i < 2; ++i) { int R, C; stage_rc(tid * 16 + i * 8192, R, C); const int Rb = Epi::PERM ? ((R & ~31) + perm32(R & 31)) : R;
        voffA[i] = (unsigned)(R * K + C) * 2u; voffB[i] = (unsigned)(Rb * K + C) * 2u; }
    const size_t kstep = (size_t)(BK * 2);
    const size_t hstep = (size_t)HALF * K * 2;
    const size_t tstep = 2 * hstep;
    const unsigned ldsw = (unsigned)wid * 1024u;
    const int aoff = lds_byte(wr * 64 + fr, fq * 8), boff = lds_byte(wc * 32 + fr, fq * 8);
#define PG8_SA(b, h) (((b) * 2 + (h)) * HTB)
#define PG8_SB(b, h) ((4 + (b) * 2 + (h)) * HTB)
#define PG8_STAGE(bufoff, gbase, voff) do { _Pragma("unroll") for (int _i = 0; _i < 2; ++_i) \
        __builtin_amdgcn_global_load_lds((const unsigned*)((const char*)(gbase) + (voff)[_i]), (PG8_LAS unsigned*)(lds + (bufoff) + ldsw + _i * 8192), 16, 0, 0); } while (0)
#define PG8_LDA(dst, b, h) do { _Pragma("unroll") for (int m = 0; m < 4; ++m) _Pragma("unroll") for (int k = 0; k < 2; ++k) dst[m][k] = *(const PG8_LAS bf16x8*)(lds + PG8_SA(b, h) + aoff + m * 2048 + k * 1024); } while (0)
#define PG8_LDB(dst, b, h) do { _Pragma("unroll") for (int n = 0; n < 2; ++n) _Pragma("unroll") for (int k = 0; k < 2; ++k) dst[n][k] = *(const PG8_LAS bf16x8*)(lds + PG8_SB(b, h) + boff + n * 2048 + k * 1024); } while (0)
#define PG8_MMA(ai, bj, At, Bt) do { __builtin_amdgcn_s_setprio(1); _Pragma("unroll") for (int m = 0; m < 4; ++m) _Pragma("unroll") for (int n = 0; n < 2; ++n) _Pragma("unroll") for (int k = 0; k < 2; ++k) \
        acc[ai][bj][m][n] = __builtin_amdgcn_mfma_f32_16x16x32_bf16(Bt[n][k], At[m][k], acc[ai][bj][m][n], 0, 0, 0); __builtin_amdgcn_s_setprio(0); } while (0)
#define PG8_WAIT_V(n) asm volatile("s_waitcnt vmcnt(" #n ")" ::: "memory")
#define PG8_WAIT_L(n) asm volatile("s_waitcnt lgkmcnt(" #n ")" ::: "memory")
#define PG8_BAR __builtin_amdgcn_s_barrier()
#define PG8_SCHED __builtin_amdgcn_sched_barrier(0)
    Unit cur, nxt; int ui = 0;
    if (!S.next(0, cur)) return;
    f32x4 acc[2][2][4][2];
#pragma unroll
    for (int a = 0; a < 2; ++a)
#pragma unroll
        for (int b = 0; b < 2; ++b)
#pragma unroll
            for (int m = 0; m < 4; ++m)
#pragma unroll
                for (int n = 0; n < 2; ++n) acc[a][b][m][n] = (f32x4){0.f, 0.f, 0.f, 0.f};
    bf16x8 At[4][2], B0[2][2], B1[2][2];
    const char* cA = S.abase(g, cur, tstep); const char* cB = S.bbase(g, cur, tstep);
    S.a_ready(cur);
    if constexpr (SP2) {
        PG8_STAGE(PG8_SB(0, 0), cB, voffB); PG8_STAGE(PG8_SB(0, 1), cB + hstep, voffB); PG8_STAGE(PG8_SA(0, 0), cA, voffA); PG8_STAGE(PG8_SA(0, 1), cA + hstep, voffA);
        if (wr == 1) PG8_BAR;
        PG8_WAIT_V(2); PG8_BAR;
        PG8_STAGE(PG8_SB(1, 0), cB + kstep, voffB); PG8_STAGE(PG8_SA(1, 0), cA + kstep, voffA); PG8_STAGE(PG8_SB(1, 1), cB + hstep + kstep, voffB);
        PG8_WAIT_V(6); PG8_BAR;
    } else {
        PG8_STAGE(PG8_SB(0, 0), cB, voffB); PG8_STAGE(PG8_SA(0, 0), cA, voffA); PG8_STAGE(PG8_SB(0, 1), cB + hstep, voffB); PG8_STAGE(PG8_SA(0, 1), cA + hstep, voffA);
        if (wr == 1) PG8_BAR;
        PG8_WAIT_V(4); PG8_BAR;
        PG8_STAGE(PG8_SB(1, 0), cB + kstep, voffB); PG8_STAGE(PG8_SA(1, 0), cA + kstep, voffA); PG8_STAGE(PG8_SB(1, 1), cB + hstep + kstep, voffB);
        PG8_WAIT_V(6); PG8_BAR;
    }
    for (;;) {
        const bool has_next = S.next(ui + 1, nxt);
        const char* nA = has_next ? S.abase(g, nxt, tstep) : cA; const char* nB = has_next ? S.bbase(g, nxt, tstep) : cB;
        for (int t = 0; t < nt; t += 2) {
            const bool last = (t == nt - 2);
            const char* a1 = cA + (size_t)(t + 1) * kstep;
            const char* a2 = last ? nA : cA + (size_t)(t + 2) * kstep; const char* b2 = last ? nB : cB + (size_t)(t + 2) * kstep;
            const char* a3 = a2 + kstep; const char* b3 = b2 + kstep;
            if (last && has_next) S.a_ready(nxt);
            if constexpr (SP2) {
            PG8_LDB(B0, 0, 0); PG8_LDB(B1, 0, 1); PG8_SCHED; PG8_LDA(At, 0, 0); PG8_STAGE(PG8_SA(1, 1), a1 + hstep, voffA);
            PG8_WAIT_V(8); PG8_WAIT_L(0); PG8_BAR; PG8_MMA(0, 0, At, B0); PG8_MMA(0, 1, At, B1); PG8_BAR; PG8_SCHED;
            PG8_LDA(At, 0, 1); PG8_STAGE(PG8_SB(0, 0), b2, voffB); PG8_STAGE(PG8_SB(0, 1), b2 + hstep, voffB); PG8_STAGE(PG8_SA(0, 0), a2, voffA);
            PG8_WAIT_V(8); PG8_WAIT_L(0); PG8_BAR; PG8_MMA(1, 0, At, B0); PG8_MMA(1, 1, At, B1); PG8_BAR; PG8_SCHED;
            PG8_LDB(B0, 1, 0); PG8_LDB(B1, 1, 1); PG8_SCHED; PG8_LDA(At, 1, 0); PG8_STAGE(PG8_SA(0, 1), a2 + hstep, voffA);
            PG8_WAIT_V(8); PG8_WAIT_L(0); PG8_BAR; PG8_MMA(0, 0, At, B0); PG8_MMA(0, 1, At, B1); PG8_BAR; PG8_SCHED;
            PG8_LDA(At, 1, 1); PG8_STAGE(PG8_SB(1, 0), b3, voffB); PG8_STAGE(PG8_SB(1, 1), b3 + hstep, voffB); PG8_STAGE(PG8_SA(1, 0), a3, voffA);
            PG8_WAIT_V(8); PG8_WAIT_L(0); PG8_BAR; PG8_MMA(1, 0, At, B0); PG8_MMA(1, 1, At, B1); PG8_BAR; PG8_SCHED;
            } else {
            PG8_LDB(B0, 0, 0); PG8_SCHED; PG8_LDA(At, 0, 0); PG8_STAGE(PG8_SA(1, 1), a1 + hstep, voffA);
            PG8_WAIT_L(8); PG8_BAR; PG8_WAIT_L(0); PG8_MMA(0, 0, At, B0); PG8_BAR; PG8_SCHED;
            PG8_LDB(B1, 0, 1); PG8_STAGE(PG8_SB(0, 0), b2, voffB);
            PG8_BAR; PG8_WAIT_L(0); PG8_MMA(0, 1, At, B1); PG8_BAR;
            PG8_LDA(At, 0, 1); PG8_STAGE(PG8_SA(0, 0), a2, voffA);
            PG8_BAR; PG8_WAIT_L(0); PG8_MMA(1, 0, At, B0); PG8_BAR; PG8_SCHED;
            PG8_STAGE(PG8_SB(0, 1), b2 + hstep, voffB);
            PG8_WAIT_V(6); PG8_BAR; PG8_MMA(1, 1, At, B1); PG8_BAR;
            PG8_LDB(B0, 1, 0); PG8_SCHED; PG8_LDA(At, 1, 0); PG8_STAGE(PG8_SA(0, 1), a2 + hstep, voffA);
            PG8_WAIT_L(8); PG8_BAR; PG8_WAIT_L(0); PG8_MMA(0, 0, At, B0); PG8_BAR; PG8_SCHED;
            PG8_LDB(B1, 1, 1); PG8_STAGE(PG8_SB(1, 0), b3, voffB);
            PG8_BAR; PG8_WAIT_L(0); PG8_MMA(0, 1, At, B1); PG8_BAR;
            PG8_LDA(At, 1, 1); PG8_STAGE(PG8_SA(1, 0), a3, voffA);
            PG8_BAR; PG8_WAIT_L(0); PG8_MMA(1, 0, At, B0); PG8_BAR; PG8_SCHED;
            PG8_STAGE(PG8_SB(1, 1), b3 + hstep, voffB);
            PG8_WAIT_V(6); PG8_BAR; PG8_MMA(1, 1, At, B1); PG8_BAR;
            }
        }
        if constexpr (ALIGN_EPI) { if (wr == 0) PG8_BAR; }
        if constexpr (!Epi::AFTER_DRAIN) { E(acc, cur, wr, wc, fr, fq); S.done(cur); }
        if (!has_next) break;
        bool zero_acc = true;
        if constexpr (Epi::KEEPS) zero_acc = !E.keep(cur);
        if (zero_acc) {
#pragma unroll
        for (int a = 0; a < 2; ++a)
#pragma unroll
            for (int b = 0; b < 2; ++b)
#pragma unroll
                for (int m = 0; m < 4; ++m)
#pragma unroll
                    for (int n = 0; n < 2; ++n) acc[a][b][m][n] = (f32x4){0.f, 0.f, 0.f, 0.f};
        }
        cur = nxt; cA = nA; cB = nB; ++ui;
        if constexpr (ALIGN_EPI) { if (wr == 1) PG8_BAR; }
    }
    PG8_WAIT_V(0);
    if constexpr (!ALIGN_EPI) { if (wr == 0) PG8_BAR; }
    PG8_BAR;
    if constexpr (Epi::AFTER_DRAIN) { E.fused(acc, cur, wr, wc, fr, fq, lds, wid, lane); S.done(cur); }
#undef PG8_SA
#undef PG8_SB
#undef PG8_STAGE
#undef PG8_LDA
#undef PG8_LDB
#undef PG8_MMA
#undef PG8_WAIT_V
#undef PG8_WAIT_L
#undef PG8_BAR
#undef PG8_SCHED
}
}

#define LAS __attribute__((address_space(3)))
typedef unsigned short u16;
typedef short bf16x8 __attribute__((ext_vector_type(8)));
typedef short s16x4 __attribute__((ext_vector_type(4)));
typedef float f32x4 __attribute__((ext_vector_type(4)));
typedef unsigned u32x4 __attribute__((ext_vector_type(4)));
typedef unsigned u32x2 __attribute__((ext_vector_type(2)));
using pg8::cvt_pk_bf16;

constexpr int S_ = 16384, DM = 1024, BW = 512, HD = 128, NCH = 256, DIN = 14344;
constexpr int NPROJ = 9216, NWIN = 14336;
constexpr float EPS = 1e-6f;
constexpr float QSCALE = 0.08838834764831845f;
constexpr int LDS_BYTES = 147456, LDS_CTL = LDS_BYTES - 64;

constexpr size_t OFF_WIN = 0;
constexpr size_t SZ_WIN = (size_t)NWIN * 1024 * 2;
constexpr size_t OFF_WUP = OFF_WIN + SZ_WIN;
constexpr size_t SZ_WUP = 5ull * 1024 * 512 * 2;
constexpr size_t OFF_WOUT = OFF_WUP + SZ_WUP;
constexpr size_t SZ_WSQ = 1024ull * 1024 * 2;
constexpr size_t OFF_WMKV = OFF_WOUT + SZ_WSQ;
constexpr size_t OFF_H = OFF_WMKV + SZ_WSQ;
constexpr size_t SZ_H = (size_t)S_ * 1024 * 2;
constexpr size_t OFF_MEMH = OFF_H + SZ_H;
constexpr size_t OFF_MKV = OFF_MEMH + 256 * 1024 * 2;
constexpr size_t OFF_IF = OFF_MKV + 256 * 1024 * 2 + 512 * 256 * 2;
constexpr size_t OFF_SC = OFF_IF + (size_t)S_ * 8 * 4;
constexpr size_t OFF_NST = OFF_SC + 3 * 4 * 256 * 4;
constexpr size_t OFF_PROJ = OFF_NST + 4 * 256 * 128 * 4;
constexpr size_t SZ_T = (size_t)S_ * 512 * 2;
constexpr size_t OFF_KV = OFF_PROJ + 18 * SZ_T;
constexpr size_t SZ_KV = 2ull * 4 * 256 * 128 * 128 * 2;
constexpr size_t OFF_BAR = OFF_KV + SZ_KV;
constexpr size_t OFF_GATES = OFF_BAR + 16384;
constexpr size_t WS_END = OFF_GATES + 4ull * 16384 * 2 * 4;
constexpr int LDS_CONV = 98304;
constexpr size_t OFF_MERGED = OFF_KV;
constexpr size_t OFF_MSCR = OFF_PROJ + 4 * SZ_T;
constexpr size_t OFF_GSCR = OFF_PROJ + 9 * SZ_T;
constexpr size_t OFF_OUTF = OFF_PROJ + 4 * SZ_T;
static_assert(OFF_PROJ % 256 == 0 && OFF_KV % 256 == 0, "align");

enum { T_SBQ = 0, T_SBK, T_SBV, T_SBZ, T_MLQ, T_MLK, T_MLV, T_MLO, T_MLZ, T_GMU, T_GMV, T_GMZ, T_RTQ, T_RTK, T_RTV, T_RTZ, T_XAQ, T_XAZ };

__device__ const float INVF[64] = {
1.000000000e+00f, 8.659643531e-01f, 7.498942614e-01f, 6.493816376e-01f, 5.623413324e-01f, 4.869675338e-01f, 4.216965139e-01f, 3.651741147e-01f, 3.162277639e-01f, 2.738419771e-01f, 2.371373773e-01f, 2.053525001e-01f, 1.778279394e-01f, 1.539926529e-01f, 1.333521307e-01f, 1.154782027e-01f, 1.000000015e-01f, 8.659642935e-02f, 7.498941571e-02f, 6.493816525e-02f, 5.623413250e-02f, 4.869675264e-02f, 4.216965288e-02f, 3.651741147e-02f, 3.162277490e-02f, 2.738419734e-02f, 2.371373773e-02f, 2.053525113e-02f, 1.778279431e-02f, 1.539926510e-02f, 1.333521493e-02f, 1.154782064e-02f, 9.999999776e-03f, 8.659643121e-03f, 7.498941850e-03f, 6.493816152e-03f, 5.623413250e-03f, 4.869675264e-03f, 4.216964822e-03f, 3.651741194e-03f, 3.162277630e-03f, 2.738419687e-03f, 2.371373586e-03f, 2.053524833e-03f, 1.778279431e-03f, 1.539926510e-03f, 1.333521446e-03f, 1.154781901e-03f, 1.000000047e-03f, 8.659643354e-04f, 7.498942432e-04f, 6.493816618e-04f, 5.623413017e-04f, 4.869675322e-04f, 4.216965172e-04f, 3.651741426e-04f, 3.162277571e-04f, 2.738419571e-04f, 2.371373703e-04f, 2.053525095e-04f, 1.778279402e-04f, 1.539926452e-04f, 1.333521504e-04f, 1.154782003e-04f };
__device__ __forceinline__ float log_gamma(int h) { return h == 0 ? -3.174869716e-02f : h == 1 ? -1.574835740e-02f : h == 2 ? -7.843177766e-03f : -3.913899418e-03f; }

struct Params { const void* in[18]; float* out; unsigned char* ws; int ph_lo, ph_hi; };

__device__ __forceinline__ float bf_lo(unsigned w) { return __uint_as_float(w << 16); }
__device__ __forceinline__ float bf_hi(unsigned w) { return __uint_as_float(w & 0xffff0000u); }
__device__ __forceinline__ float bf2f(u16 b) { return __uint_as_float(((unsigned)b) << 16); }
__device__ __forceinline__ float fexp(float x) { return __expf(x); }
__device__ __forceinline__ float sigmoidf_(float x) { return __builtin_amdgcn_rcpf(1.0f + __expf(-x)); }
__device__ __forceinline__ float siluf_(float x) { return x * __builtin_amdgcn_rcpf(1.0f + __expf(-x)); }
__device__ __forceinline__ float geluf_(float v) { return v * sigmoidf_(1.5957691216057308f * (v + 0.044715f * v * v * v)); }
__device__ __forceinline__ float softplusf_(float z) { return fmaxf(z, 0.f) + __logf(1.0f + __expf(-fabsf(z))); }
__device__ __forceinline__ float wave_sum(float v) {
#pragma unroll
    for (int o = 1; o < 64; o <<= 1) v += __shfl_xor(v, o);
    return v;
}
#define LDS_WAIT() asm volatile("s_waitcnt lgkmcnt(0)" ::: "memory")
#define MFMA16(a, b, c) __builtin_amdgcn_mfma_f32_16x16x32_bf16((a), (b), (c), 0, 0, 0)
__device__ __forceinline__ bf16x8 lfrag(const LAS u16* base, int row, int ld, int kofs) { return *(const LAS bf16x8*)(base + row * ld + kofs); }
__device__ __forceinline__ bf16x8 lfrag_slot(const LAS u16* base, int row, int ld, int kb, int quad) {
    const s16x4 lo = *(const LAS s16x4*)(base + row * ld + kb + quad * 4);
    const s16x4 hi = *(const LAS s16x4*)(base + row * ld + kb + 16 + quad * 4);
    bf16x8 r; r[0] = lo[0]; r[1] = lo[1]; r[2] = lo[2]; r[3] = lo[3]; r[4] = hi[0]; r[5] = hi[1]; r[6] = hi[2]; r[7] = hi[3]; return r;
}
__device__ __forceinline__ bf16x8 pack_p(const f32x4 a, const f32x4 b) {
    u32x4 w; w.x = cvt_pk_bf16(a[0], a[1]); w.y = cvt_pk_bf16(a[2], a[3]); w.z = cvt_pk_bf16(b[0], b[1]); w.w = cvt_pk_bf16(b[2], b[3]);
    return __builtin_bit_cast(bf16x8, w);
}
__device__ __forceinline__ float bfe(const u32x4 v, int e) { const unsigned w = v[e >> 1]; return (e & 1) ? bf_hi(w) : bf_lo(w); }
__device__ __forceinline__ void ld_pair(const u16* rowbase, int quad, u32x2& za, u32x2& zb) {
    const u32x4 wv = *(const u32x4*)(rowbase + (quad & 1) * 16 + (quad >> 1) * 8);
    const auto r0 = __builtin_amdgcn_permlane16_swap(wv.x, wv.z, false, false); const auto r1 = __builtin_amdgcn_permlane16_swap(wv.y, wv.w, false, false);
    za.x = r0[0]; za.y = r1[0]; zb.x = r0[1]; zb.y = r1[1];
}
__device__ __forceinline__ void st_pair(u16* rowbase, int quad, const u32x2 a, const u32x2 b) {
    const auto r0 = __builtin_amdgcn_permlane16_swap(a.x, b.x, false, false); const auto r1 = __builtin_amdgcn_permlane16_swap(a.y, b.y, false, false);
    u32x4 wv; wv.x = r0[0]; wv.y = r1[0]; wv.z = r0[1]; wv.w = r1[1];
    *(u32x4*)(rowbase + (quad & 1) * 16 + (quad >> 1) * 8) = wv;
}
__device__ __forceinline__ void st_tr8(LAS u16* XT, int ld, int c0, int row, const float (&val)[8]) {
#pragma unroll
    for (int e = 0; e < 8; e += 2) { const unsigned w = cvt_pk_bf16(val[e], val[e + 1]); XT[(c0 + e) * ld + row] = (u16)(w & 0xffffu); XT[(c0 + e + 1) * ld + row] = (u16)(w >> 16); }
}
__device__ __forceinline__ void st_tr8_raw(LAS u16* XT, int ld, int c0, int row, const u32x4 v) {
#pragma unroll
    for (int e = 0; e < 4; ++e) { XT[(c0 + 2 * e) * ld + row] = (u16)(v[e] & 0xffffu); XT[(c0 + 2 * e + 1) * ld + row] = (u16)(v[e] >> 16); }
}
#include <cstdint>
#include <cstdlib>
#include <vector>

#define XB_TMO      128
#define XB_XCNT(j)  (256  + 64 * (j))
#define XB_XSUB(j)  (1280 + 64 * (j))
#define XB_XGEN(j)  (2304 + 64 * (j))
#define XB_TOP      3328
#define XB_TOPGEN   3392
#define XCD_BAR_WORDS 3456
#define XB_SPIN_CAP (1u << 18)

__device__ __forceinline__ unsigned xb_ld(unsigned* p)              { return __hip_atomic_load(p, __ATOMIC_RELAXED, __HIP_MEMORY_SCOPE_AGENT); }
__device__ __forceinline__ unsigned xb_add(unsigned* p, unsigned v) { return __hip_atomic_fetch_add(p, v, __ATOMIC_RELAXED, __HIP_MEMORY_SCOPE_AGENT); }
__device__ __forceinline__ unsigned xb_xcc_id() { return (unsigned)__builtin_amdgcn_s_getreg((3 << 11) | 20) & 0xFu; }
#define XB_SPIN(cond, bar) do { unsigned _sp = 0; while (cond) { __builtin_amdgcn_s_sleep(1); \
    if ((++_sp & 255u) == 0u) { if (xb_ld(&(bar)[XB_TMO])) break; if (_sp > XB_SPIN_CAP) { atomicAdd(&(bar)[XB_TMO], 1u); break; } } } } while (0)

struct XcdBarrier {
    unsigned* bar; unsigned x;
    volatile LAS unsigned* st;
};

__device__ __forceinline__ XcdBarrier xcd_barrier_post(unsigned* bar, volatile LAS unsigned* st) {
    XcdBarrier b; b.bar = bar; b.x = xb_xcc_id(); b.st = st;
    if (threadIdx.x == 0) (void)xb_add(&bar[XB_XCNT(b.x)], 1u);
    return b;
}
__device__ __forceinline__ void xcd_barrier_complete(unsigned* bar, unsigned x, unsigned& nloc, unsigned& nx) {
    const unsigned G = gridDim.x * gridDim.y * gridDim.z;
    unsigned sum, cnt, mine, sp = 0u;
    for (;;) {
        sum = 0u; cnt = 0u; mine = 0u;
#pragma unroll
        for (unsigned j = 0; j < 16; ++j) { const unsigned c = xb_ld(&bar[XB_XCNT(j)]); sum += c; cnt += (c > 0u) ? 1u : 0u; mine = (j == x) ? c : mine; }
        if (sum == G) break;
        __builtin_amdgcn_s_sleep(1);
        if ((++sp & 255u) == 0u) { if (xb_ld(&bar[XB_TMO])) break; if (sp > XB_SPIN_CAP) { atomicAdd(&bar[XB_TMO], 1u); break; } }
    }
    nloc = mine > 0u ? mine : 1u; nx = cnt > 0u ? cnt : 1u;
}

__device__ __forceinline__ void xcd_barrier(const XcdBarrier& b) {
    asm volatile("s_waitcnt vmcnt(0)" ::: "memory");
    __syncthreads();
    if (threadIdx.x == 0) {
        unsigned* bar = b.bar;
        __builtin_amdgcn_s_waitcnt(0);
        unsigned nloc = b.st[0], nx = b.st[1];
        if (nloc == 0u) { xcd_barrier_complete(bar, b.x, nloc, nx); b.st[0] = nloc; b.st[1] = nx; }
        const unsigned old = xb_add(&bar[XB_XSUB(b.x)], 1u);
        const unsigned gen = old / nloc;
        if (old + 1u == (gen + 1u) * nloc) {
            __builtin_amdgcn_fence(__ATOMIC_RELEASE, "agent");
            asm volatile("s_waitcnt vmcnt(0)" ::: "memory");
            const unsigned og = xb_add(&bar[XB_TOP], 1u);
            const unsigned tg = og / nx;
            if (og + 1u == (tg + 1u) * nx) xb_add(&bar[XB_TOPGEN], 1u);
            else XB_SPIN(xb_ld(&bar[XB_TOPGEN]) == tg, bar);
            __builtin_amdgcn_fence(__ATOMIC_ACQUIRE, "agent");
            xb_add(&bar[XB_XGEN(b.x)], 1u);
            asm volatile("s_waitcnt vmcnt(0)" ::: "memory");
        } else {
            XB_SPIN(xb_ld(&bar[XB_XGEN(b.x)]) == gen, bar);
            __builtin_amdgcn_fence(__ATOMIC_ACQUIRE, "agent");
            asm volatile("s_waitcnt vmcnt(0)" ::: "memory");
        }
    }
    __syncthreads();
}

__device__ __forceinline__ float act_apply(float v, int mode) {
    if (mode == 0) return v;
    if (mode == 1) return v * QSCALE;
    if (mode == 2) return v * (QSCALE * 1.4426950408889634f);
    if (mode == 3) return sigmoidf_(v);
    const float y = 1.5957691216057308f * (v + 0.044715f * v * v * v);
    return v * sigmoidf_(y);
}
struct EpiProj {
    static constexpr bool PERM = true, AFTER_DRAIN = false, KEEPS = false;
    u16* base; u16* mkv;
    __device__ __forceinline__ void operator()(const f32x4 (&acc)[2][2][4][2], const pg8::Unit& u, int wr, int wc, int fr, int fq) const {
        int mode = 0; u16* b = mkv; int colt = (u.pn - 70) * 256; int ldc = 1024; int pm = 0;
        if (u.pm < 64) {
            const int t = u.pn >> 1; colt = (u.pn & 1) * 256; b = base + (size_t)t * ((size_t)S_ * 512); ldc = 512; pm = u.pm;
            mode = (t == T_SBQ) ? 2 : (t == T_XAQ) ? 1 : 0;
        }
        const int row0 = pm * 256 + wr * 64 + fr, col0 = colt + wc * 32 + 8 * fq;
        if (u.pm >= 64 && u.pn >= 72) {
#pragma unroll
            for (int ai = 0; ai < 2; ++ai)
#pragma unroll
                for (int m = 0; m < 4; ++m) { const int r = row0 + ai * 128 + m * 16;
#pragma unroll
                    for (int bj = 0; bj < 2; ++bj) { const int cv = col0 + bj * 128 - 512; u16* tp = mkv + 256 * 1024 + (size_t)cv * 256 + r;
                        const f32x4 v0 = acc[ai][bj][m][0], v1 = acc[ai][bj][m][1];
                        const unsigned w0 = cvt_pk_bf16(v0[0], v0[1]), w1 = cvt_pk_bf16(v0[2], v0[3]), w2 = cvt_pk_bf16(v1[0], v1[1]), w3 = cvt_pk_bf16(v1[2], v1[3]);
                        tp[0] = (u16)(w0 & 0xffffu); tp[256] = (u16)(w0 >> 16); tp[512] = (u16)(w1 & 0xffffu); tp[768] = (u16)(w1 >> 16);
                        tp[1024] = (u16)(w2 & 0xffffu); tp[1280] = (u16)(w2 >> 16); tp[1536] = (u16)(w3 & 0xffffu); tp[1792] = (u16)(w3 >> 16); } }
            return;
        }
        if (u.pm < 64 && ((u.pn >> 1) == T_SBV || (u.pn >> 1) == T_MLV || (u.pn >> 1) == T_RTV)) {
#pragma unroll
            for (int ai = 0; ai < 2; ++ai)
#pragma unroll
                for (int m = 0; m < 4; ++m) { const int r = row0 + ai * 128 + m * 16;
#pragma unroll
                    for (int bj = 0; bj < 2; ++bj) { const int c = col0 + bj * 128; u16* tp = b + ((size_t)((r >> 6) * 4 + (c >> 7))) * 8192 + (size_t)(c & 127) * 64 + (r & 63);
                        const f32x4 v0 = acc[ai][bj][m][0], v1 = acc[ai][bj][m][1];
                        const unsigned w0 = cvt_pk_bf16(v0[0], v0[1]), w1 = cvt_pk_bf16(v0[2], v0[3]), w2 = cvt_pk_bf16(v1[0], v1[1]), w3 = cvt_pk_bf16(v1[2], v1[3]);
                        tp[0] = (u16)(w0 & 0xffffu); tp[64] = (u16)(w0 >> 16); tp[128] = (u16)(w1 & 0xffffu); tp[192] = (u16)(w1 >> 16);
                        tp[256] = (u16)(w2 & 0xffffu); tp[320] = (u16)(w2 >> 16); tp[384] = (u16)(w3 & 0xffffu); tp[448] = (u16)(w3 >> 16); } }
            return;
        }
#pragma unroll
        for (int ai = 0; ai < 2; ++ai)
#pragma unroll
            for (int m = 0; m < 4; ++m) { u16* rowp = b + (size_t)(row0 + ai * 128 + m * 16) * ldc + col0;
#pragma unroll
                for (int bj = 0; bj < 2; ++bj) { const f32x4 v0 = acc[ai][bj][m][0], v1 = acc[ai][bj][m][1];
                    u32x4 w; w.x = cvt_pk_bf16(act_apply(v0[0], mode), act_apply(v0[1], mode)); w.y = cvt_pk_bf16(act_apply(v0[2], mode), act_apply(v0[3], mode));
                    w.z = cvt_pk_bf16(act_apply(v1[0], mode), act_apply(v1[1], mode)); w.w = cvt_pk_bf16(act_apply(v1[2], mode), act_apply(v1[3], mode));
                    *(u32x4*)(rowp + bj * 128) = w; __builtin_amdgcn_sched_barrier(0); } }
    }
};
__device__ __forceinline__ int eslot(int n) { return n == 0 ? T_SBQ : n == 1 ? T_MLQ : n == 2 ? T_MLV : n == 3 ? T_GMU : T_RTQ; }
__device__ __forceinline__ int yslot(int n) { return n == 0 ? T_SBZ : n == 1 ? T_MLZ : n == 2 ? T_GMZ : n == 3 ? T_RTZ : T_XAZ; }
struct EpiGateE {
    static constexpr bool PERM = true, AFTER_DRAIN = false, KEEPS = false;
    u16* proj;
    __device__ __forceinline__ void operator()(const f32x4 (&acc)[2][2][4][2], const pg8::Unit& u, int wr, int wc, int fr, int fq) const {
        const int n = u.pn >> 2; u16* b = proj + (size_t)eslot(n) * ((size_t)S_ * 512);
        const int row0 = u.pm * 256 + wr * 64 + fr, col0 = (u.pn & 3) * 256 + wc * 32 + 8 * fq;
#pragma unroll
        for (int ai = 0; ai < 2; ++ai)
#pragma unroll
            for (int m = 0; m < 4; ++m) { u16* rowp = b + (size_t)(row0 + ai * 128 + m * 16) * 1024 + col0;
#pragma unroll
                for (int bj = 0; bj < 2; ++bj) { const f32x4 v0 = acc[ai][bj][m][0], v1 = acc[ai][bj][m][1];
                    float e[8];
#pragma unroll
                    for (int i = 0; i < 4; ++i) { e[i] = fminf(1.0f + __expf(-v0[i]), 1e30f); e[4 + i] = fminf(1.0f + __expf(-v1[i]), 1e30f); }
                    u32x4 w; w.x = cvt_pk_bf16(e[0], e[1]); w.y = cvt_pk_bf16(e[2], e[3]); w.z = cvt_pk_bf16(e[4], e[5]); w.w = cvt_pk_bf16(e[6], e[7]);
                    *(u32x4*)(rowp + bj * 128) = w; } }
    }
};
struct EpiMerge {
    static constexpr bool PERM = true, AFTER_DRAIN = false, KEEPS = true;
    const u16* proj; u16* merged;
    __device__ __forceinline__ bool keep(const pg8::Unit& u) const { return u.n < 4; }
    __device__ __forceinline__ void operator()(f32x4 (&acc)[2][2][4][2], const pg8::Unit& u, int wr, int wc, int fr, int fq) const {
        const int n = u.n; const bool last = (n == 4);
        const u16* e0 = proj + (size_t)eslot(n) * ((size_t)S_ * 512); const u16* e1 = proj + (size_t)eslot(last ? 4 : n + 1) * ((size_t)S_ * 512);
        const int row0 = u.pm * 256 + wr * 64 + fr, col0 = u.pn * 256 + wc * 32 + 8 * fq;
#pragma unroll
        for (int ai = 0; ai < 2; ++ai) {
            u32x4 a[4][2], b[4][2];
#pragma unroll
            for (int m = 0; m < 4; ++m)
#pragma unroll
                for (int bj = 0; bj < 2; ++bj) { const size_t ro = (size_t)(row0 + ai * 128 + m * 16) * 1024 + col0 + bj * 128;
                    a[m][bj] = *(const u32x4*)(e0 + ro); b[m][bj] = *(const u32x4*)(e1 + ro); }
#pragma unroll
            for (int m = 0; m < 4; ++m)
#pragma unroll
                for (int bj = 0; bj < 2; ++bj) {
                    float f[8];
#pragma unroll
                    for (int i = 0; i < 8; ++i) { f[i] = __builtin_amdgcn_rcpf(bfe(a[m][bj], i)); if (!last) f[i] *= bfe(b[m][bj], i); }
#pragma unroll
                    for (int i = 0; i < 4; ++i) { acc[ai][bj][m][0][i] *= f[i]; acc[ai][bj][m][1][i] *= f[4 + i]; }
                    if (last) { const f32x4 v0 = acc[ai][bj][m][0], v1 = acc[ai][bj][m][1];
                        u32x4 w; w.x = cvt_pk_bf16(v0[0], v0[1]); w.y = cvt_pk_bf16(v0[2], v0[3]); w.z = cvt_pk_bf16(v1[0], v1[1]); w.w = cvt_pk_bf16(v1[2], v1[3]);
                        *(u32x4*)(merged + (size_t)(row0 + ai * 128 + m * 16) * 1024 + col0 + bj * 128) = w; } }
            asm volatile("" ::: "memory"); }
    }
};
struct UpOrder : pg8::StaticOrder {
    __device__ __forceinline__ bool next(int i, pg8::Unit& u) const { const int ti = i / 5; if (!pg8::StaticOrder::next(ti, u)) return false; u.n = i - ti * 5; return true; }
    __device__ __forceinline__ const char* abase(const pg8::Gemm& g, const pg8::Unit& u, size_t tstep) const { return (const char*)g.A + (size_t)yslot(u.n) * SZ_T + (size_t)u.pm * tstep; }
    __device__ __forceinline__ const char* bbase(const pg8::Gemm& g, const pg8::Unit& u, size_t tstep) const { return (const char*)g.Bt + ((size_t)u.n * 1024 + (size_t)u.pn * 256) * 1024; }
};
struct EpiF32 {
    static constexpr bool PERM = false, AFTER_DRAIN = false, KEEPS = false;
    float* C; int ldc;
    __device__ __forceinline__ void operator()(const f32x4 (&acc)[2][2][4][2], const pg8::Unit& u, int wr, int wc, int fr, int fq) const {
        const int row0 = u.pm * 256 + wr * 64 + fr, col0 = u.pn * 256 + wc * 32 + 4 * fq;
#pragma unroll
        for (int ai = 0; ai < 2; ++ai)
#pragma unroll
            for (int m = 0; m < 4; ++m) { float* rowp = C + (size_t)(row0 + ai * 128 + m * 16) * ldc + col0;
#pragma unroll
                for (int bj = 0; bj < 2; ++bj)
#pragma unroll
                    for (int n = 0; n < 2; ++n) *(f32x4*)(rowp + bj * 128 + n * 16) = acc[ai][bj][m][n]; }
    }
};
struct ProjOrder : pg8::StaticOrder {
    int nfull;
    __device__ __forceinline__ bool next(int i, pg8::Unit& u) const {
        if (i < nfull) return pg8::StaticOrder::next(i, u);
        if (i == nfull && c < 4) { u.pm = 64; u.pn = 70 + c; return true; }
        return false; }
};
struct OneUnit { int pm, pn, cnt;
    __device__ __forceinline__ const char* abase(const pg8::Gemm& g, const pg8::Unit& u, size_t tstep) const { return (const char*)g.A + (size_t)u.pm * tstep; }
    __device__ __forceinline__ const char* bbase(const pg8::Gemm& g, const pg8::Unit& u, size_t tstep) const { return (const char*)g.Bt + (size_t)u.pn * tstep; }
    __device__ __forceinline__ bool next(int i, pg8::Unit& u) const { if (i >= cnt) return false; u.pm = pm; u.pn = pn; return true; }
    __device__ __forceinline__ void a_ready(const pg8::Unit&) const {}
    __device__ __forceinline__ void done(const pg8::Unit&) const {}
};

__device__ __forceinline__ void transpose_item(const float* W, int ldw, int c0, int k0, u16* WT, int K, int n0, LAS float* scr, int lane) {
    f32x4 tv[8];
#pragma unroll
    for (int i = 0; i < 8; ++i) { const int kk = 8 * i + (lane >> 3); tv[i] = *(const f32x4*)(W + (size_t)(k0 + kk) * ldw + c0 + (lane & 7) * 4); }
#pragma unroll
    for (int i = 0; i < 8; ++i) { const int kk = 8 * i + (lane >> 3); LAS float* d = scr + kk * 33 + (lane & 7) * 4; d[0] = tv[i][0]; d[1] = tv[i][1]; d[2] = tv[i][2]; d[3] = tv[i][3]; }
    LDS_WAIT();
    const int c = lane & 7;
#pragma unroll
    for (int j = 0; j < 4; ++j) { const int n = (lane >> 3) + 8 * j; const LAS float* s = scr + (8 * c) * 33 + n;
        u32x4 o; o.x = cvt_pk_bf16(s[0 * 33], s[1 * 33]); o.y = cvt_pk_bf16(s[2 * 33], s[3 * 33]); o.z = cvt_pk_bf16(s[4 * 33], s[5 * 33]); o.w = cvt_pk_bf16(s[6 * 33], s[7 * 33]);
        *(u32x4*)(WT + (size_t)(n0 + n) * K + k0 + 8 * c) = o; }
    LDS_WAIT();
}
__device__ __forceinline__ void phase_prep(const Params& p, int l, LAS unsigned char* lds, const int tid, const int bid, const int nblk) {
    const int lane = tid & 63, wave = tid >> 6;
    unsigned char* ws = p.ws;
    const int gw = bid * 8 + wave, NGW = nblk * 8;
    if (l < 2) {
        LAS float* scr = (LAS float*)(lds + wave * 8448);
        const float* w_in = (const float*)p.in[5] + (size_t)l * 1024 * DIN;
        const float* w_mkv = (const float*)p.in[15] + (size_t)l * 1024 * 1024;
        const float* w_up = (const float*)p.in[16] + (size_t)l * 5 * 512 * 1024;
        const float* w_out = (const float*)p.in[17] + (size_t)l * 1024 * 1024;
        constexpr int I_IN = 16 * 448, I_UP = 5 * 256, I_SQ = 512;
        for (int it = gw; it < I_IN + I_UP + 2 * I_SQ; it += NGW) {
            int r = it;
            if (r < I_IN) { const int kb = r / 448, nb = r % 448, n0 = nb * 32; transpose_item(w_in, DIN, n0 + (n0 >= 4608 ? 8 : 0), kb * 64, (u16*)(ws + OFF_WIN), 1024, n0, scr, lane); continue; }
            r -= I_IN;
            if (r < I_UP) { const int n = r / 256, q = r % 256, kb = q / 32, nb = q % 32; transpose_item(w_up + (size_t)n * 512 * 1024, 1024, nb * 32, kb * 64, (u16*)(ws + OFF_WUP) + (size_t)n * 1024 * 512, 512, nb * 32, scr, lane); continue; }
            r -= I_UP;
            if (r < I_SQ) { const int kb = r / 32, nb = r % 32; transpose_item(w_out, 1024, nb * 32, kb * 64, (u16*)(ws + OFF_WOUT), 1024, nb * 32, scr, lane); continue; }
            r -= I_SQ;
            { const int kb = r / 32, nb = r % 32; transpose_item(w_mkv, 1024, nb * 32, kb * 64, (u16*)(ws + OFF_WMKV), 1024, nb * 32, scr, lane); }
        }
    }
    LAS float* w8 = (LAS float*)(lds + 73728);
    if (l < 2) {
        const float* w_in = (const float*)p.in[5] + (size_t)l * 1024 * DIN;
        for (int i = tid; i < 8192; i += 512) w8[i] = w_in[(size_t)(i >> 3) * DIN + 4608 + (i & 7)];
    }
    __syncthreads();
    const float* xin = (l <= 1) ? (const float*)p.in[0] : (const float*)p.out;
    const float* outf = (const float*)(ws + OFF_OUTF);
    const int nrows = S_ + (l < 2 ? 256 : 0);
    for (int row = gw; row < nrows; row += NGW) {
        if (row < S_) {
            f32x4 v[4];
            const f32x4* xr = (const f32x4*)(xin + (size_t)row * 1024) + lane;
#pragma unroll
            for (int j = 0; j < 4; ++j) v[j] = xr[64 * j];
            if (l > 0) {
                const f32x4* orow = (const f32x4*)(outf + (size_t)row * 1024) + lane; const f32x4* gp = (const f32x4*)((const float*)p.in[4] + (size_t)(l - 1) * 1024) + lane;
                f32x4 o[4]; float ss = 0.f;
#pragma unroll
                for (int j = 0; j < 4; ++j) { o[j] = orow[64 * j]; ss += (o[j][0] * o[j][0] + o[j][1] * o[j][1]) + (o[j][2] * o[j][2] + o[j][3] * o[j][3]); }
                const float rs = rsqrtf(wave_sum(ss) * (1.0f / 1024.0f) + EPS);
                f32x4* dst = (f32x4*)(p.out + (size_t)row * 1024) + lane;
#pragma unroll
                for (int j = 0; j < 4; ++j) { v[j] = v[j] + o[j] * rs * gp[64 * j]; dst[64 * j] = v[j]; }
            }
            if (l < 2) {
                float ss = 0.f;
#pragma unroll
                for (int j = 0; j < 4; ++j) ss += (v[j][0] * v[j][0] + v[j][1] * v[j][1]) + (v[j][2] * v[j][2] + v[j][3] * v[j][3]);
                const float rs = rsqrtf(wave_sum(ss) * (1.0f / 1024.0f) + EPS);
                const f32x4* gp = (const f32x4*)((const float*)p.in[3] + (size_t)l * 1024) + lane;
                u32x2* hrow = (u32x2*)((u16*)(ws + OFF_H) + (size_t)row * 1024) + lane;
                float g8[8];
#pragma unroll
                for (int q = 0; q < 8; ++q) g8[q] = 0.f;
#pragma unroll
                for (int j = 0; j < 4; ++j) { const f32x4 hv = v[j] * rs * gp[64 * j];
                    u32x2 w; w.x = cvt_pk_bf16(hv[0], hv[1]); w.y = cvt_pk_bf16(hv[2], hv[3]); hrow[64 * j] = w;
#pragma unroll
                    for (int i = 0; i < 4; ++i) { const int k = 4 * lane + 256 * j + i; const f32x4 wa = *(const LAS f32x4*)(w8 + k * 8), wb = *(const LAS f32x4*)(w8 + k * 8 + 4);
                        g8[0] += hv[i] * wa[0]; g8[1] += hv[i] * wa[1]; g8[2] += hv[i] * wa[2]; g8[3] += hv[i] * wa[3];
                        g8[4] += hv[i] * wb[0]; g8[5] += hv[i] * wb[1]; g8[6] += hv[i] * wb[2]; g8[7] += hv[i] * wb[3]; } }
#pragma unroll
                for (int q = 0; q < 8; ++q) g8[q] = wave_sum(g8[q]);
                if (lane < 8) { float val = g8[0];
#pragma unroll
                    for (int q = 1; q < 8; ++q) val = (lane == q) ? g8[q] : val;
                    const float bias = (lane < 4) ? ((const float*)p.in[6])[l * 4 + lane] : ((const float*)p.in[7])[l * 4 + lane - 4];
                    ((float*)(ws + OFF_IF))[(size_t)row * 8 + lane] = val + bias; }
            }
        } else {
            const int mr = row - S_;
            const f32x4* xr = (const f32x4*)((const float*)p.in[1] + (size_t)mr * 1024) + lane; const f32x4* gp = (const f32x4*)((const float*)p.in[14] + (size_t)l * 1024) + lane;
            f32x4 v[4]; float ss = 0.f;
#pragma unroll
            for (int j = 0; j < 4; ++j) { v[j] = xr[64 * j]; ss += (v[j][0] * v[j][0] + v[j][1] * v[j][1]) + (v[j][2] * v[j][2] + v[j][3] * v[j][3]); }
            const float rs = rsqrtf(wave_sum(ss) * (1.0f / 1024.0f) + EPS);
            u32x2* hrow = (u32x2*)((u16*)(ws + OFF_MEMH) + (size_t)mr * 1024) + lane;
#pragma unroll
            for (int j = 0; j < 4; ++j) { const f32x4 hv = v[j] * rs * gp[64 * j]; u32x2 w; w.x = cvt_pk_bf16(hv[0], hv[1]); w.y = cvt_pk_bf16(hv[2], hv[3]); hrow[64 * j] = w; }
        }
    }
}

__device__ __forceinline__ void sb_item(const u16* Q, const u16* Kg, const u16* Vg, const u16* ZY, u16* ZW, int qb, int h, LAS unsigned char* lds, const int tid) {
    const int lane = tid & 63, w = tid >> 6, fr = lane & 15, quad = lane >> 4;
    LAS u16* Qs = (LAS u16*)lds;
    LAS u16* Ks = Qs + 128 * 136;
    LAS u16* VT = Ks + 64 * 136;
    LAS int* flg = (LAS int*)(VT + 128 * 72);
    const int q0 = qb * 128;
    u32x4 qpre[4];
#pragma unroll
    for (int i = 0; i < 4; ++i) { const int ch = tid + i * 512, r = ch >> 4, c = ch & 15; qpre[i] = *(const u32x4*)(Q + (size_t)(q0 + r) * 512 + h * 128 + c * 8); }
    u32x4 kreg[2], vreg[2];
#pragma unroll
    for (int i = 0; i < 2; ++i) { const int ch = tid + i * 512, r = ch >> 4, c = ch & 15, c2 = w + 8 * i; const int kt = 2 * qb + 1;
        kreg[i] = *(const u32x4*)(Kg + (size_t)(kt * 64 + r) * 512 + h * 128 + c * 8);
        vreg[i] = *(const u32x4*)(Vg + (size_t)(kt * 4 + h) * 8192 + (size_t)ch * 8); (void)c2; }
    __syncthreads();
#pragma unroll
    for (int i = 0; i < 4; ++i) { const int ch = tid + i * 512, r = ch >> 4, c = ch & 15; *(LAS u32x4*)(Qs + r * 136 + c * 8) = qpre[i]; }
    if (tid < 8) flg[tid] = 0;
    f32x4 o[8];
#pragma unroll
    for (int i = 0; i < 8; ++i) o[i] = (f32x4){0.f, 0.f, 0.f, 0.f};
    float carry = 0.f; int wdone = 0;
    const int tq = q0 + w * 16 + fr;
    for (int kt = 2 * qb + 1; kt >= 0; --kt) {
        __syncthreads();
        int nd = 0;
#pragma unroll
        for (int i = 0; i < 8; ++i) nd += flg[i];
        if (nd == 8) break;
#pragma unroll
        for (int i = 0; i < 2; ++i) { const int ch = tid + i * 512, r = ch >> 4, c = ch & 15;
            *(LAS u32x4*)(Ks + r * 136 + c * 8) = kreg[i];
            *(LAS u32x4*)(VT + (ch >> 3) * 72 + (ch & 7) * 8) = vreg[i]; }
        __syncthreads();
        if (kt > 0) {
#pragma unroll
            for (int i = 0; i < 2; ++i) { const int ch = tid + i * 512, r = ch >> 4, c = ch & 15, c2 = w + 8 * i;
                kreg[i] = *(const u32x4*)(Kg + (size_t)((kt - 1) * 64 + r) * 512 + h * 128 + c * 8);
                vreg[i] = *(const u32x4*)(Vg + (size_t)((kt - 1) * 4 + h) * 8192 + (size_t)ch * 8); (void)c2; } }
        const int wq0 = q0 + w * 16;
        if (!wdone && kt * 64 < wq0 + 15) {
        const bool full = (kt * 64 + 63 < wq0);
        f32x4 st[4];
#pragma unroll
        for (int i = 0; i < 4; ++i) st[i] = (f32x4){0.f, 0.f, 0.f, 0.f};
#pragma unroll
        for (int ks = 0; ks < 4; ++ks) { const bf16x8 qf = lfrag(Qs, w * 16 + fr, 136, ks * 32 + quad * 8);
#pragma unroll
            for (int mt = 0; mt < 4; ++mt) st[mt] = MFMA16(lfrag(Ks, mt * 16 + fr, 136, ks * 32 + quad * 8), qf, st[mt]); }
        float run = carry; int dead = 0;
#pragma unroll
        for (int mt = 3; mt >= 0; --mt) {
            const int kb = kt * 64 + mt * 16;
            if (dead || kb >= wq0 + 16) { st[mt] = (f32x4){0.f, 0.f, 0.f, 0.f}; }
            else {
                const bool mfull = full || (kb + 15 < wq0);
                float l[4], ls[4], gs = 0.f;
#pragma unroll
                for (int j = 0; j < 4; ++j) { const float zc = __builtin_amdgcn_fmed3f(st[mt][j], -115.0f, 115.0f);
                    const float sp = __builtin_amdgcn_logf(1.0f + __builtin_amdgcn_exp2f(zc));
                    l[j] = -sp; ls[j] = zc - sp;
                    if (!mfull) { const bool valid = (kb + quad * 4 + j) < tq; l[j] = valid ? l[j] : 0.f; ls[j] = valid ? ls[j] : -1e30f; }
                    gs += l[j]; }
                const float g1 = __shfl(gs, ((quad + 1) & 3) * 16 + fr), g2 = __shfl(gs, ((quad + 2) & 3) * 16 + fr), g3 = __shfl(gs, ((quad + 3) & 3) * 16 + fr);
                const float qsuf = (quad < 3 ? g1 : 0.f) + (quad < 2 ? g2 : 0.f) + (quad < 1 ? g3 : 0.f);
                const float b3 = run + qsuf, b2 = b3 + l[3], b1 = b2 + l[2], b0 = b1 + l[1];
                st[mt][3] = __builtin_amdgcn_exp2f(ls[3] + b3); st[mt][2] = __builtin_amdgcn_exp2f(ls[2] + b2); st[mt][1] = __builtin_amdgcn_exp2f(ls[1] + b1); st[mt][0] = __builtin_amdgcn_exp2f(ls[0] + b0);
                run += gs + g1 + g2 + g3;
                dead = __all(run < -151.0f);
            }
        }
        carry = run;
#pragma unroll
        for (int k2 = 0; k2 < 2; ++k2) { const bf16x8 pf = pack_p(st[2 * k2], st[2 * k2 + 1]);
#pragma unroll
            for (int mt = 0; mt < 8; ++mt) o[mt] = MFMA16(lfrag_slot(VT, mt * 16 + fr, 72, k2 * 32, quad), pf, o[mt]); }
        wdone = __all(carry < -151.0f);
        if (lane == 0) flg[w] = wdone ? 1 : 0;
        }
    }
    const u16* zr = ZY + (size_t)tq * 512 + h * 128; u16* zw = ZW + (size_t)tq * 512 + h * 128;
#pragma unroll
    for (int mt = 0; mt < 8; mt += 2) { u32x2 za, zb; ld_pair(zr + mt * 16, quad, za, zb);
        u32x2 ra, rb;
        ra.x = cvt_pk_bf16(o[mt][0] * siluf_(bf_lo(za.x)), o[mt][1] * siluf_(bf_hi(za.x))); ra.y = cvt_pk_bf16(o[mt][2] * siluf_(bf_lo(za.y)), o[mt][3] * siluf_(bf_hi(za.y)));
        rb.x = cvt_pk_bf16(o[mt + 1][0] * siluf_(bf_lo(zb.x)), o[mt + 1][1] * siluf_(bf_hi(zb.x))); rb.y = cvt_pk_bf16(o[mt + 1][2] * siluf_(bf_lo(zb.y)), o[mt + 1][3] * siluf_(bf_hi(zb.y)));
        st_pair(zw + mt * 16, quad, ra, rb); }
}

__device__ __forceinline__ void ml_chunk_gates(const float ic, const float fp, int lane, float& bcum, float& g) {
    float b = fminf(fp, 0.f) - __logf(1.0f + __expf(-fabsf(fp)));
#pragma unroll
    for (int o = 1; o < 64; o <<= 1) { const float n = __shfl_up(b, o); if (lane >= o) b += n; }
    float x = ic - b;
#pragma unroll
    for (int o = 1; o < 64; o <<= 1) { const float n = __shfl_up(x, o); if (lane >= o) x = fmaxf(x, n); }
    bcum = b; g = b + x;
}
__device__ __forceinline__ void rot_cs(int pos, int i, float& cs, float& sn) {
    const float ang = (float)pos * INVF[i];
    double rev = (double)ang * 0.15915494309189535; rev -= floor(rev);
    const float fr = (float)rev;
    sn = __builtin_amdgcn_sinf(fr); cs = __builtin_amdgcn_cosf(fr);
}
template <bool RT, bool TRANSPOSED>
__device__ __forceinline__ void stage_qk(const u16* X, const float* convw, const int* pos, int c, int h, float scale, const LAS float* scale_row, LAS u16* dst, const int tid) {
    if (!RT) {
#pragma unroll
        for (int i = 0; i < 2; ++i) { const int ch = tid + i * 512; const int l = TRANSPOSED ? (tid & 63) : (ch >> 4), d0 = TRANSPOSED ? ((tid >> 6) + 8 * i) * 8 : (ch & 15) * 8;
            float a[8];
#pragma unroll
            for (int e = 0; e < 8; ++e) a[e] = 0.f;
#pragma unroll
            for (int j = 0; j < 4; ++j) { const int tt = c * 64 + l - 3 + j;
                if (tt >= 0) { const u32x4 v = *(const u32x4*)(X + (size_t)tt * 512 + h * 128 + d0); const f32x4 w0 = *(const f32x4*)(convw + j * 512 + h * 128 + d0), w1 = *(const f32x4*)(convw + j * 512 + h * 128 + d0 + 4);
#pragma unroll
                    for (int e = 0; e < 4; ++e) { a[e] += w0[e] * bfe(v, e); a[4 + e] += w1[e] * bfe(v, 4 + e); } } }
            const float sr = scale * (scale_row ? scale_row[l] : 1.0f);
#pragma unroll
            for (int e = 0; e < 8; ++e) a[e] = siluf_(a[e]) * sr;
            if (TRANSPOSED) st_tr8(dst, 72, d0, l, a);
            else { u32x4 o; o.x = cvt_pk_bf16(a[0], a[1]); o.y = cvt_pk_bf16(a[2], a[3]); o.z = cvt_pk_bf16(a[4], a[5]); o.w = cvt_pk_bf16(a[6], a[7]); *(LAS u32x4*)(dst + l * 136 + d0) = o; } }
    } else {
        const int l = TRANSPOSED ? (tid & 63) : (tid >> 3), d0 = TRANSPOSED ? (tid >> 6) * 8 : (tid & 7) * 8; const int t = c * 64 + l; const int ps = pos[t];
        const u32x4 v1 = *(const u32x4*)(X + (size_t)t * 512 + h * 128 + d0), v2 = *(const u32x4*)(X + (size_t)t * 512 + h * 128 + 64 + d0);
        const float sr = scale * (scale_row ? scale_row[l] : 1.0f);
        float a[8], b[8];
#pragma unroll
        for (int e = 0; e < 8; ++e) { float cs, sn; rot_cs(ps, d0 + e, cs, sn); const float t1 = bfe(v1, e), t2 = bfe(v2, e); a[e] = (t1 * cs - t2 * sn) * sr; b[e] = (t1 * sn + t2 * cs) * sr; }
        if (TRANSPOSED) { st_tr8(dst, 72, d0, l, a); st_tr8(dst, 72, 64 + d0, l, b); }
        else { u32x4 o; o.x = cvt_pk_bf16(a[0], a[1]); o.y = cvt_pk_bf16(a[2], a[3]); o.z = cvt_pk_bf16(a[4], a[5]); o.w = cvt_pk_bf16(a[6], a[7]); *(LAS u32x4*)(dst + l * 136 + d0) = o;
               o.x = cvt_pk_bf16(b[0], b[1]); o.y = cvt_pk_bf16(b[2], b[3]); o.z = cvt_pk_bf16(b[4], b[5]); o.w = cvt_pk_bf16(b[6], b[7]); *(LAS u32x4*)(dst + l * 136 + 64 + d0) = o; }
    }
}
__device__ __forceinline__ void stage_vt(const u16* V, int c, int h, LAS u16* VT, const int tid) {
#pragma unroll
    for (int i = 0; i < 2; ++i) { const int l = tid & 63, d0 = ((tid >> 6) + 8 * i) * 8;
        st_tr8_raw(VT, 72, d0, l, *(const u32x4*)(V + (size_t)(c * 64 + l) * 512 + h * 128 + d0)); }
}

template <bool RT>
__device__ __forceinline__ void kv1_item(const Params& p, int l, int c, int h, LAS unsigned char* lds, const int tid) {
    const int lane = tid & 63, w = tid >> 6, fr = lane & 15, quad = lane >> 4;
    unsigned char* ws = p.ws;
    LAS u16* KWT = (LAS u16*)lds;
    LAS u16* VT = KWT + 128 * 72;
    LAS float* wend = (LAS float*)(VT + 128 * 72);
    const u16* proj = (const u16*)(ws + OFF_PROJ);
    float* SC = (float*)(ws + OFF_SC);
    float ic = 0.f, fpv = 0.f;
    if (!RT && w == 0) { const float* IFg = (const float*)(ws + OFF_IF) + (size_t)(c * 64 + lane) * 8; ic = IFg[h]; fpv = IFg[4 + h]; }
    u32x4 vpre[2];
#pragma unroll
    for (int i = 0; i < 2; ++i) vpre[i] = *(const u32x4*)(proj + (size_t)(RT ? T_RTV : T_MLV) * S_ * 512 + (size_t)(c * 4 + h) * 8192 + (size_t)(tid + i * 512) * 8);
    u32x4 kpre[2][4]; int kpos = 0;
    { const int l_ = tid & 63; const u16* Kb = proj + (size_t)(RT ? T_RTK : T_MLK) * S_ * 512;
      if (!RT) {
#pragma unroll
        for (int i = 0; i < 2; ++i) { const int d0 = ((tid >> 6) + 8 * i) * 8;
#pragma unroll
            for (int j = 0; j < 4; ++j) { const int tt = c * 64 + l_ - 3 + j; kpre[i][j] = (tt >= 0) ? *(const u32x4*)(Kb + (size_t)tt * 512 + h * 128 + d0) : (u32x4){0u, 0u, 0u, 0u}; } }
      } else { const int d0 = (tid >> 6) * 8, t = c * 64 + l_; kpos = ((const int*)p.in[2])[t];
        kpre[0][0] = *(const u32x4*)(Kb + (size_t)t * 512 + h * 128 + d0); kpre[0][1] = *(const u32x4*)(Kb + (size_t)t * 512 + h * 128 + 64 + d0); } }
    __syncthreads();
    if (!RT) { if (w == 0) { float bcum, g; ml_chunk_gates(ic, fpv, lane, bcum, g);
            const float bl = __shfl(bcum, 63), al = __shfl(g, 63);
            wend[lane] = fexp(bl - bcum + ic - al);
            *(float2*)((float*)(ws + OFF_GATES) + ((size_t)h * S_ + c * 64 + lane) * 2) = make_float2(bcum, g);
            if (lane == 0) { SC[h * 256 + c] = bl; SC[1024 + h * 256 + c] = al; } } }
    else { if (tid < 64) wend[tid] = fexp(log_gamma(h) * (float)(63 - tid)); }
    __syncthreads();
    { const int l_ = tid & 63; const float sr = QSCALE * wend[l_];
      if (!RT) { const LAS float* convw = (const LAS float*)(lds + LDS_CONV) + 2048;
#pragma unroll
        for (int i = 0; i < 2; ++i) { const int d0 = ((tid >> 6) + 8 * i) * 8; float a[8];
#pragma unroll
            for (int e = 0; e < 8; ++e) a[e] = 0.f;
#pragma unroll
            for (int j = 0; j < 4; ++j) { const f32x4 w0 = *(const LAS f32x4*)(convw + j * 512 + h * 128 + d0), w1 = *(const LAS f32x4*)(convw + j * 512 + h * 128 + d0 + 4);
#pragma unroll
                for (int e = 0; e < 4; ++e) { a[e] += w0[e] * bfe(kpre[i][j], e); a[4 + e] += w1[e] * bfe(kpre[i][j], 4 + e); } }
#pragma unroll
            for (int e = 0; e < 8; ++e) a[e] = siluf_(a[e]) * sr;
            st_tr8(KWT, 72, d0, l_, a); }
      } else { const int d0 = (tid >> 6) * 8; float a[8], b[8];
#pragma unroll
        for (int e = 0; e < 8; ++e) { float cs, sn; rot_cs(kpos, d0 + e, cs, sn); const float t1 = bfe(kpre[0][0], e), t2 = bfe(kpre[0][1], e); a[e] = (t1 * cs - t2 * sn) * sr; b[e] = (t1 * sn + t2 * cs) * sr; }
        st_tr8(KWT, 72, d0, l_, a); st_tr8(KWT, 72, 64 + d0, l_, b); } }
#pragma unroll
    for (int i = 0; i < 2; ++i) { const int ch = tid + i * 512; *(LAS u32x4*)(VT + (ch >> 3) * 72 + (ch & 7) * 8) = vpre[i]; }
    __syncthreads();
    const int db = (w & 3) * 32, eh = (w >> 2) * 64;
    f32x4 acc[2][4];
#pragma unroll
    for (int a = 0; a < 2; ++a)
#pragma unroll
        for (int b = 0; b < 4; ++b) acc[a][b] = (f32x4){0.f, 0.f, 0.f, 0.f};
#pragma unroll
    for (int ks = 0; ks < 2; ++ks) { bf16x8 af[2], bfr[4];
#pragma unroll
        for (int a = 0; a < 2; ++a) af[a] = lfrag(KWT, db + a * 16 + fr, 72, ks * 32 + quad * 8);
#pragma unroll
        for (int b = 0; b < 4; ++b) bfr[b] = lfrag(VT, eh + b * 16 + fr, 72, ks * 32 + quad * 8);
#pragma unroll
        for (int a = 0; a < 2; ++a)
#pragma unroll
            for (int b = 0; b < 4; ++b) acc[a][b] = MFMA16(af[a], bfr[b], acc[a][b]); }
    u16* ST = (u16*)(ws + OFF_KV) + ((size_t)((RT ? 4 : 0) + h) * 256 + c) * 16384;
#pragma unroll
    for (int b = 0; b < 4; ++b) { const int e = eh + b * 16 + fr;
        u32x2 r0, r1; r0.x = cvt_pk_bf16(acc[0][b][0], acc[0][b][1]); r0.y = cvt_pk_bf16(acc[0][b][2], acc[0][b][3]); r1.x = cvt_pk_bf16(acc[1][b][0], acc[1][b][1]); r1.y = cvt_pk_bf16(acc[1][b][2], acc[1][b][3]);
        st_pair(ST + e * 128 + db, quad, r0, r1); }
    if (!RT && tid < 128) { float s = 0.f;
#pragma unroll 8
        for (int i = 0; i < 64; ++i) s += bf2f(KWT[tid * 72 + i]);
        ((float*)(ws + OFF_NST))[((size_t)h * 256 + c) * 128 + tid] = s; }
}

__device__ __forceinline__ void scan_item(const Params& p, LAS unsigned char* lds, const int tid, const int it, const bool dummy) {
    unsigned char* ws = p.ws;
    const float* SC = (const float*)(ws + OFF_SC);
    LAS float* do_s = (LAS float*)lds;
    LAS float* dl_s = do_s + 1024;
    LAS float* mp_s = dl_s + 1024;
    LAS float* bl_s = mp_s + 1024;
    LAS float* al_s = bl_s + 1024;
    __syncthreads();
    for (int i = tid; i < 2048; i += 512) bl_s[i] = SC[i];
    __syncthreads();
    if (tid < 4) { float m = 0.f;
        for (int c0 = 0; c0 < 256; c0 += 16) { float bl[16], al[16], mo[16];
#pragma unroll
            for (int i = 0; i < 16; ++i) { bl[i] = bl_s[tid * 256 + c0 + i]; al[i] = al_s[tid * 256 + c0 + i]; }
#pragma unroll
            for (int i = 0; i < 16; ++i) { mo[i] = m; m = fmaxf(bl[i] + m, al[i]); }
#pragma unroll
            for (int i = 0; i < 16; ++i) { const float mn = fmaxf(bl[i] + mo[i], al[i]);
                do_s[tid * 256 + c0 + i] = fexp(bl[i] + mo[i] - mn); dl_s[tid * 256 + c0 + i] = fexp(al[i] - mn); mp_s[tid * 256 + c0 + i] = mo[i]; } } }
    __syncthreads();
    {
        if (it < 128) {
            const int brh = it >> 4, part = it & 15, br = brh >> 2, h = brh & 3;
            unsigned* base = (unsigned*)(ws + OFF_KV) + (size_t)brh * 256 * 8192 + part * 512 + tid;
            unsigned* wbase = dummy ? (unsigned*)p.out + (size_t)brh * 256 * 8192 + part * 512 + tid : base;
            float s0 = 0.f, s1 = 0.f;
            const float cd = fexp(log_gamma(h) * 64.0f);
            for (int c0 = 0; c0 < 256; c0 += 32) {
                unsigned kv[32];
#pragma unroll
                for (int i = 0; i < 32; ++i) kv[i] = base[(size_t)(c0 + i) * 8192];
#pragma unroll
                for (int i = 0; i < 32; ++i) { const int c = c0 + i;
                    wbase[(size_t)c * 8192] = cvt_pk_bf16(s0, s1);
                    const float dold = (br == 0) ? do_s[h * 256 + c] : cd, dloc = (br == 0) ? dl_s[h * 256 + c] : 1.0f;
                    s0 = dold * s0 + dloc * bf_lo(kv[i]); s1 = dold * s1 + dloc * bf_hi(kv[i]); }
            }
        } else {
            const int h = tid >> 7, d = tid & 127;
            float* NST = (float*)(ws + OFF_NST) + (size_t)h * 256 * 128 + d; float* MP = (float*)(ws + OFF_SC) + 2048;
            for (int i = tid; i < 1024; i += 512) MP[i] = mp_s[i];
            float n = 0.f;
            for (int c0 = 0; c0 < 256; c0 += 16) {
                float nl[16];
#pragma unroll
                for (int i = 0; i < 16; ++i) nl[i] = NST[(c0 + i) * 128];
#pragma unroll
                for (int i = 0; i < 16; ++i) { const int c = c0 + i; if (!dummy) NST[c * 128] = n; n = do_s[h * 256 + c] * n + dl_s[h * 256 + c] * nl[i]; }
            }
        }
    }
}

template <bool RT>
__device__ __forceinline__ void out3_item(const Params& p, int l, int c, int h, LAS unsigned char* lds, const int tid, u16* zwb, const int nc, const int nh) {
    const int lane = tid & 63, w = tid >> 6, fr = lane & 15, quad = lane >> 4;
    unsigned char* ws = p.ws;
    LAS u16* Qs = (LAS u16*)lds;
    LAS u16* Ks = Qs + 64 * 136;
    LAS u16* VT = Ks + 64 * 136;
    LAS u16* STs = VT + 128 * 72;
    LAS float* fs = (LAS float*)(STs + 128 * 136);
    LAS float* rowterm = fs;
    LAS float* colterm = fs + 64;
    LAS float* dinter = fs + 128;
    LAS float* emt = fs + 192;
    LAS float* nprev = fs + 256;
    LAS float* red = fs + 384;
    const u16* proj = (const u16*)(ws + OFF_PROJ);
    float ic = 0.f, mp = 0.f, npv = 0.f;
    float2 bg = make_float2(0.f, 0.f);
    if (!RT) { if (w == 0) { const float* IFg = (const float*)(ws + OFF_IF) + (size_t)(c * 64 + lane) * 8; ic = IFg[h]; mp = ((const float*)(ws + OFF_SC))[2048 + h * 256 + c];
            bg = *(const float2*)((const float*)(ws + OFF_GATES) + ((size_t)h * S_ + c * 64 + lane) * 2); }
        if (tid >= 64 && tid < 192) npv = ((const float*)(ws + OFF_NST))[((size_t)h * 256 + c) * 128 + tid - 64]; }
    u32x4 vpre[2], spre[4];
#pragma unroll
    for (int i = 0; i < 2; ++i) vpre[i] = *(const u32x4*)(proj + (size_t)(RT ? T_RTV : T_MLV) * S_ * 512 + (size_t)(c * 4 + h) * 8192 + (size_t)(tid + i * 512) * 8);
    u32x4 qraw[2][4], kraw[2][4]; int ppos = 0;
    { const u16* Qb = proj + (size_t)(RT ? T_RTQ : T_MLQ) * S_ * 512; const u16* Kb = proj + (size_t)(RT ? T_RTK : T_MLK) * S_ * 512;
      if (!RT) {
        const int l0 = (tid >> 4) * 2, d0 = (tid & 15) * 8;
#pragma unroll
        for (int j = 0; j < 5; ++j) { const int tt = c * 64 + l0 - 3 + j; const size_t go_ = (size_t)tt * 512 + h * 128 + d0;
            qraw[j >> 2][j & 3] = (tt >= 0) ? *(const u32x4*)(Qb + go_) : (u32x4){0u, 0u, 0u, 0u}; kraw[j >> 2][j & 3] = (tt >= 0) ? *(const u32x4*)(Kb + go_) : (u32x4){0u, 0u, 0u, 0u}; }
      } else { const int l_ = tid >> 3, d0 = (tid & 7) * 8, t = c * 64 + l_; ppos = ((const int*)p.in[2])[t]; const size_t go_ = (size_t)t * 512 + h * 128 + d0;
        qraw[0][0] = *(const u32x4*)(Qb + go_); qraw[0][1] = *(const u32x4*)(Qb + go_ + 64); kraw[0][0] = *(const u32x4*)(Kb + go_); kraw[0][1] = *(const u32x4*)(Kb + go_ + 64); } }
    { const u16* ST = (const u16*)(ws + OFF_KV) + ((size_t)((RT ? 4 : 0) + h) * 256 + c) * 16384;
#pragma unroll
      for (int i = 0; i < 4; ++i) { const int ch = tid + i * 512; spre[i] = *(const u32x4*)(ST + (ch >> 4) * 128 + (ch & 15) * 8); } }
    __syncthreads();
    if (!RT) {
        if (w == 0) { const float bcum = bg.x, g = bg.y;
            const float mt = fmaxf(bcum + mp, g);
            rowterm[lane] = bcum - mt; colterm[lane] = ic - bcum; dinter[lane] = fexp(bcum + mp - mt); emt[lane] = fexp(-mt); }
        if (tid >= 64 && tid < 192) nprev[tid - 64] = npv;
        const LAS float* cwq = (const LAS float*)(lds + LDS_CONV); const LAS float* cwk = cwq + 2048;
        const int l0 = (tid >> 4) * 2, d0 = (tid & 15) * 8;
        f32x4 wq[4][2], wk[4][2];
#pragma unroll
        for (int j = 0; j < 4; ++j) { wq[j][0] = *(const LAS f32x4*)(cwq + j * 512 + h * 128 + d0); wq[j][1] = *(const LAS f32x4*)(cwq + j * 512 + h * 128 + d0 + 4);
            wk[j][0] = *(const LAS f32x4*)(cwk + j * 512 + h * 128 + d0); wk[j][1] = *(const LAS f32x4*)(cwk + j * 512 + h * 128 + d0 + 4); }
#pragma unroll
        for (int i = 0; i < 2; ++i) { const int l_ = l0 + i; float a[8], b[8];
#pragma unroll
            for (int e = 0; e < 8; ++e) { a[e] = 0.f; b[e] = 0.f; }
#pragma unroll
            for (int j = 0; j < 4; ++j) { const u32x4 qv = qraw[(i + j) >> 2][(i + j) & 3], kv = kraw[(i + j) >> 2][(i + j) & 3];
#pragma unroll
                for (int e = 0; e < 4; ++e) { a[e] += wq[j][0][e] * bfe(qv, e); a[4 + e] += wq[j][1][e] * bfe(qv, 4 + e); b[e] += wk[j][0][e] * bfe(kv, e); b[4 + e] += wk[j][1][e] * bfe(kv, 4 + e); } }
#pragma unroll
            for (int e = 0; e < 8; ++e) { a[e] = siluf_(a[e]); b[e] = siluf_(b[e]) * QSCALE; }
            u32x4 o; o.x = cvt_pk_bf16(a[0], a[1]); o.y = cvt_pk_bf16(a[2], a[3]); o.z = cvt_pk_bf16(a[4], a[5]); o.w = cvt_pk_bf16(a[6], a[7]); *(LAS u32x4*)(Qs + l_ * 136 + d0) = o;
            o.x = cvt_pk_bf16(b[0], b[1]); o.y = cvt_pk_bf16(b[2], b[3]); o.z = cvt_pk_bf16(b[4], b[5]); o.w = cvt_pk_bf16(b[6], b[7]); *(LAS u32x4*)(Ks + l_ * 136 + d0) = o; }
    } else {
        const int l_ = tid >> 3, d0 = (tid & 7) * 8; float a[8], b[8], a2[8], b2[8];
#pragma unroll
        for (int e = 0; e < 8; ++e) { float cs, sn; rot_cs(ppos, d0 + e, cs, sn);
            const float q1 = bfe(qraw[0][0], e), q2 = bfe(qraw[0][1], e), k1 = bfe(kraw[0][0], e), k2 = bfe(kraw[0][1], e);
            a[e] = q1 * cs - q2 * sn; a2[e] = q1 * sn + q2 * cs; b[e] = (k1 * cs - k2 * sn) * QSCALE; b2[e] = (k1 * sn + k2 * cs) * QSCALE; }
        u32x4 o; o.x = cvt_pk_bf16(a[0], a[1]); o.y = cvt_pk_bf16(a[2], a[3]); o.z = cvt_pk_bf16(a[4], a[5]); o.w = cvt_pk_bf16(a[6], a[7]); *(LAS u32x4*)(Qs + l_ * 136 + d0) = o;
        o.x = cvt_pk_bf16(a2[0], a2[1]); o.y = cvt_pk_bf16(a2[2], a2[3]); o.z = cvt_pk_bf16(a2[4], a2[5]); o.w = cvt_pk_bf16(a2[6], a2[7]); *(LAS u32x4*)(Qs + l_ * 136 + 64 + d0) = o;
        o.x = cvt_pk_bf16(b[0], b[1]); o.y = cvt_pk_bf16(b[2], b[3]); o.z = cvt_pk_bf16(b[4], b[5]); o.w = cvt_pk_bf16(b[6], b[7]); *(LAS u32x4*)(Ks + l_ * 136 + d0) = o;
        o.x = cvt_pk_bf16(b2[0], b2[1]); o.y = cvt_pk_bf16(b2[2], b2[3]); o.z = cvt_pk_bf16(b2[4], b2[5]); o.w = cvt_pk_bf16(b2[6], b2[7]); *(LAS u32x4*)(Ks + l_ * 136 + 64 + d0) = o;
    }
#pragma unroll
    for (int i = 0; i < 2; ++i) { const int ch = tid + i * 512; *(LAS u32x4*)(VT + (ch >> 3) * 72 + (ch & 7) * 8) = vpre[i]; }
#pragma unroll
    for (int i = 0; i < 4; ++i) { const int ch = tid + i * 512; *(LAS u32x4*)(STs + (ch >> 4) * 136 + (ch & 15) * 8) = spre[i]; }
    __syncthreads();
    const int tb = (w & 3) * 16, eh = (w >> 2) * 64;
    const int tl = tb + fr;
    const size_t go = (size_t)(c * 64 + tl) * 512 + h * 128 + eh;
    const u16* zr = (const u16*)(ws + OFF_PROJ) + (size_t)(RT ? T_RTZ : T_MLZ) * S_ * 512 + go; u16* zw = zwb + go;
    const u16* orow = proj + (size_t)T_MLO * S_ * 512 + go;
    u32x2 zpre[4], opre[4];
#pragma unroll
    for (int mt = 0; mt < 4; mt += 2) { ld_pair(zr + mt * 16, quad, zpre[mt], zpre[mt + 1]);
        if (!RT) ld_pair(orow + mt * 16, quad, opre[mt], opre[mt + 1]); else { opre[mt] = zpre[mt]; opre[mt + 1] = zpre[mt + 1]; } }
    f32x4 st[4];
#pragma unroll
    for (int i = 0; i < 4; ++i) st[i] = (f32x4){0.f, 0.f, 0.f, 0.f};
    f32x4 oe[4], oi[4];
#pragma unroll
    for (int i = 0; i < 4; ++i) { oe[i] = (f32x4){0.f, 0.f, 0.f, 0.f}; oi[i] = (f32x4){0.f, 0.f, 0.f, 0.f}; }
#pragma unroll
    for (int ks = 0; ks < 4; ++ks) { const bf16x8 qf = lfrag(Qs, tl, 136, ks * 32 + quad * 8);
#pragma unroll
        for (int mt = 0; mt < 4; ++mt) st[mt] = MFMA16(lfrag(Ks, mt * 16 + fr, 136, ks * 32 + quad * 8), qf, st[mt]);
#pragma unroll
        for (int mt = 0; mt < 4; ++mt) oe[mt] = MFMA16(lfrag(STs, eh + mt * 16 + fr, 136, ks * 32 + quad * 8), qf, oe[mt]); }
    float dsum = 0.f;
    const float lg = log_gamma(h);
    const float rt_ = RT ? 0.f : rowterm[tl];
#pragma unroll
    for (int mt = 0; mt < 4; ++mt)
#pragma unroll
        for (int j = 0; j < 4; ++j) { const int s = mt * 16 + quad * 4 + j; float dec;
            if (RT) dec = fexp(lg * fabsf((float)(tl - s)));
            else dec = (s <= tl) ? fexp(rt_ + colterm[s]) : 0.f;
            const float v = st[mt][j] * dec; st[mt][j] = v; dsum += v; }
#pragma unroll
    for (int k2 = 0; k2 < 2; ++k2) { const bf16x8 pf = pack_p(st[2 * k2], st[2 * k2 + 1]);
#pragma unroll
        for (int mt = 0; mt < 4; ++mt) oi[mt] = MFMA16(lfrag_slot(VT, eh + mt * 16 + fr, 72, k2 * 32, quad), pf, oi[mt]); }
    float cin, cden = 1.0f;
    if (!RT) {
        dsum += __shfl_xor(dsum, 16); dsum += __shfl_xor(dsum, 32);
        float qn = 0.f;
#pragma unroll 8
        for (int i = 0; i < 32; ++i) qn += bf2f(Qs[tl * 136 + quad * 32 + i]) * nprev[quad * 32 + i];
        qn += __shfl_xor(qn, 16); qn += __shfl_xor(qn, 32);
        cin = dinter[tl];
        const float den = cin * qn + dsum;
        cden = 1.0f / fmaxf(fabsf(den), emt[tl]);
    } else cin = fexp(lg * (float)(tl + 1));
    float s1 = 0.f, s2 = 0.f;
#pragma unroll
    for (int mt = 0; mt < 4; ++mt)
#pragma unroll
        for (int j = 0; j < 4; ++j) { const float v = (cin * oe[mt][j] + oi[mt][j]) * cden; oi[mt][j] = v; s1 += v; s2 += v * v; }
    s1 += __shfl_xor(s1, 16); s1 += __shfl_xor(s1, 32); s2 += __shfl_xor(s2, 16); s2 += __shfl_xor(s2, 32);
    if (quad == 0) { red[((w >> 2) * 64 + tl) * 2] = s1; red[((w >> 2) * 64 + tl) * 2 + 1] = s2; }
    __syncthreads();
    const float t1 = red[tl * 2] + red[(64 + tl) * 2], t2 = red[tl * 2 + 1] + red[(64 + tl) * 2 + 1];
    const float mu = t1 * (1.0f / 128.0f); const float var = fmaxf(t2 * (1.0f / 128.0f) - mu * mu, 0.f); const float rstd = rsqrtf(var + EPS);
    u32x2 yv[4];
#pragma unroll
    for (int mt = 0; mt < 4; ++mt) { const u32x2 z = zpre[mt];
        float g0 = siluf_(bf_lo(z.x)), g1 = siluf_(bf_hi(z.x)), g2 = siluf_(bf_lo(z.y)), g3 = siluf_(bf_hi(z.y));
        if (!RT) { const u32x2 ov = opre[mt]; g0 *= sigmoidf_(bf_lo(ov.x)); g1 *= sigmoidf_(bf_hi(ov.x)); g2 *= sigmoidf_(bf_lo(ov.y)); g3 *= sigmoidf_(bf_hi(ov.y)); }
        yv[mt].x = cvt_pk_bf16((oi[mt][0] - mu) * rstd * g0, (oi[mt][1] - mu) * rstd * g1); yv[mt].y = cvt_pk_bf16((oi[mt][2] - mu) * rstd * g2, (oi[mt][3] - mu) * rstd * g3); }
    st_pair(zw, quad, yv[0], yv[1]); st_pair(zw + 32, quad, yv[2], yv[3]);
}

__device__ __forceinline__ void gm_item(const Params& p, int l, int nb, LAS unsigned char* lds, const int tid, u16* zwb) {
    const int lane = tid & 63, w = tid >> 6, fr = lane & 15, quad = lane >> 4;
    unsigned char* ws = p.ws;
    LAS u16* Wm = (LAS u16*)lds;
    LAS u16* VNT = Wm + 128 * 136;
    LAS float* mu_s = (LAS float*)(VNT + 128 * 136);
    LAS float* rs_s = mu_s + 128;
    const u16* V = (const u16*)(ws + OFF_PROJ) + (size_t)T_GMV * S_ * 512 + (size_t)nb * 128 * 512;
    __syncthreads();
    { const int r = tid >> 2, part = tid & 3; float s1 = 0.f, s2 = 0.f;
#pragma unroll 8
      for (int i = 0; i < 16; ++i) { const u32x4 v = *(const u32x4*)(V + (size_t)r * 512 + part * 128 + i * 8);
#pragma unroll
          for (int e = 0; e < 8; ++e) { const float x = geluf_(bfe(v, e)); s1 += x; s2 += x * x; } }
      s1 += __shfl_xor(s1, 1); s1 += __shfl_xor(s1, 2); s2 += __shfl_xor(s2, 1); s2 += __shfl_xor(s2, 2);
      if (part == 0) { const float mu = s1 * (1.0f / 512.0f); const float var = fmaxf(s2 * (1.0f / 512.0f) - mu * mu, 0.f); mu_s[r] = mu; rs_s[r] = rsqrtf(var + EPS); } }
    for (int g = 0; g < 4; ++g) {
    if (g) __syncthreads();
    { const float* wsrc = (const float*)p.in[12] + ((size_t)l * 4 + g) * 16384;
#pragma unroll
      for (int i = 0; i < 4; ++i) { const int ch = tid + i * 512, pr = ch >> 4, q0 = (ch & 15) * 8;
          f32x4 a = *(const f32x4*)(wsrc + pr * 128 + q0), b = *(const f32x4*)(wsrc + pr * 128 + q0 + 4);
          if (pr < 64 && q0 >= 64) { a = (f32x4){0.f, 0.f, 0.f, 0.f}; b = a; }
          u32x4 o; o.x = cvt_pk_bf16(a[0], a[1]); o.y = cvt_pk_bf16(a[2], a[3]); o.z = cvt_pk_bf16(b[0], b[1]); o.w = cvt_pk_bf16(b[2], b[3]);
          *(LAS u32x4*)(Wm + pr * 136 + q0) = o; } }
    __syncthreads();
    { const float* lng = (const float*)p.in[10] + l * 512 + g * 128; const float* lnb = (const float*)p.in[11] + l * 512 + g * 128;
#pragma unroll
      for (int i = 0; i < 4; ++i) { const int q = lane + 64 * (i & 1), c0 = (w + 8 * (i >> 1)) * 8;
          const u32x4 v = *(const u32x4*)(V + (size_t)q * 512 + g * 128 + c0); const float mu = mu_s[q], rs = rs_s[q];
          float a[8];
#pragma unroll
          for (int e = 0; e < 8; ++e) a[e] = (geluf_(bfe(v, e)) - mu) * rs * lng[c0 + e] + lnb[c0 + e];
          st_tr8(VNT, 136, c0, q, a); } }
    __syncthreads();
    const int cb = (w & 3) * 32, ph = (w >> 2) * 64;
    u32x2 upre[4][2], zpre[4][2];
#pragma unroll
    for (int b = 0; b < 4; ++b)
#pragma unroll
        for (int a = 0; a < 2; ++a) { const size_t go = (size_t)(nb * 128 + ph + b * 16 + fr) * 512 + g * 128 + cb + a * 16 + quad * 4;
            upre[b][a] = *(const u32x2*)((const u16*)(ws + OFF_PROJ) + (size_t)T_GMU * S_ * 512 + go); zpre[b][a] = *(const u32x2*)((const u16*)(ws + OFF_PROJ) + (size_t)T_GMZ * S_ * 512 + go); }
    f32x4 acc[2][4];
#pragma unroll
    for (int a = 0; a < 2; ++a)
#pragma unroll
        for (int b = 0; b < 4; ++b) acc[a][b] = (f32x4){0.f, 0.f, 0.f, 0.f};
#pragma unroll
    for (int ks = 0; ks < 4; ++ks) { bf16x8 af[2], bfr[4];
#pragma unroll
        for (int a = 0; a < 2; ++a) af[a] = lfrag(VNT, cb + a * 16 + fr, 136, ks * 32 + quad * 8);
#pragma unroll
        for (int b = 0; b < 4; ++b) bfr[b] = lfrag(Wm, ph + b * 16 + fr, 136, ks * 32 + quad * 8);
#pragma unroll
        for (int a = 0; a < 2; ++a)
#pragma unroll
            for (int b = 0; b < 4; ++b) acc[a][b] = MFMA16(af[a], bfr[b], acc[a][b]); }
    const float* bs = (const float*)p.in[13] + ((size_t)l * 4 + g) * 128;
#pragma unroll
    for (int b = 0; b < 4; ++b) { const int pl = ph + b * 16 + fr; const float bias = bs[pl];
#pragma unroll
        for (int a = 0; a < 2; ++a) { const size_t go = (size_t)(nb * 128 + pl) * 512 + g * 128 + cb + a * 16 + quad * 4;
            const u32x2 uv = upre[b][a], z = zpre[b][a];
            u32x2 r; r.x = cvt_pk_bf16(geluf_(bf_lo(uv.x)) * (acc[a][b][0] + bias) * siluf_(bf_lo(z.x)), geluf_(bf_hi(uv.x)) * (acc[a][b][1] + bias) * siluf_(bf_hi(z.x)));
            r.y = cvt_pk_bf16(geluf_(bf_lo(uv.y)) * (acc[a][b][2] + bias) * siluf_(bf_lo(z.y)), geluf_(bf_hi(uv.y)) * (acc[a][b][3] + bias) * siluf_(bf_hi(z.y)));
            *(u32x2*)(zwb + go) = r; } }
    }
}

__device__ __forceinline__ void xa_item(const Params& p, int sb5, int h, LAS unsigned char* lds, const int tid, u16* zwb) {
    const int lane = tid & 63, w = tid >> 6, fr = lane & 15, quad = lane >> 4;
    unsigned char* ws = p.ws;
    LAS u16* KM = (LAS u16*)lds;
    LAS u16* VT = KM + 256 * 136;
    const u16* MKV = (const u16*)(ws + OFF_MKV);
    u32x4 kpre[8], vpre[8];
#pragma unroll
    for (int i = 0; i < 8; ++i) { const int ch = tid + i * 512, r = ch >> 4, c = ch & 15; kpre[i] = *(const u32x4*)(MKV + (size_t)r * 1024 + h * 128 + c * 8); }
#pragma unroll
    for (int i = 0; i < 8; ++i) { const int ch = tid + i * 512; vpre[i] = *(const u32x4*)(MKV + 256 * 1024 + (size_t)(h * 128 + (ch >> 5)) * 256 + (ch & 31) * 8); }
    __syncthreads();
#pragma unroll
    for (int i = 0; i < 8; ++i) { const int ch = tid + i * 512, r = ch >> 4, c = ch & 15; *(LAS u32x4*)(KM + r * 136 + c * 8) = kpre[i]; }
#pragma unroll
    for (int i = 0; i < 8; ++i) { const int ch = tid + i * 512; *(LAS u32x4*)(VT + (ch >> 5) * 264 + (ch & 31) * 8) = vpre[i]; }
    __syncthreads();
#pragma unroll 1
    for (int sub = 0; sub < 4; ++sub) {
        int row = (sb5 * 4 + sub) * 128 + w * 16 + fr;
        asm volatile("" : "+v"(row));
        const u16* Qr = (const u16*)(ws + OFF_PROJ) + (size_t)T_XAQ * S_ * 512 + (size_t)row * 512 + h * 128 + quad * 8;
        bf16x8 qf[4];
#pragma unroll
        for (int ks = 0; ks < 4; ++ks) qf[ks] = *(const bf16x8*)(Qr + ks * 32);
        const size_t zo = (size_t)row * 512 + h * 128;
        const u16* zr = (const u16*)(ws + OFF_PROJ) + (size_t)T_XAZ * S_ * 512 + zo; u16* zw = zwb + zo;
        u32x2 zpre[8];
#pragma unroll
        for (int mt = 0; mt < 8; mt += 2) ld_pair(zr + mt * 16, quad, zpre[mt], zpre[mt + 1]);
        f32x4 st[16];
#pragma unroll
        for (int i = 0; i < 16; ++i) st[i] = (f32x4){0.f, 0.f, 0.f, 0.f};
#pragma unroll
        for (int ks = 0; ks < 4; ++ks) {
#pragma unroll
            for (int mt = 0; mt < 16; ++mt) st[mt] = MFMA16(lfrag(KM, mt * 16 + fr, 136, ks * 32 + quad * 8), qf[ks], st[mt]); }
        float mx = -1e30f;
#pragma unroll
        for (int mt = 0; mt < 16; ++mt)
#pragma unroll
            for (int j = 0; j < 4; ++j) mx = fmaxf(mx, st[mt][j]);
        mx = fmaxf(mx, __shfl_xor(mx, 16)); mx = fmaxf(mx, __shfl_xor(mx, 32));
        float sum = 0.f;
#pragma unroll
        for (int mt = 0; mt < 16; ++mt)
#pragma unroll
            for (int j = 0; j < 4; ++j) { const float e = fexp(st[mt][j] - mx); st[mt][j] = e; sum += e; }
        sum += __shfl_xor(sum, 16); sum += __shfl_xor(sum, 32);
        f32x4 o[8];
#pragma unroll
        for (int i = 0; i < 8; ++i) o[i] = (f32x4){0.f, 0.f, 0.f, 0.f};
#pragma unroll
        for (int k2 = 0; k2 < 8; ++k2) { const bf16x8 pf = pack_p(st[2 * k2], st[2 * k2 + 1]);
#pragma unroll
            for (int mt = 0; mt < 8; ++mt) o[mt] = MFMA16(lfrag_slot(VT, mt * 16 + fr, 264, k2 * 32, quad), pf, o[mt]); }
        const float inv = 1.0f / sum;
        u32x2 yv[8];
#pragma unroll
        for (int mt = 0; mt < 8; ++mt) { const u32x2 z = zpre[mt];
            yv[mt].x = cvt_pk_bf16(o[mt][0] * inv * siluf_(bf_lo(z.x)), o[mt][1] * inv * siluf_(bf_hi(z.x))); yv[mt].y = cvt_pk_bf16(o[mt][2] * inv * siluf_(bf_lo(z.y)), o[mt][3] * inv * siluf_(bf_hi(z.y))); }
#pragma unroll
        for (int mt = 0; mt < 8; mt += 2) st_pair(zw + mt * 16, quad, yv[mt], yv[mt + 1]);
    }
}

__device__ __forceinline__ int q_pop(unsigned* ctr, LAS int* slot, const int tid) {
    __syncthreads();
    if (tid == 0) *slot = (int)__hip_atomic_fetch_add(ctr, 1u, __ATOMIC_RELAXED, __HIP_MEMORY_SCOPE_AGENT);
    __syncthreads();
    return *slot;
}
constexpr int N_PHASES = 17;
#ifdef DUP_MASK
#define DUPREP rep
#else
#define DUPREP 0
#endif
#ifndef P3MASK
#define P3MASK 15
#endif
#ifndef DUPSEL
#define DUPSEL 15
#endif
#ifndef DUP_PHMAX
#define DUP_PHMAX 16
#endif
#ifndef IMASK
#define IMASK 31
#endif
#ifndef PMASK
#define PMASK 127
#endif
__global__ void __launch_bounds__(512) hybrid_fwd(Params p) {
    extern __shared__ __attribute__((aligned(16))) unsigned char lds_raw[];
    LAS unsigned char* lds = (LAS unsigned char*)lds_raw;
    volatile LAS unsigned* xst = (volatile LAS unsigned*)(lds + LDS_CTL);
    LAS int* qslot = (LAS int*)(lds + LDS_CTL + 32);
    if (p.ph_hi - p.ph_lo > 2) { if (threadIdx.x < 4) xst[threadIdx.x] = 0u; __syncthreads();
        const XcdBarrier b0 = xcd_barrier_post((unsigned*)(p.ws + OFF_BAR), xst); if (threadIdx.x == 0) xst[2] = b0.x; }
    for (int ph = p.ph_lo; ph < p.ph_hi; ++ph) {
        if (ph > p.ph_lo) { if (p.ph_hi > 1000) cg::this_grid().sync();
            else { size_t boff = OFF_BAR; asm volatile("" : "+s"(boff)); unsigned* barp = (unsigned*)(p.ws + boff); XcdBarrier xb;     xb.bar = barp; xb.x = xst[2]; xb.st = xst; xcd_barrier(xb); } }
#ifdef DUP_MASK
        for (int rep = 0; rep < ((ph < DUP_PHMAX) ? 1 + ((DUP_MASK >> (ph % 8)) & 1) : 1); ++rep) { if (rep) __syncthreads();
#endif
        int tid = threadIdx.x, bid = blockIdx.x, nblk = gridDim.x; unsigned char* ws = p.ws;
        size_t wso = 0; asm volatile("" : "+v"(tid), "+s"(bid), "+s"(nblk), "+s"(wso)); ws = p.ws + wso;
        Params q = p; q.ws = ws;
#ifdef DUP_MASK
        const bool dummy = (rep == 0) && (((DUP_MASK >> (ph % 8)) & 1) != 0) && ph < DUP_PHMAX;
#else
        const bool dummy = false;
#endif
#define ZW(T) (dummy ? (u16*)p.out : (u16*)(ws + OFF_PROJ) + (size_t)(T) * S_ * 512)
        if (ph == 16) { if (PMASK & 1) phase_prep(q, 2, lds, tid, bid, nblk); continue; }
        const int l = ph / 8, s = ph % 8;
        if (s == 0) { if (PMASK & 1) phase_prep(q, l, lds, tid, bid, nblk); }
        else if (s == 1) { if (PMASK & 2) {
            pg8::Gemm g{(const u16*)(ws + OFF_H), (const u16*)(ws + OFF_WIN), S_, NPROJ, 1024};
            pg8::StaticOrder so; so.init(S_, NPROJ, nblk, bid);
            EpiProj E{(u16*)(ws + OFF_PROJ), (u16*)(ws + OFF_MKV)};
            pg8::gemm_phase<EpiProj, pg8::StaticOrder>(lds, g, so, E, tid);
        } } else if (s == 2) { if (PMASK & 4) { const int tid_ = tid;
            static_assert(OFF_MEMH == OFF_H + 64ull * 256 * 1024 * 2 && OFF_WMKV == OFF_WIN + 70ull * 256 * 1024 * 2, "the mem_kv GEMM addresses MEMH / WMKV as tile (64, 70..73) of the projection GEMM");
            unsigned* ctr = (unsigned*)(ws + OFF_BAR) + XCD_BAR_WORDS + 64 * (2 * l + 4 * DUPREP);
            { LAS float* cw = (LAS float*)(lds + LDS_CONV); const float* cq = (const float*)p.in[8] + (size_t)l * 2048; const float* ck = (const float*)p.in[9] + (size_t)l * 2048;
              for (int i = tid_; i < 2048; i += 512) { cw[i] = cq[i]; cw[2048 + i] = ck[i]; } }
            int it = q_pop(ctr, qslot, tid_);
            while (it < 4 + 2048) {
                int tid = tid_; asm volatile("" : "+v"(tid));
                unsigned nxt = 0; if (tid_ == 0) nxt = __hip_atomic_fetch_add(ctr, 1u, __ATOMIC_RELAXED, __HIP_MEMORY_SCOPE_AGENT);
                if (it < 4) { pg8::Gemm g{(const u16*)(ws + OFF_H), (const u16*)(ws + OFF_WIN), S_, NPROJ, 1024}; OneUnit ou{64, 70 + it, p.ph_hi > 1000 ? 2 : 1};
                    EpiProj E{(u16*)(ws + OFF_PROJ), (u16*)(ws + OFF_MKV)}; pg8::gemm_phase<EpiProj, OneUnit>(lds, g, ou, E, tid);
                    { LAS float* cw = (LAS float*)(lds + LDS_CONV); const float* cq = (const float*)p.in[8] + (size_t)l * 2048; const float* ck = (const float*)p.in[9] + (size_t)l * 2048;
                      for (int i = tid_; i < 2048; i += 512) { cw[i] = cq[i]; cw[2048 + i] = ck[i]; } } }
                else if (it < 4 + 1024) { const int j = it - 4; kv1_item<false>(q, l, j >> 2, j & 3, lds, tid); }
                else { const int j = it - 4 - 1024; kv1_item<true>(q, l, j >> 2, j & 3, lds, tid); }
                __syncthreads(); if (tid_ == 0) *qslot = (int)nxt; __syncthreads(); it = *qslot;
            }
        } } else if (s == 3) { if (PMASK & 8) { const int tid_ = tid;
            const u16* proj = (const u16*)(ws + OFF_PROJ);
            unsigned* ctr = (unsigned*)(ws + OFF_BAR) + XCD_BAR_WORDS + 64 * (2 * l + 1 + 4 * DUPREP);
            int it = q_pop(ctr, qslot, tid_);
            while (it < 129 + 128 + 512 + 128) {
                int tid = tid_; asm volatile("" : "+v"(tid));
                unsigned nxt = 0; if (tid_ == 0) nxt = __hip_atomic_fetch_add(ctr, 1u, __ATOMIC_RELAXED, __HIP_MEMORY_SCOPE_AGENT);
                if (it < 129) { if ((P3MASK & 1) && (!dummy || (DUPSEL & 1))) scan_item(q, lds, tid, it, dummy); }
                else if (it < 129 + 128) { const int j = it - 129; if ((P3MASK & 8) && (!dummy || (DUPSEL & 8))) xa_item(q, j >> 2, j & 3, lds, tid, ZW(T_XAZ)); }
                else if (it < 129 + 256) { if ((P3MASK & 2) && (!dummy || (DUPSEL & 2))) gm_item(q, l, it - 257, lds, tid, ZW(T_GMZ)); }
                else { const int j = it - 385; if ((P3MASK & 4) && (!dummy || (DUPSEL & 4))) sb_item(proj + (size_t)T_SBQ * S_ * 512, proj + (size_t)T_SBK * S_ * 512, proj + (size_t)T_SBV * S_ * 512, proj + (size_t)T_SBZ * S_ * 512, ZW(T_SBZ), j >> 2, j & 3, lds, tid); }
                __syncthreads(); if (tid_ == 0) *qslot = (int)nxt; __syncthreads(); it = *qslot;
            }
        } }
        else if (s == 4) { if (PMASK & 16) { const int tid_ = tid;
            { LAS float* cw = (LAS float*)(lds + LDS_CONV); const float* cq = (const float*)p.in[8] + (size_t)l * 2048; const float* ck = (const float*)p.in[9] + (size_t)l * 2048;
              for (int i = tid_; i < 2048; i += 512) { cw[i] = cq[i]; cw[2048 + i] = ck[i]; } __syncthreads(); }
            for (int it = bid; it < 2048; it += nblk) {
                int tid = tid_; asm volatile("" : "+v"(tid));
                const int itn = it + nblk; const bool same = (itn < 2048) && ((itn < 1024) == (it < 1024)); const int jn = itn < 1024 ? itn : itn - 1024;
                if (it < 1024) { if (!dummy || (DUPSEL & 1)) out3_item<false>(q, l, it >> 2, it & 3, lds, tid, ZW(T_MLZ), same ? (jn >> 2) : -1, jn & 3); }
                else { const int j = it - 1024; if (!dummy || (DUPSEL & 2)) out3_item<true>(q, l, j >> 2, j & 3, lds, tid, ZW(T_RTZ), same ? (jn >> 2) : -1, jn & 3); }
            }
        } } else if (s == 5) { if (PMASK & 32) {
            pg8::Gemm g{(const u16*)(ws + OFF_H), (const u16*)(ws + OFF_WIN) + (size_t)NPROJ * 1024, S_, 5120, 1024};
            pg8::StaticOrder so; so.init(S_, 5120, nblk, bid);
            EpiGateE E{(u16*)(ws + OFF_PROJ)};
            pg8::gemm_phase<EpiGateE, pg8::StaticOrder>(lds, g, so, E, tid);
        } } else if (s == 6) { if (PMASK & 32) {
            pg8::Gemm g{(const u16*)(ws + OFF_PROJ), (const u16*)(ws + OFF_WUP), S_, 1024, 512};
            UpOrder so; so.init(S_, 1024, nblk, bid);
            EpiMerge E{(const u16*)(ws + OFF_PROJ), (u16*)(ws + OFF_MERGED)};
            pg8::gemm_phase<EpiMerge, UpOrder>(lds, g, so, E, tid);
        } } else { if (PMASK & 64) {
            pg8::Gemm g{(const u16*)(ws + OFF_MERGED), (const u16*)(ws + OFF_WOUT), S_, 1024, 1024};
            pg8::StaticOrder so; so.init(S_, 1024, nblk, bid);
            EpiF32 E{(float*)(ws + OFF_OUTF), 1024};
            pg8::gemm_phase<EpiF32, pg8::StaticOrder>(lds, g, so, E, tid);
        } }
#ifdef DUP_MASK
        }
#endif
    }
}

#ifdef DBG_K
__global__ void dbg_dump(const unsigned* ws, float* out, size_t nwords, int n) {
    for (int i = blockIdx.x * blockDim.x + threadIdx.x; i < n; i += gridDim.x * blockDim.x) {
        unsigned s = 0; for (size_t k = i; k < nwords; k += (size_t)n) s += ws[k] * 2654435761u + (ws[k] >> 16);
        out[i] = (float)(s & 0xFFFFFu); }
}
#endif
extern "C" void kernel_launch(void* const* d_in, const int* in_sizes, int n_in, void* d_out, int out_size, void* d_ws, size_t ws_size, hipStream_t stream) {
    static int grid = 0;
    if (grid == 0) {
        if (n_in != 18 || out_size != S_ * DM || ws_size < WS_END) { fprintf(stderr, "kernel_launch: unexpected shapes / workspace (%d inputs, out %d, ws %zu < %zu)\n", n_in, out_size, ws_size, (size_t)WS_END); grid = -1; return; }
        int dev = 0, cus = 0, per_cu = 0;
        (void)hipGetDevice(&dev); (void)hipDeviceGetAttribute(&cus, hipDeviceAttributeMultiprocessorCount, dev);
        if (hipFuncSetAttribute((const void*)hybrid_fwd, hipFuncAttributeMaxDynamicSharedMemorySize, LDS_BYTES) != hipSuccess) { fprintf(stderr, "kernel_launch: hipFuncSetAttribute failed\n"); grid = -1; return; }
        if (hipOccupancyMaxActiveBlocksPerMultiprocessor(&per_cu, (const void*)hybrid_fwd, 512, LDS_BYTES) != hipSuccess || per_cu < 1) per_cu = 1;
        (void)hipGetLastError();
        grid = cus * per_cu; if (grid > 256) grid = 256; if (grid < 4) grid = 4;
    }
    if (grid < 0) return;
    (void)hipMemsetAsync((unsigned char*)d_ws + OFF_BAR, 0, 16384, stream);
    Params p{};
    for (int i = 0; i < 18; ++i) p.in[i] = d_in[i];
    p.out = (float*)d_out; p.ws = (unsigned char*)d_ws;
#if ONE_LAUNCH
    p.ph_lo = 0; p.ph_hi = N_PHASES;
    void* args[] = {&p};
    hipError_t e = hipLaunchCooperativeKernel((const void*)hybrid_fwd, dim3(grid), dim3(512), args, LDS_BYTES, stream);
    if (e != hipSuccess) fprintf(stderr, "cooperative launch failed: %s (grid %d)\n", hipGetErrorString(e), grid);
#else
#ifdef DBG_K
    for (int ph = 0; ph < DBG_K; ++ph) { p.ph_lo = ph; p.ph_hi = ph + 1; hipLaunchKernelGGL(hybrid_fwd, dim3(grid), dim3(512), LDS_BYTES, stream, p); }
    hipLaunchKernelGGL(dbg_dump, dim3(2048), dim3(256), 0, stream, (const unsigned*)d_ws, (float*)d_out, (size_t)(WS_END / 4), out_size);
#else
    for (int ph = 0; ph < N_PHASES; ++ph) { p.ph_lo = ph; p.ph_hi = ph + 1; hipLaunchKernelGGL(hybrid_fwd, dim3(grid), dim3(512), LDS_BYTES, stream, p); }
#endif
#endif
}
```

```cpp
#include <hip/hip_runtime.h>
#include <hip/hip_cooperative_groups.h>
#include <cstdio>
namespace cg = cooperative_groups;
#ifndef ONE_LAUNCH
#define ONE_LAUNCH 1
#endif
namespace pg8 {
#define PG8_LAS __attribute__((address_space(3)))
typedef unsigned short bf16_t;
typedef short bf16x8 __attribute__((ext_vector_type(8)));
typedef float f32x4 __attribute__((ext_vector_type(4)));
typedef unsigned u32x4 __attribute__((ext_vector_type(4)));
constexpr int BM = 256, BK = 64, HALF = 128, HTB = HALF * BK * 2  , STAGE_BYTES = 8 * HTB, NXCD = 8, WGM = 8;

__host__ __device__ __forceinline__ int lds_byte(int r, int c) { const int st = (r >> 4) * 2 + (c >> 5), rr = r & 15, cc = c & 31, ob = rr * 64 + cc * 2; return st * 1024 + (ob ^ (((ob >> 9) & 1) << 5)); }
__host__ __device__ __forceinline__ void stage_rc(int b, int& R, int& C) { const int st = b / 1024, sb = b % 1024, swz = sb ^ (((sb >> 9) & 1) << 5); R = (st >> 1) * 16 + swz / 64; C = (st & 1) * 32 + (swz % 64) / 2; }
__host__ __device__ __forceinline__ int perm32(int rho) { const int n = rho >> 4, i = rho & 15; return 8 * (i >> 2) + 4 * n + (i & 3); }

struct Unit { int pm, pn, n; };
struct Gemm { const bf16_t* A; const bf16_t* Bt; int M, N, K; };

struct StaticOrder {
    int nM, nN, nwg, G, c;
    __host__ __device__ __forceinline__ void init(int M, int N, int G_, int c_) { nM = M / BM; nN = N / BM; nwg = nM * nN; G = G_; c = c_; }
    __host__ __device__ __forceinline__ bool next(int i, Unit& u) const {
        const long L = (long)i * G + c; if (L >= nwg) return false;
        int wgid = (int)L; { const int q = nwg / NXCD, r = nwg % NXCD, xcd = wgid % NXCD, off = wgid / NXCD; wgid = (xcd < r ? xcd * (q + 1) : r * (q + 1) + (xcd - r) * q) + off; }
        const int nig = WGM * nN, gid = wgid / nig, fm = gid * WGM, gsz = (nM - fm) < WGM ? (nM - fm) : WGM;
        u.pm = fm + ((wgid % nig) % gsz); u.pn = (wgid % nig) / gsz; return true;
    }
    __device__ __forceinline__ void a_ready(const Unit&) const {}
    __device__ __forceinline__ void done(const Unit&) const {}
    __device__ __forceinline__ const char* abase(const Gemm& g, const Unit& u, size_t tstep) const { return (const char*)g.A + (size_t)u.pm * tstep; }
    __device__ __forceinline__ const char* bbase(const Gemm& g, const Unit& u, size_t tstep) const { return (const char*)g.Bt + (size_t)u.pn * tstep; }
};

typedef __bf16 bf16v2_t __attribute__((ext_vector_type(2)));
typedef float f32v2_t __attribute__((ext_vector_type(2)));
__device__ __forceinline__ unsigned cvt_pk_bf16(float lo, float hi) { const f32v2_t v = {lo, hi}; const bf16v2_t r = __builtin_convertvector(v, bf16v2_t); return __builtin_bit_cast(unsigned, r); }
template <class Epi, class Sched, bool ALIGN_EPI = true, bool SP2 = true>
__device__ __forceinline__ void gemm_phase(PG8_LAS unsigned char* lds, const Gemm g, const Sched& S, const Epi& E, const int tid) {
    const int wid = __builtin_amdgcn_readfirstlane(tid >> 6), lane = tid & 63, wr = wid >> 2, wc = wid & 3, fr = lane & 15, fq = lane >> 4;
    const int K = g.K, nt = K / BK;
    unsigned voffA[2], voffB[2];
#pragma unroll
    for (int i = 0; i < 2; ++i) { int R, C; stage_rc(tid * 16 + i * 8192, R, C); const int Rb = Epi::PERM ? ((R & ~31) + perm32(R & 31)) : R;
        voffA[i] = (unsigned)(R * K + C) * 2u; voffB[i] = (unsigned)(Rb * K + C) * 2u; }
    const size_t kstep = (size_t)(BK * 2);
    const size_t hstep = (size_t)HALF * K * 2;
    const size_t tstep = 2 * hstep;
    const unsigned ldsw = (unsigned)wid * 1024u;
    const int aoff = lds_byte(wr * 64 + fr, fq * 8), boff = lds_byte(wc * 32 + fr, fq * 8);
#define PG8_SA(b, h) (((b) * 2 + (h)) * HTB)
#define PG8_SB(b, h) ((4 + (b) * 2 + (h)) * HTB)
#define PG8_STAGE(bufoff, gbase, voff) do { _Pragma("unroll") for (int _i = 0; _i < 2; ++_i) \
        __builtin_amdgcn_global_load_lds((const unsigned*)((const char*)(gbase) + (voff)[_i]), (PG8_LAS unsigned*)(lds + (bufoff) + ldsw + _i * 8192), 16, 0, 0); } while (0)
#define PG8_LDA(dst, b, h) do { _Pragma("unroll") for (int m = 0; m < 4; ++m) _Pragma("unroll") for (int k = 0; k < 2; ++k) dst[m][k] = *(const PG8_LAS bf16x8*)(lds + PG8_SA(b, h) + aoff + m * 2048 + k * 1024); } while (0)
#define PG8_LDB(dst, b, h) do { _Pragma("unroll") for (int n = 0; n < 2; ++n) _Pragma("unroll") for (int k = 0; k < 2; ++k) dst[n][k] = *(const PG8_LAS bf16x8*)(lds + PG8_SB(b, h) + boff + n * 2048 + k * 1024); } while (0)
#define PG8_MMA(ai, bj, At, Bt) do { __builtin_amdgcn_s_setprio(1); _Pragma("unroll") for (int m = 0; m < 4; ++m) _Pragma("unroll") for (int n = 0; n < 2; ++n) _Pragma("unroll") for (int k = 0; k < 2; ++k) \
        acc[ai][bj][m][n] = __builtin_amdgcn_mfma_f32_16x16x32_bf16(Bt[n][k], At[m][k], acc[ai][bj][m][n], 0, 0, 0); __builtin_amdgcn_s_setprio(0); } while (0)
#define PG8_WAIT_V(n) asm volatile("s_waitcnt vmcnt(" #n ")" ::: "memory")
#define PG8_WAIT_L(n) asm volatile("s_waitcnt lgkmcnt(" #n ")" ::: "memory")
#define PG8_BAR __builtin_amdgcn_s_barrier()
#define PG8_SCHED __builtin_amdgcn_sched_barrier(0)
    Unit cur, nxt; int ui = 0;
    if (!S.next(0, cur)) return;
    f32x4 acc[2][2][4][2];
#pragma unroll
    for (int a = 0; a < 2; ++a)
#pragma unroll
        for (int b = 0; b < 2; ++b)
#pragma unroll
            for (int m = 0; m < 4; ++m)
#pragma unroll
                for (int n = 0; n < 2; ++n) acc[a][b][m][n] = (f32x4){0.f, 0.f, 0.f, 0.f};
    bf16x8 At[4][2], B0[2][2], B1[2][2];
    const char* cA = S.abase(g, cur, tstep); const char* cB = S.bbase(g, cur, tstep);
    S.a_ready(cur);
    if constexpr (SP2) {
        PG8_STAGE(PG8_SB(0, 0), cB, voffB); PG8_STAGE(PG8_SB(0, 1), cB + hstep, voffB); PG8_STAGE(PG8_SA(0, 0), cA, voffA); PG8_STAGE(PG8_SA(0, 1), cA + hstep, voffA);
        if (wr == 1) PG8_BAR;
        PG8_WAIT_V(2); PG8_BAR;
        PG8_STAGE(PG8_SB(1, 0), cB + kstep, voffB); PG8_STAGE(PG8_SA(1, 0), cA + kstep, voffA); PG8_STAGE(PG8_SB(1, 1), cB + hstep + kstep, voffB);
        PG8_WAIT_V(6); PG8_BAR;
    } else {
        PG8_STAGE(PG8_SB(0, 0), cB, voffB); PG8_STAGE(PG8_SA(0, 0), cA, voffA); PG8_STAGE(PG8_SB(0, 1), cB + hstep, voffB); PG8_STAGE(PG8_SA(0, 1), cA + hstep, voffA);
        if (wr == 1) PG8_BAR;
        PG8_WAIT_V(4); PG8_BAR;
        PG8_STAGE(PG8_SB(1, 0), cB + kstep, voffB); PG8_STAGE(PG8_SA(1, 0), cA + kstep, voffA); PG8_STAGE(PG8_SB(1, 1), cB + hstep + kstep, voffB);
        PG8_WAIT_V(6); PG8_BAR;
    }
    for (;;) {
        const bool has_next = S.next(ui + 1, nxt);
        const char* nA = has_next ? S.abase(g, nxt, tstep) : cA; const char* nB = has_next ? S.bbase(g, nxt, tstep) : cB;
        for (int t = 0; t < nt; t += 2) {
            const bool last = (t == nt - 2);
            const char* a1 = cA + (size_t)(t + 1) * kstep;
            const char* a2 = last ? nA : cA + (size_t)(t + 2) * kstep; const char* b2 = last ? nB : cB + (size_t)(t + 2) * kstep;
            const char* a3 = a2 + kstep; const char* b3 = b2 + kstep;
            if (last && has_next) S.a_ready(nxt);
            if constexpr (SP2) {
            PG8_LDB(B0, 0, 0); PG8_LDB(B1, 0, 1); PG8_SCHED; PG8_LDA(At, 0, 0); PG8_STAGE(PG8_SA(1, 1), a1 + hstep, voffA);
            PG8_WAIT_V(8); PG8_WAIT_L(0); PG8_BAR; PG8_MMA(0, 0, At, B0); PG8_MMA(0, 1, At, B1); PG8_BAR; PG8_SCHED;
            PG8_LDA(At, 0, 1); PG8_STAGE(PG8_SB(0, 0), b2, voffB); PG8_STAGE(PG8_SB(0, 1), b2 + hstep, voffB); PG8_STAGE(PG8_SA(0, 0), a2, voffA);
            PG8_WAIT_V(8); PG8_WAIT_L(0); PG8_BAR; PG8_MMA(1, 0, At, B0); PG8_MMA(1, 1, At, B1); PG8_BAR; PG8_SCHED;
            PG8_LDB(B0, 1, 0); PG8_LDB(B1, 1, 1); PG8_SCHED; PG8_LDA(At, 1, 0); PG8_STAGE(PG8_SA(0, 1), a2 + hstep, voffA);
            PG8_WAIT_V(8); PG8_WAIT_L(0); PG8_BAR; PG8_MMA(0, 0, At, B0); PG8_MMA(0, 1, At, B1); PG8_BAR; PG8_SCHED;
            PG8_LDA(At, 1, 1); PG8_STAGE(PG8_SB(1, 0), b3, voffB); PG8_STAGE(PG8_SB(1, 1), b3 + hstep, voffB); PG8_STAGE(PG8_SA(1, 0), a3, voffA);
            PG8_WAIT_V(8); PG8_WAIT_L(0); PG8_BAR; PG8_MMA(1, 0, At, B0); PG8_MMA(1, 1, At, B1); PG8_BAR; PG8_SCHED;
            } else {
            PG8_LDB(B0, 0, 0); PG8_SCHED; PG8_LDA(At, 0, 0); PG8_STAGE(PG8_SA(1, 1), a1 + hstep, voffA);
            PG8_WAIT_L(8); PG8_BAR; PG8_WAIT_L(0); PG8_MMA(0, 0, At, B0); PG8_BAR; PG8_SCHED;
            PG8_LDB(B1, 0, 1); PG8_STAGE(PG8_SB(0, 0), b2, voffB);
            PG8_BAR; PG8_WAIT_L(0); PG8_MMA(0, 1, At, B1); PG8_BAR;
            PG8_LDA(At, 0, 1); PG8_STAGE(PG8_SA(0, 0), a2, voffA);
            PG8_BAR; PG8_WAIT_L(0); PG8_MMA(1, 0, At, B0); PG8_BAR; PG8_SCHED;
            PG8_STAGE(PG8_SB(0, 1), b2 + hstep, voffB);
            PG8_WAIT_V(6); PG8_BAR; PG8_MMA(1, 1, At, B1); PG8_BAR;
            PG8_LDB(B0, 1, 0); PG8_SCHED; PG8_LDA(At, 1, 0); PG8_STAGE(PG8_SA(0, 1), a2 + hstep, voffA);
            PG8_WAIT_L(8); PG8_BAR; PG8_WAIT_L(0); PG8_MMA(0, 0, At, B0); PG8_BAR; PG8_SCHED;
            PG8_LDB(B1, 1, 1); PG8_STAGE(PG8_SB(1, 0), b3, voffB);
            PG8_BAR; PG8_WAIT_L(0); PG8_MMA(0, 1, At, B1); PG8_BAR;
            PG8_LDA(At, 1, 1); PG8_STAGE(PG8_SA(1, 0), a3, voffA);
            PG8_BAR; PG8_WAIT_L(0); PG8_MMA(1, 0, At, B0); PG8_BAR; PG8_SCHED;
            PG8_STAGE(PG8_SB(1, 1), b3 + hstep, voffB);
            PG8_WAIT_V(6); PG8_BAR; PG8_MMA(1, 1, At, B1); PG8_BAR;
            }
        }
        if constexpr (ALIGN_EPI) { if (wr == 0) PG8_BAR; }
        if constexpr (!Epi::AFTER_DRAIN) { E(acc, cur, wr, wc, fr, fq); S.done(cur); }
        if (!has_next) break;
        bool zero_acc = true;
        if constexpr (Epi::KEEPS) zero_acc = !E.keep(cur);
        if (zero_acc) {
#pragma unroll
        for (int a = 0; a < 2; ++a)
#pragma unroll
            for (int b = 0; b < 2; ++b)
#pragma unroll
                for (int m = 0; m < 4; ++m)
#pragma unroll
                    for (int n = 0; n < 2; ++n) acc[a][b][m][n] = (f32x4){0.f, 0.f, 0.f, 0.f};
        }
        cur = nxt; cA = nA; cB = nB; ++ui;
        if constexpr (ALIGN_EPI) { if (wr == 1) PG8_BAR; }
    }
    PG8_WAIT_V(0);
    if constexpr (!ALIGN_EPI) { if (wr == 0) PG8_BAR; }
    PG8_BAR;
    if constexpr (Epi::AFTER_DRAIN) { E.fused(acc, cur, wr, wc, fr, fq, lds, wid, lane); S.done(cur); }
#undef PG8_SA
#undef PG8_SB
#undef PG8_STAGE
#undef PG8_LDA
#undef PG8_LDB
#undef PG8_MMA
#undef PG8_WAIT_V
#undef PG8_WAIT_L
#undef PG8_BAR
#undef PG8_SCHED
}
}

#define LAS __attribute__((address_space(3)))
typedef unsigned short u16;
typedef short bf16x8 __attribute__((ext_vector_type(8)));
typedef short s16x4 __attribute__((ext_vector_type(4)));
typedef float f32x4 __attribute__((ext_vector_type(4)));
typedef unsigned u32x4 __attribute__((ext_vector_type(4)));
typedef unsigned u32x2 __attribute__((ext_vector_type(2)));
using pg8::cvt_pk_bf16;

constexpr int S_ = 16384, DM = 1024, BW = 512, HD = 128, NCH = 256, DIN = 14344;
constexpr int NPROJ = 9216, NWIN = 14336;
constexpr float EPS = 1e-6f;
constexpr float QSCALE = 0.08838834764831845f;
constexpr int LDS_BYTES = 147456, LDS_CTL = LDS_BYTES - 64;

constexpr size_t OFF_WIN = 0;
constexpr size_t SZ_WIN = (size_t)NWIN * 1024 * 2;
constexpr size_t OFF_WUP = OFF_WIN + SZ_WIN;
constexpr size_t SZ_WUP = 5ull * 1024 * 512 * 2;
constexpr size_t OFF_WOUT = OFF_WUP + SZ_WUP;
constexpr size_t SZ_WSQ = 1024ull * 1024 * 2;
constexpr size_t OFF_WMKV = OFF_WOUT + SZ_WSQ;
constexpr size_t OFF_H = OFF_WMKV + SZ_WSQ;
constexpr size_t SZ_H = (size_t)S_ * 1024 * 2;
constexpr size_t OFF_MEMH = OFF_H + SZ_H;
constexpr size_t OFF_MKV = OFF_MEMH + 256 * 1024 * 2;
constexpr size_t OFF_IF = OFF_MKV + 256 * 1024 * 2 + 512 * 256 * 2;
constexpr size_t OFF_SC = OFF_IF + (size_t)S_ * 8 * 4;
constexpr size_t OFF_NST = OFF_SC + 3 * 4 * 256 * 4;
constexpr size_t OFF_PROJ = OFF_NST + 4 * 256 * 128 * 4;
constexpr size_t SZ_T = (size_t)S_ * 512 * 2;
constexpr size_t OFF_KV = OFF_PROJ + 18 * SZ_T;
constexpr size_t SZ_KV = 2ull * 4 * 256 * 128 * 128 * 2;
constexpr size_t OFF_BAR = OFF_KV + SZ_KV;
constexpr size_t OFF_GATES = OFF_BAR + 16384;
constexpr size_t WS_END = OFF_GATES + 4ull * 16384 * 2 * 4;
constexpr int LDS_CONV = 98304;
constexpr size_t OFF_MERGED = OFF_KV;
constexpr size_t OFF_MSCR = OFF_PROJ + 4 * SZ_T;
constexpr size_t OFF_GSCR = OFF_PROJ + 9 * SZ_T;
constexpr size_t OFF_OUTF = OFF_PROJ + 4 * SZ_T;
static_assert(OFF_PROJ % 256 == 0 && OFF_KV % 256 == 0, "align");

enum { T_SBQ = 0, T_SBK, T_SBV, T_SBZ, T_MLQ, T_MLK, T_MLV, T_MLO, T_MLZ, T_GMU, T_GMV, T_GMZ, T_RTQ, T_RTK, T_RTV, T_RTZ, T_XAQ, T_XAZ };

__device__ const float INVF[64] = {
1.000000000e+00f, 8.659643531e-01f, 7.498942614e-01f, 6.493816376e-01f, 5.623413324e-01f, 4.869675338e-01f, 4.216965139e-01f, 3.651741147e-01f, 3.162277639e-01f, 2.738419771e-01f, 2.371373773e-01f, 2.053525001e-01f, 1.778279394e-01f, 1.539926529e-01f, 1.333521307e-01f, 1.154782027e-01f, 1.000000015e-01f, 8.659642935e-02f, 7.498941571e-02f, 6.493816525e-02f, 5.623413250e-02f, 4.869675264e-02f, 4.216965288e-02f, 3.651741147e-02f, 3.162277490e-02f, 2.738419734e-02f, 2.371373773e-02f, 2.053525113e-02f, 1.778279431e-02f, 1.539926510e-02f, 1.333521493e-02f, 1.154782064e-02f, 9.999999776e-03f, 8.659643121e-03f, 7.498941850e-03f, 6.493816152e-03f, 5.623413250e-03f, 4.869675264e-03f, 4.216964822e-03f, 3.651741194e-03f, 3.162277630e-03f, 2.738419687e-03f, 2.371373586e-03f, 2.053524833e-03f, 1.778279431e-03f, 1.539926510e-03f, 1.333521446e-03f, 1.154781901e-03f, 1.000000047e-03f, 8.659643354e-04f, 7.498942432e-04f, 6.493816618e-04f, 5.623413017e-04f, 4.869675322e-04f, 4.216965172e-04f, 3.651741426e-04f, 3.162277571e-04f, 2.738419571e-04f, 2.371373703e-04f, 2.053525095e-04f, 1.778279402e-04f, 1.539926452e-04f, 1.333521504e-04f, 1.154782003e-04f };
__device__ __forceinline__ float log_gamma(int h) { return h == 0 ? -3.174869716e-02f : h == 1 ? -1.574835740e-02f : h == 2 ? -7.843177766e-03f : -3.913899418e-03f; }

struct Params { const void* in[18]; float* out; unsigned char* ws; int ph_lo, ph_hi; };

__device__ __forceinline__ float bf_lo(unsigned w) { return __uint_as_float(w << 16); }
__device__ __forceinline__ float bf_hi(unsigned w) { return __uint_as_float(w & 0xffff0000u); }
__device__ __forceinline__ float bf2f(u16 b) { return __uint_as_float(((unsigned)b) << 16); }
__device__ __forceinline__ float fexp(float x) { return __expf(x); }
__device__ __forceinline__ float sigmoidf_(float x) { return __builtin_amdgcn_rcpf(1.0f + __expf(-x)); }
__device__ __forceinline__ float siluf_(float x) { return x * __builtin_amdgcn_rcpf(1.0f + __expf(-x)); }
__device__ __forceinline__ float geluf_(float v) { return v * sigmoidf_(1.5957691216057308f * (v + 0.044715f * v * v * v)); }
__device__ __forceinline__ float softplusf_(float z) { return fmaxf(z, 0.f) + __logf(1.0f + __expf(-fabsf(z))); }
__device__ __forceinline__ float wave_sum(float v) {
#pragma unroll
    for (int o = 1; o < 64; o <<= 1) v += __shfl_xor(v, o);
    return v;
}
#define LDS_WAIT() asm volatile("s_waitcnt lgkmcnt(0)" ::: "memory")
#define LBAR() do { asm volatile("s_waitcnt lgkmcnt(0)" ::: "memory"); __builtin_amdgcn_s_barrier(); asm volatile("" ::: "memory"); } while (0)
#define MFMA16(a, b, c) __builtin_amdgcn_mfma_f32_16x16x32_bf16((a), (b), (c), 0, 0, 0)
__device__ __forceinline__ bf16x8 lfrag(const LAS u16* base, int row, int ld, int kofs) { return *(const LAS bf16x8*)(base + row * ld + kofs); }
__device__ __forceinline__ bf16x8 lfrag_slot(const LAS u16* base, int row, int ld, int kb, int quad) {
    const s16x4 lo = *(const LAS s16x4*)(base + row * ld + kb + quad * 4);
    const s16x4 hi = *(const LAS s16x4*)(base + row * ld + kb + 16 + quad * 4);
    bf16x8 r; r[0] = lo[0]; r[1] = lo[1]; r[2] = lo[2]; r[3] = lo[3]; r[4] = hi[0]; r[5] = hi[1]; r[6] = hi[2]; r[7] = hi[3]; return r;
}
__device__ __forceinline__ bf16x8 pack_p(const f32x4 a, const f32x4 b) {
    u32x4 w; w.x = cvt_pk_bf16(a[0], a[1]); w.y = cvt_pk_bf16(a[2], a[3]); w.z = cvt_pk_bf16(b[0], b[1]); w.w = cvt_pk_bf16(b[2], b[3]);
    return __builtin_bit_cast(bf16x8, w);
}
__device__ __forceinline__ float bfe(const u32x4 v, int e) { const unsigned w = v[e >> 1]; return (e & 1) ? bf_hi(w) : bf_lo(w); }
__device__ __forceinline__ void st_tr8(LAS u16* XT, int ld, int c0, int row, const float (&val)[8]) {
#pragma unroll
    for (int e = 0; e < 8; e += 2) { const unsigned w = cvt_pk_bf16(val[e], val[e + 1]); XT[(c0 + e) * ld + row] = (u16)(w & 0xffffu); XT[(c0 + e + 1) * ld + row] = (u16)(w >> 16); }
}
__device__ __forceinline__ void st_tr8_raw(LAS u16* XT, int ld, int c0, int row, const u32x4 v) {
#pragma unroll
    for (int e = 0; e < 4; ++e) { XT[(c0 + 2 * e) * ld + row] = (u16)(v[e] & 0xffffu); XT[(c0 + 2 * e + 1) * ld + row] = (u16)(v[e] >> 16); }
}
#include <cstdint>
#include <cstdlib>
#include <vector>

#define XB_TMO      128
#define XB_XCNT(j)  (256  + 64 * (j))
#define XB_XSUB(j)  (1280 + 64 * (j))
#define XB_XGEN(j)  (2304 + 64 * (j))
#define XB_TOP      3328
#define XB_TOPGEN   3392
#define XCD_BAR_WORDS 3456
#define XB_SPIN_CAP (1u << 18)

__device__ __forceinline__ unsigned xb_ld(unsigned* p)              { return __hip_atomic_load(p, __ATOMIC_RELAXED, __HIP_MEMORY_SCOPE_AGENT); }
__device__ __forceinline__ unsigned xb_add(unsigned* p, unsigned v) { return __hip_atomic_fetch_add(p, v, __ATOMIC_RELAXED, __HIP_MEMORY_SCOPE_AGENT); }
__device__ __forceinline__ unsigned xb_xcc_id() { return (unsigned)__builtin_amdgcn_s_getreg((3 << 11) | 20) & 0xFu; }
#define XB_SPIN(cond, bar) do { unsigned _sp = 0; while (cond) { __builtin_amdgcn_s_sleep(1); \
    if ((++_sp & 255u) == 0u) { if (xb_ld(&(bar)[XB_TMO])) break; if (_sp > XB_SPIN_CAP) { atomicAdd(&(bar)[XB_TMO], 1u); break; } } } } while (0)

struct XcdBarrier {
    unsigned* bar; unsigned x;
    volatile LAS unsigned* st;
};

__device__ __forceinline__ XcdBarrier xcd_barrier_post(unsigned* bar, volatile LAS unsigned* st) {
    XcdBarrier b; b.bar = bar; b.x = xb_xcc_id(); b.st = st;
    if (threadIdx.x == 0) (void)xb_add(&bar[XB_XCNT(b.x)], 1u);
    return b;
}
__device__ __forceinline__ void xcd_barrier_complete(unsigned* bar, unsigned x, unsigned& nloc, unsigned& nx) {
    const unsigned G = gridDim.x * gridDim.y * gridDim.z;
    unsigned sum, cnt, mine, sp = 0u;
    for (;;) {
        sum = 0u; cnt = 0u; mine = 0u;
#pragma unroll
        for (unsigned j = 0; j < 16; ++j) { const unsigned c = xb_ld(&bar[XB_XCNT(j)]); sum += c; cnt += (c > 0u) ? 1u : 0u; mine = (j == x) ? c : mine; }
        if (sum == G) break;
        __builtin_amdgcn_s_sleep(1);
        if ((++sp & 255u) == 0u) { if (xb_ld(&bar[XB_TMO])) break; if (sp > XB_SPIN_CAP) { atomicAdd(&bar[XB_TMO], 1u); break; } }
    }
    nloc = mine > 0u ? mine : 1u; nx = cnt > 0u ? cnt : 1u;
}

__device__ __forceinline__ void xcd_barrier(const XcdBarrier& b) {
    asm volatile("s_waitcnt vmcnt(0)" ::: "memory");
    __syncthreads();
    if (threadIdx.x == 0) {
        unsigned* bar = b.bar;
        __builtin_amdgcn_s_waitcnt(0);
        unsigned nloc = b.st[0], nx = b.st[1];
        if (nloc == 0u) { xcd_barrier_complete(bar, b.x, nloc, nx); b.st[0] = nloc; b.st[1] = nx; }
        const unsigned old = xb_add(&bar[XB_XSUB(b.x)], 1u);
        const unsigned gen = old / nloc;
        if (old + 1u == (gen + 1u) * nloc) {
            __builtin_amdgcn_fence(__ATOMIC_RELEASE, "agent");
            asm volatile("s_waitcnt vmcnt(0)" ::: "memory");
            const unsigned og = xb_add(&bar[XB_TOP], 1u);
            const unsigned tg = og / nx;
            if (og + 1u == (tg + 1u) * nx) xb_add(&bar[XB_TOPGEN], 1u);
            else XB_SPIN(xb_ld(&bar[XB_TOPGEN]) == tg, bar);
            __builtin_amdgcn_fence(__ATOMIC_ACQUIRE, "agent");
            xb_add(&bar[XB_XGEN(b.x)], 1u);
            asm volatile("s_waitcnt vmcnt(0)" ::: "memory");
        } else {
            XB_SPIN(xb_ld(&bar[XB_XGEN(b.x)]) == gen, bar);
            __builtin_amdgcn_fence(__ATOMIC_ACQUIRE, "agent");
            asm volatile("s_waitcnt vmcnt(0)" ::: "memory");
        }
    }
    __syncthreads();
}

__device__ __forceinline__ float act_apply(float v, int mode) {
    if (mode == 0) return v;
    if (mode == 1) return v * QSCALE;
    if (mode == 2) return v * (QSCALE * 1.4426950408889634f);
    if (mode == 3) return sigmoidf_(v);
    const float y = 1.5957691216057308f * (v + 0.044715f * v * v * v);
    return v * sigmoidf_(y);
}
struct EpiProj {
    static constexpr bool PERM = true, AFTER_DRAIN = false, KEEPS = false;
    u16* base; u16* mkv;
    __device__ __forceinline__ void operator()(const f32x4 (&acc)[2][2][4][2], const pg8::Unit& u, int wr, int wc, int fr, int fq) const {
        int mode = 0; u16* b = mkv; int colt = (u.pn - 70) * 256; int ldc = 1024; int pm = 0;
        if (u.pm < 64) {
            const int t = u.pn >> 1; colt = (u.pn & 1) * 256; b = base + (size_t)t * ((size_t)S_ * 512); ldc = 512; pm = u.pm;
            mode = (t == T_SBQ) ? 2 : (t == T_XAQ) ? 1 : 0;
        }
        const int row0 = pm * 256 + wr * 64 + fr, col0 = colt + wc * 32 + 8 * fq;
        if (u.pm >= 64 && u.pn >= 72) {
#pragma unroll
            for (int ai = 0; ai < 2; ++ai)
#pragma unroll
                for (int m = 0; m < 4; ++m) { const int r = row0 + ai * 128 + m * 16;
#pragma unroll
                    for (int bj = 0; bj < 2; ++bj) { const int cv = col0 + bj * 128 - 512; u16* tp = mkv + 256 * 1024 + (size_t)cv * 256 + r;
                        const f32x4 v0 = acc[ai][bj][m][0], v1 = acc[ai][bj][m][1];
                        const unsigned w0 = cvt_pk_bf16(v0[0], v0[1]), w1 = cvt_pk_bf16(v0[2], v0[3]), w2 = cvt_pk_bf16(v1[0], v1[1]), w3 = cvt_pk_bf16(v1[2], v1[3]);
                        tp[0] = (u16)(w0 & 0xffffu); tp[256] = (u16)(w0 >> 16); tp[512] = (u16)(w1 & 0xffffu); tp[768] = (u16)(w1 >> 16);
                        tp[1024] = (u16)(w2 & 0xffffu); tp[1280] = (u16)(w2 >> 16); tp[1536] = (u16)(w3 & 0xffffu); tp[1792] = (u16)(w3 >> 16); } }
            return;
        }
        if (u.pm < 64 && ((u.pn >> 1) == T_SBV || (u.pn >> 1) == T_MLV || (u.pn >> 1) == T_RTV)) {
#pragma unroll
            for (int ai = 0; ai < 2; ++ai)
#pragma unroll
                for (int m = 0; m < 4; ++m) { const int r = row0 + ai * 128 + m * 16;
#pragma unroll
                    for (int bj = 0; bj < 2; ++bj) { const int c = col0 + bj * 128; u16* tp = b + ((size_t)((r >> 6) * 4 + (c >> 7))) * 8192 + (size_t)(c & 127) * 64 + (r & 63);
                        const f32x4 v0 = acc[ai][bj][m][0], v1 = acc[ai][bj][m][1];
                        const unsigned w0 = cvt_pk_bf16(v0[0], v0[1]), w1 = cvt_pk_bf16(v0[2], v0[3]), w2 = cvt_pk_bf16(v1[0], v1[1]), w3 = cvt_pk_bf16(v1[2], v1[3]);
                        tp[0] = (u16)(w0 & 0xffffu); tp[64] = (u16)(w0 >> 16); tp[128] = (u16)(w1 & 0xffffu); tp[192] = (u16)(w1 >> 16);
                        tp[256] = (u16)(w2 & 0xffffu); tp[320] = (u16)(w2 >> 16); tp[384] = (u16)(w3 & 0xffffu); tp[448] = (u16)(w3 >> 16); } }
            return;
        }
#pragma unroll
        for (int ai = 0; ai < 2; ++ai)
#pragma unroll
            for (int m = 0; m < 4; ++m) { u16* rowp = b + (size_t)(row0 + ai * 128 + m * 16) * ldc + col0;
#pragma unroll
                for (int bj = 0; bj < 2; ++bj) { const f32x4 v0 = acc[ai][bj][m][0], v1 = acc[ai][bj][m][1];
                    u32x4 w; w.x = cvt_pk_bf16(act_apply(v0[0], mode), act_apply(v0[1], mode)); w.y = cvt_pk_bf16(act_apply(v0[2], mode), act_apply(v0[3], mode));
                    w.z = cvt_pk_bf16(act_apply(v1[0], mode), act_apply(v1[1], mode)); w.w = cvt_pk_bf16(act_apply(v1[2], mode), act_apply(v1[3], mode));
                    *(u32x4*)(rowp + bj * 128) = w; __builtin_amdgcn_sched_barrier(0); } }
    }
};
__device__ __forceinline__ int eslot(int n) { return n == 0 ? T_SBQ : n == 1 ? T_MLQ : n == 2 ? T_MLV : n == 3 ? T_GMU : T_RTQ; }
__device__ __forceinline__ int yslot(int n) { return n == 0 ? T_SBZ : n == 1 ? T_MLZ : n == 2 ? T_GMZ : n == 3 ? T_RTZ : T_XAZ; }
struct EpiGateE {
    static constexpr bool PERM = true, AFTER_DRAIN = false, KEEPS = false;
    u16* proj;
    __device__ __forceinline__ void operator()(const f32x4 (&acc)[2][2][4][2], const pg8::Unit& u, int wr, int wc, int fr, int fq) const {
        const int n = u.pn >> 2; u16* b = proj + (size_t)eslot(n) * ((size_t)S_ * 512);
        const int row0 = u.pm * 256 + wr * 64 + fr, col0 = (u.pn & 3) * 256 + wc * 32 + 8 * fq;
#pragma unroll
        for (int ai = 0; ai < 2; ++ai)
#pragma unroll
            for (int m = 0; m < 4; ++m) { u16* rowp = b + (size_t)(row0 + ai * 128 + m * 16) * 1024 + col0;
#pragma unroll
                for (int bj = 0; bj < 2; ++bj) { const f32x4 v0 = acc[ai][bj][m][0], v1 = acc[ai][bj][m][1];
                    float e[8];
#pragma unroll
                    for (int i = 0; i < 4; ++i) { e[i] = fminf(1.0f + __expf(-v0[i]), 1e30f); e[4 + i] = fminf(1.0f + __expf(-v1[i]), 1e30f); }
                    u32x4 w; w.x = cvt_pk_bf16(e[0], e[1]); w.y = cvt_pk_bf16(e[2], e[3]); w.z = cvt_pk_bf16(e[4], e[5]); w.w = cvt_pk_bf16(e[6], e[7]);
                    *(u32x4*)(rowp + bj * 128) = w; } }
    }
};
struct EpiMerge {
    static constexpr bool PERM = true, AFTER_DRAIN = false, KEEPS = true;
    const u16* proj; u16* merged;
    __device__ __forceinline__ bool keep(const pg8::Unit& u) const { return u.n < 4; }
    __device__ __forceinline__ void operator()(f32x4 (&acc)[2][2][4][2], const pg8::Unit& u, int wr, int wc, int fr, int fq) const {
        const int n = u.n; const bool last = (n == 4);
        const u16* e0 = proj + (size_t)eslot(n) * ((size_t)S_ * 512); const u16* e1 = proj + (size_t)eslot(last ? 4 : n + 1) * ((size_t)S_ * 512);
        const int row0 = u.pm * 256 + wr * 64 + fr, col0 = u.pn * 256 + wc * 32 + 8 * fq;
#pragma unroll
        for (int ai = 0; ai < 2; ++ai) {
            u32x4 a[4][2], b[4][2];
#pragma unroll
            for (int m = 0; m < 4; ++m)
#pragma unroll
                for (int bj = 0; bj < 2; ++bj) { const size_t ro = (size_t)(row0 + ai * 128 + m * 16) * 1024 + col0 + bj * 128;
                    a[m][bj] = *(const u32x4*)(e0 + ro); b[m][bj] = *(const u32x4*)(e1 + ro); }
#pragma unroll
            for (int m = 0; m < 4; ++m)
#pragma unroll
                for (int bj = 0; bj < 2; ++bj) {
                    float f[8];
#pragma unroll
                    for (int i = 0; i < 8; ++i) { f[i] = __builtin_amdgcn_rcpf(bfe(a[m][bj], i)); if (!last) f[i] *= bfe(b[m][bj], i); }
#pragma unroll
                    for (int i = 0; i < 4; ++i) { acc[ai][bj][m][0][i] *= f[i]; acc[ai][bj][m][1][i] *= f[4 + i]; }
                    if (last) { const f32x4 v0 = acc[ai][bj][m][0], v1 = acc[ai][bj][m][1];
                        u32x4 w; w.x = cvt_pk_bf16(v0[0], v0[1]); w.y = cvt_pk_bf16(v0[2], v0[3]); w.z = cvt_pk_bf16(v1[0], v1[1]); w.w = cvt_pk_bf16(v1[2], v1[3]);
                        *(u32x4*)(merged + (size_t)(row0 + ai * 128 + m * 16) * 1024 + col0 + bj * 128) = w; } }
            asm volatile("" ::: "memory"); }
    }
};
struct UpOrder : pg8::StaticOrder {
    __device__ __forceinline__ bool next(int i, pg8::Unit& u) const { const int ti = i / 5; if (!pg8::StaticOrder::next(ti, u)) return false; u.n = i - ti * 5; return true; }
    __device__ __forceinline__ const char* abase(const pg8::Gemm& g, const pg8::Unit& u, size_t tstep) const { return (const char*)g.A + (size_t)yslot(u.n) * SZ_T + (size_t)u.pm * tstep; }
    __device__ __forceinline__ const char* bbase(const pg8::Gemm& g, const pg8::Unit& u, size_t tstep) const { return (const char*)g.Bt + ((size_t)u.n * 1024 + (size_t)u.pn * 256) * 1024; }
};
struct EpiOutBf16 {
    static constexpr bool PERM = true, AFTER_DRAIN = false, KEEPS = false;
    u16* C;
    __device__ __forceinline__ void operator()(const f32x4 (&acc)[2][2][4][2], const pg8::Unit& u, int wr, int wc, int fr, int fq) const {
        const int row0 = u.pm * 256 + wr * 64 + fr, col0 = u.pn * 256 + wc * 32 + 8 * fq;
#pragma unroll
        for (int ai = 0; ai < 2; ++ai)
#pragma unroll
            for (int m = 0; m < 4; ++m) { u16* rowp = C + (size_t)(row0 + ai * 128 + m * 16) * 1024 + col0;
#pragma unroll
                for (int bj = 0; bj < 2; ++bj) { const f32x4 v0 = acc[ai][bj][m][0], v1 = acc[ai][bj][m][1];
                    u32x4 w; w.x = cvt_pk_bf16(v0[0], v0[1]); w.y = cvt_pk_bf16(v0[2], v0[3]); w.z = cvt_pk_bf16(v1[0], v1[1]); w.w = cvt_pk_bf16(v1[2], v1[3]);
                    *(u32x4*)(rowp + bj * 128) = w; } }
    }
};
struct EpiF32 {
    static constexpr bool PERM = false, AFTER_DRAIN = false, KEEPS = false;
    float* C; int ldc;
    __device__ __forceinline__ void operator()(const f32x4 (&acc)[2][2][4][2], const pg8::Unit& u, int wr, int wc, int fr, int fq) const {
        const int row0 = u.pm * 256 + wr * 64 + fr, col0 = u.pn * 256 + wc * 32 + 4 * fq;
#pragma unroll
        for (int ai = 0; ai < 2; ++ai)
#pragma unroll
            for (int m = 0; m < 4; ++m) { float* rowp = C + (size_t)(row0 + ai * 128 + m * 16) * ldc + col0;
#pragma unroll
                for (int bj = 0; bj < 2; ++bj)
#pragma unroll
                    for (int n = 0; n < 2; ++n) *(f32x4*)(rowp + bj * 128 + n * 16) = acc[ai][bj][m][n]; }
    }
};
struct ProjOrder : pg8::StaticOrder {
    int nfull;
    __device__ __forceinline__ bool next(int i, pg8::Unit& u) const {
        if (i < nfull) return pg8::StaticOrder::next(i, u);
        if (i == nfull && c < 4) { u.pm = 64; u.pn = 70 + c; return true; }
        return false; }
};
struct OneUnit { int pm, pn, cnt;
    __device__ __forceinline__ const char* abase(const pg8::Gemm& g, const pg8::Unit& u, size_t tstep) const { return (const char*)g.A + (size_t)u.pm * tstep; }
    __device__ __forceinline__ const char* bbase(const pg8::Gemm& g, const pg8::Unit& u, size_t tstep) const { return (const char*)g.Bt + (size_t)u.pn * tstep; }
    __device__ __forceinline__ bool next(int i, pg8::Unit& u) const { if (i >= cnt) return false; u.pm = pm; u.pn = pn; return true; }
    __device__ __forceinline__ void a_ready(const pg8::Unit&) const {}
    __device__ __forceinline__ void done(const pg8::Unit&) const {}
};

__device__ __forceinline__ void transpose_item(const float* W, int ldw, int c0, int k0, u16* WT, int K, int n0, LAS float* scr, int lane) {
    f32x4 tv[8];
#pragma unroll
    for (int i = 0; i < 8; ++i) { const int kk = 8 * i + (lane >> 3); tv[i] = *(const f32x4*)(W + (size_t)(k0 + kk) * ldw + c0 + (lane & 7) * 4); }
#pragma unroll
    for (int i = 0; i < 8; ++i) { const int kk = 8 * i + (lane >> 3); LAS float* d = scr + kk * 33 + (lane & 7) * 4; d[0] = tv[i][0]; d[1] = tv[i][1]; d[2] = tv[i][2]; d[3] = tv[i][3]; }
    LDS_WAIT();
    const int c = lane & 7;
#pragma unroll
    for (int j = 0; j < 4; ++j) { const int n = (lane >> 3) + 8 * j; const LAS float* s = scr + (8 * c) * 33 + n;
        u32x4 o; o.x = cvt_pk_bf16(s[0 * 33], s[1 * 33]); o.y = cvt_pk_bf16(s[2 * 33], s[3 * 33]); o.z = cvt_pk_bf16(s[4 * 33], s[5 * 33]); o.w = cvt_pk_bf16(s[6 * 33], s[7 * 33]);
        *(u32x4*)(WT + (size_t)(n0 + n) * K + k0 + 8 * c) = o; }
    LDS_WAIT();
}
__device__ __forceinline__ void phase_prep(const Params& p, int l, LAS unsigned char* lds, const int tid, const int bid, const int nblk) {
    const int lane = tid & 63, wave = tid >> 6;
    unsigned char* ws = p.ws;
    const int gw = bid * 8 + wave, NGW = nblk * 8;
    if (l < 2) {
        LAS float* scr = (LAS float*)(lds + wave * 8448);
        const float* w_in = (const float*)p.in[5] + (size_t)l * 1024 * DIN;
        const float* w_mkv = (const float*)p.in[15] + (size_t)l * 1024 * 1024;
        const float* w_up = (const float*)p.in[16] + (size_t)l * 5 * 512 * 1024;
        const float* w_out = (const float*)p.in[17] + (size_t)l * 1024 * 1024;
        constexpr int I_IN = 16 * 448, I_UP = 5 * 256, I_SQ = 512;
        for (int it = gw; it < I_IN + I_UP + 2 * I_SQ; it += NGW) {
            int r = it;
            if (r < I_IN) { const int kb = r / 448, nb = r % 448, n0 = nb * 32; transpose_item(w_in, DIN, n0 + (n0 >= 4608 ? 8 : 0), kb * 64, (u16*)(ws + OFF_WIN), 1024, n0, scr, lane); continue; }
            r -= I_IN;
            if (r < I_UP) { const int n = r / 256, q = r % 256, kb = q / 32, nb = q % 32; transpose_item(w_up + (size_t)n * 512 * 1024, 1024, nb * 32, kb * 64, (u16*)(ws + OFF_WUP) + (size_t)n * 1024 * 512, 512, nb * 32, scr, lane); continue; }
            r -= I_UP;
            if (r < I_SQ) { const int kb = r / 32, nb = r % 32; transpose_item(w_out, 1024, nb * 32, kb * 64, (u16*)(ws + OFF_WOUT), 1024, nb * 32, scr, lane); continue; }
            r -= I_SQ;
            { const int kb = r / 32, nb = r % 32; transpose_item(w_mkv, 1024, nb * 32, kb * 64, (u16*)(ws + OFF_WMKV), 1024, nb * 32, scr, lane); }
        }
    }
    LAS float* w8 = (LAS float*)(lds + 73728);
    if (l < 2) {
        const float* w_in = (const float*)p.in[5] + (size_t)l * 1024 * DIN;
        for (int i = tid; i < 8192; i += 512) w8[i] = w_in[(size_t)(i >> 3) * DIN + 4608 + (i & 7)];
    }
    __syncthreads();
    const float* xin = (l <= 1) ? (const float*)p.in[0] : (const float*)p.out;
    const u16* outf = (const u16*)(ws + OFF_OUTF);
    const int nrows = S_ + (l < 2 ? 256 : 0);
    for (int row = gw; row < nrows; row += NGW) {
        if (row < S_) {
            f32x4 v[4];
            const f32x4* xr = (const f32x4*)(xin + (size_t)row * 1024) + lane;
#pragma unroll
            for (int j = 0; j < 4; ++j) v[j] = xr[64 * j];
            if (l > 0) {
                const u32x2* orow = (const u32x2*)(outf + (size_t)row * 1024) + lane; const f32x4* gp = (const f32x4*)((const float*)p.in[4] + (size_t)(l - 1) * 1024) + lane;
                f32x4 o[4]; float ss = 0.f;
#pragma unroll
                for (int j = 0; j < 4; ++j) { const u32x2 ob = orow[64 * j]; o[j] = (f32x4){bf_lo(ob.x), bf_hi(ob.x), bf_lo(ob.y), bf_hi(ob.y)}; ss += (o[j][0] * o[j][0] + o[j][1] * o[j][1]) + (o[j][2] * o[j][2] + o[j][3] * o[j][3]); }
                const float rs = rsqrtf(wave_sum(ss) * (1.0f / 1024.0f) + EPS);
                f32x4* dst = (f32x4*)(p.out + (size_t)row * 1024) + lane;
#pragma unroll
                for (int j = 0; j < 4; ++j) { v[j] = v[j] + o[j] * rs * gp[64 * j]; dst[64 * j] = v[j]; }
            }
            if (l < 2) {
                float ss = 0.f;
#pragma unroll
                for (int j = 0; j < 4; ++j) ss += (v[j][0] * v[j][0] + v[j][1] * v[j][1]) + (v[j][2] * v[j][2] + v[j][3] * v[j][3]);
                const float rs = rsqrtf(wave_sum(ss) * (1.0f / 1024.0f) + EPS);
                const f32x4* gp = (const f32x4*)((const float*)p.in[3] + (size_t)l * 1024) + lane;
                u32x2* hrow = (u32x2*)((u16*)(ws + OFF_H) + (size_t)row * 1024) + lane;
                float g8[8];
#pragma unroll
                for (int q = 0; q < 8; ++q) g8[q] = 0.f;
#pragma unroll
                for (int j = 0; j < 4; ++j) { const f32x4 hv = v[j] * rs * gp[64 * j];
                    u32x2 w; w.x = cvt_pk_bf16(hv[0], hv[1]); w.y = cvt_pk_bf16(hv[2], hv[3]); hrow[64 * j] = w;
#pragma unroll
                    for (int i = 0; i < 4; ++i) { const int k = 4 * lane + 256 * j + i; const f32x4 wa = *(const LAS f32x4*)(w8 + k * 8), wb = *(const LAS f32x4*)(w8 + k * 8 + 4);
                        g8[0] += hv[i] * wa[0]; g8[1] += hv[i] * wa[1]; g8[2] += hv[i] * wa[2]; g8[3] += hv[i] * wa[3];
                        g8[4] += hv[i] * wb[0]; g8[5] += hv[i] * wb[1]; g8[6] += hv[i] * wb[2]; g8[7] += hv[i] * wb[3]; } }
#pragma unroll
                for (int q = 0; q < 8; ++q) g8[q] = wave_sum(g8[q]);
                if (lane < 8) { float val = g8[0];
#pragma unroll
                    for (int q = 1; q < 8; ++q) val = (lane == q) ? g8[q] : val;
                    const float bias = (lane < 4) ? ((const float*)p.in[6])[l * 4 + lane] : ((const float*)p.in[7])[l * 4 + lane - 4];
                    ((float*)(ws + OFF_IF))[(size_t)row * 8 + lane] = val + bias; }
            }
        } else {
            const int mr = row - S_;
            const f32x4* xr = (const f32x4*)((const float*)p.in[1] + (size_t)mr * 1024) + lane; const f32x4* gp = (const f32x4*)((const float*)p.in[14] + (size_t)l * 1024) + lane;
            f32x4 v[4]; float ss = 0.f;
#pragma unroll
            for (int j = 0; j < 4; ++j) { v[j] = xr[64 * j]; ss += (v[j][0] * v[j][0] + v[j][1] * v[j][1]) + (v[j][2] * v[j][2] + v[j][3] * v[j][3]); }
            const float rs = rsqrtf(wave_sum(ss) * (1.0f / 1024.0f) + EPS);
            u32x2* hrow = (u32x2*)((u16*)(ws + OFF_MEMH) + (size_t)mr * 1024) + lane;
#pragma unroll
            for (int j = 0; j < 4; ++j) { const f32x4 hv = v[j] * rs * gp[64 * j]; u32x2 w; w.x = cvt_pk_bf16(hv[0], hv[1]); w.y = cvt_pk_bf16(hv[2], hv[3]); hrow[64 * j] = w; }
        }
    }
}

__device__ __forceinline__ void sb_item(const u16* Q, const u16* Kg, const u16* Vg, const u16* ZY, u16* ZW, int qb, int h, LAS unsigned char* lds, const int tid) {
    const int lane = tid & 63, w = tid >> 6, fr = lane & 15, quad = lane >> 4;
    LAS u16* Qs = (LAS u16*)lds;
    LAS u16* Ks = Qs + 128 * 136;
    LAS u16* VT = Ks + 64 * 136;
    LAS int* flg = (LAS int*)(VT + 128 * 72);
    const int q0 = qb * 128;
    u32x4 qpre[4];
#pragma unroll
    for (int i = 0; i < 4; ++i) { const int ch = tid + i * 512, r = ch >> 4, c = ch & 15; qpre[i] = *(const u32x4*)(Q + (size_t)(q0 + r) * 512 + h * 128 + c * 8); }
    u32x4 kreg[2], vreg[2];
#pragma unroll
    for (int i = 0; i < 2; ++i) { const int ch = tid + i * 512, r = ch >> 4, c = ch & 15, c2 = w + 8 * i; const int kt = 2 * qb + 1;
        kreg[i] = *(const u32x4*)(Kg + (size_t)(kt * 64 + r) * 512 + h * 128 + c * 8);
        vreg[i] = *(const u32x4*)(Vg + (size_t)(kt * 4 + h) * 8192 + (size_t)ch * 8); (void)c2; }
    LBAR();
#pragma unroll
    for (int i = 0; i < 4; ++i) { const int ch = tid + i * 512, r = ch >> 4, c = ch & 15; *(LAS u32x4*)(Qs + r * 136 + c * 8) = qpre[i]; }
    if (tid < 8) flg[tid] = 0;
    f32x4 o[8];
#pragma unroll
    for (int i = 0; i < 8; ++i) o[i] = (f32x4){0.f, 0.f, 0.f, 0.f};
    float carry = 0.f; int wdone = 0;
    const int tq = q0 + w * 16 + fr;
    for (int kt = 2 * qb + 1; kt >= 0; --kt) {
        LBAR();
        int nd = 0;
#pragma unroll
        for (int i = 0; i < 8; ++i) nd += flg[i];
        if (nd == 8) break;
#pragma unroll
        for (int i = 0; i < 2; ++i) { const int ch = tid + i * 512, r = ch >> 4, c = ch & 15;
            *(LAS u32x4*)(Ks + r * 136 + c * 8) = kreg[i];
            *(LAS u32x4*)(VT + (ch >> 3) * 72 + (ch & 7) * 8) = vreg[i]; }
        LBAR();
        if (kt > 0) {
#pragma unroll
            for (int i = 0; i < 2; ++i) { const int ch = tid + i * 512, r = ch >> 4, c = ch & 15, c2 = w + 8 * i;
                kreg[i] = *(const u32x4*)(Kg + (size_t)((kt - 1) * 64 + r) * 512 + h * 128 + c * 8);
                vreg[i] = *(const u32x4*)(Vg + (size_t)((kt - 1) * 4 + h) * 8192 + (size_t)ch * 8); (void)c2; } }
        const int wq0 = q0 + w * 16;
        if (!wdone && kt * 64 < wq0 + 15) {
        const bool full = (kt * 64 + 63 < wq0);
        f32x4 st[4];
#pragma unroll
        for (int i = 0; i < 4; ++i) st[i] = (f32x4){0.f, 0.f, 0.f, 0.f};
#pragma unroll
        for (int ks = 0; ks < 4; ++ks) { const bf16x8 qf = lfrag(Qs, w * 16 + fr, 136, ks * 32 + quad * 8);
#pragma unroll
            for (int mt = 0; mt < 4; ++mt) st[mt] = MFMA16(lfrag(Ks, mt * 16 + fr, 136, ks * 32 + quad * 8), qf, st[mt]); }
        float run = carry; int dead = 0;
#pragma unroll
        for (int mt = 3; mt >= 0; --mt) {
            const int kb = kt * 64 + mt * 16;
            if (dead || kb >= wq0 + 16) { st[mt] = (f32x4){0.f, 0.f, 0.f, 0.f}; }
            else {
                const bool mfull = full || (kb + 15 < wq0);
                float l[4], ls[4], gs = 0.f;
#pragma unroll
                for (int j = 0; j < 4; ++j) { const float zc = __builtin_amdgcn_fmed3f(st[mt][j], -115.0f, 115.0f);
                    const float sp = __builtin_amdgcn_logf(1.0f + __builtin_amdgcn_exp2f(zc));
                    l[j] = -sp; ls[j] = zc - sp;
                    if (!mfull) { const bool valid = (kb + quad * 4 + j) < tq; l[j] = valid ? l[j] : 0.f; ls[j] = valid ? ls[j] : -1e30f; }
                    gs += l[j]; }
                const float g1 = __shfl(gs, ((quad + 1) & 3) * 16 + fr), g2 = __shfl(gs, ((quad + 2) & 3) * 16 + fr), g3 = __shfl(gs, ((quad + 3) & 3) * 16 + fr);
                const float qsuf = (quad < 3 ? g1 : 0.f) + (quad < 2 ? g2 : 0.f) + (quad < 1 ? g3 : 0.f);
                const float b3 = run + qsuf, b2 = b3 + l[3], b1 = b2 + l[2], b0 = b1 + l[1];
                st[mt][3] = __builtin_amdgcn_exp2f(ls[3] + b3); st[mt][2] = __builtin_amdgcn_exp2f(ls[2] + b2); st[mt][1] = __builtin_amdgcn_exp2f(ls[1] + b1); st[mt][0] = __builtin_amdgcn_exp2f(ls[0] + b0);
                run += gs + g1 + g2 + g3;
                dead = __all(run < -151.0f);
            }
        }
        carry = run;
#pragma unroll
        for (int k2 = 0; k2 < 2; ++k2) { const bf16x8 pf = pack_p(st[2 * k2], st[2 * k2 + 1]);
#pragma unroll
            for (int mt = 0; mt < 8; ++mt) o[mt] = MFMA16(lfrag_slot(VT, mt * 16 + fr, 72, k2 * 32, quad), pf, o[mt]); }
        wdone = __all(carry < -151.0f);
        if (lane == 0) flg[w] = wdone ? 1 : 0;
        }
    }
    const u16* zr = ZY + (size_t)tq * 512 + h * 128 + quad * 4; u16* zw = ZW + (size_t)tq * 512 + h * 128 + quad * 4;
#pragma unroll
    for (int mt = 0; mt < 8; ++mt) { const u32x2 z = *(const u32x2*)(zr + mt * 16);
        u32x2 r; r.x = cvt_pk_bf16(o[mt][0] * siluf_(bf_lo(z.x)), o[mt][1] * siluf_(bf_hi(z.x))); r.y = cvt_pk_bf16(o[mt][2] * siluf_(bf_lo(z.y)), o[mt][3] * siluf_(bf_hi(z.y)));
        *(u32x2*)(zw + mt * 16) = r; }
}

__device__ __forceinline__ void ml_chunk_gates(const float ic, const float fp, int lane, float& bcum, float& g) {
    float b = fminf(fp, 0.f) - __logf(1.0f + __expf(-fabsf(fp)));
#pragma unroll
    for (int o = 1; o < 64; o <<= 1) { const float n = __shfl_up(b, o); if (lane >= o) b += n; }
    float x = ic - b;
#pragma unroll
    for (int o = 1; o < 64; o <<= 1) { const float n = __shfl_up(x, o); if (lane >= o) x = fmaxf(x, n); }
    bcum = b; g = b + x;
}
__device__ __forceinline__ void rot_cs(int pos, int i, float& cs, float& sn) {
    const float ang = (float)pos * INVF[i];
    double rev = (double)ang * 0.15915494309189535; rev -= floor(rev);
    const float fr = (float)rev;
    sn = __builtin_amdgcn_sinf(fr); cs = __builtin_amdgcn_cosf(fr);
}
template <bool RT, bool TRANSPOSED>
__device__ __forceinline__ void stage_qk(const u16* X, const float* convw, const int* pos, int c, int h, float scale, const LAS float* scale_row, LAS u16* dst, const int tid) {
    if (!RT) {
#pragma unroll
        for (int i = 0; i < 2; ++i) { const int ch = tid + i * 512; const int l = TRANSPOSED ? (tid & 63) : (ch >> 4), d0 = TRANSPOSED ? ((tid >> 6) + 8 * i) * 8 : (ch & 15) * 8;
            float a[8];
#pragma unroll
            for (int e = 0; e < 8; ++e) a[e] = 0.f;
#pragma unroll
            for (int j = 0; j < 4; ++j) { const int tt = c * 64 + l - 3 + j;
                if (tt >= 0) { const u32x4 v = *(const u32x4*)(X + (size_t)tt * 512 + h * 128 + d0); const f32x4 w0 = *(const f32x4*)(convw + j * 512 + h * 128 + d0), w1 = *(const f32x4*)(convw + j * 512 + h * 128 + d0 + 4);
#pragma unroll
                    for (int e = 0; e < 4; ++e) { a[e] += w0[e] * bfe(v, e); a[4 + e] += w1[e] * bfe(v, 4 + e); } } }
            const float sr = scale * (scale_row ? scale_row[l] : 1.0f);
#pragma unroll
            for (int e = 0; e < 8; ++e) a[e] = siluf_(a[e]) * sr;
            if (TRANSPOSED) st_tr8(dst, 72, d0, l, a);
            else { u32x4 o; o.x = cvt_pk_bf16(a[0], a[1]); o.y = cvt_pk_bf16(a[2], a[3]); o.z = cvt_pk_bf16(a[4], a[5]); o.w = cvt_pk_bf16(a[6], a[7]); *(LAS u32x4*)(dst + l * 136 + d0) = o; } }
    } else {
        const int l = TRANSPOSED ? (tid & 63) : (tid >> 3), d0 = TRANSPOSED ? (tid >> 6) * 8 : (tid & 7) * 8; const int t = c * 64 + l; const int ps = pos[t];
        const u32x4 v1 = *(const u32x4*)(X + (size_t)t * 512 + h * 128 + d0), v2 = *(const u32x4*)(X + (size_t)t * 512 + h * 128 + 64 + d0);
        const float sr = scale * (scale_row ? scale_row[l] : 1.0f);
        float a[8], b[8];
#pragma unroll
        for (int e = 0; e < 8; ++e) { float cs, sn; rot_cs(ps, d0 + e, cs, sn); const float t1 = bfe(v1, e), t2 = bfe(v2, e); a[e] = (t1 * cs - t2 * sn) * sr; b[e] = (t1 * sn + t2 * cs) * sr; }
        if (TRANSPOSED) { st_tr8(dst, 72, d0, l, a); st_tr8(dst, 72, 64 + d0, l, b); }
        else { u32x4 o; o.x = cvt_pk_bf16(a[0], a[1]); o.y = cvt_pk_bf16(a[2], a[3]); o.z = cvt_pk_bf16(a[4], a[5]); o.w = cvt_pk_bf16(a[6], a[7]); *(LAS u32x4*)(dst + l * 136 + d0) = o;
               o.x = cvt_pk_bf16(b[0], b[1]); o.y = cvt_pk_bf16(b[2], b[3]); o.z = cvt_pk_bf16(b[4], b[5]); o.w = cvt_pk_bf16(b[6], b[7]); *(LAS u32x4*)(dst + l * 136 + 64 + d0) = o; }
    }
}
__device__ __forceinline__ void stage_vt(const u16* V, int c, int h, LAS u16* VT, const int tid) {
#pragma unroll
    for (int i = 0; i < 2; ++i) { const int l = tid & 63, d0 = ((tid >> 6) + 8 * i) * 8;
        st_tr8_raw(VT, 72, d0, l, *(const u32x4*)(V + (size_t)(c * 64 + l) * 512 + h * 128 + d0)); }
}

template <bool RT>
__device__ __forceinline__ void kv1_item(const Params& p, int l, int c, int h, LAS unsigned char* lds, const int tid) {
    const int lane = tid & 63, w = tid >> 6, fr = lane & 15, quad = lane >> 4;
    unsigned char* ws = p.ws;
    LAS u16* KWT = (LAS u16*)lds;
    LAS u16* VT = KWT + 128 * 72;
    LAS float* wend = (LAS float*)(VT + 128 * 72);
    const u16* proj = (const u16*)(ws + OFF_PROJ);
    float* SC = (float*)(ws + OFF_SC);
    float ic = 0.f, fpv = 0.f;
    if (!RT && w == 0) { const float* IFg = (const float*)(ws + OFF_IF) + (size_t)(c * 64 + lane) * 8; ic = IFg[h]; fpv = IFg[4 + h]; }
    u32x4 vpre[2];
#pragma unroll
    for (int i = 0; i < 2; ++i) vpre[i] = *(const u32x4*)(proj + (size_t)(RT ? T_RTV : T_MLV) * S_ * 512 + (size_t)(c * 4 + h) * 8192 + (size_t)(tid + i * 512) * 8);
    u32x4 kpre[2][4]; int kpos = 0;
    { const int l_ = tid & 63; const u16* Kb = proj + (size_t)(RT ? T_RTK : T_MLK) * S_ * 512;
      if (!RT) {
#pragma unroll
        for (int i = 0; i < 2; ++i) { const int d0 = ((tid >> 6) + 8 * i) * 8;
#pragma unroll
            for (int j = 0; j < 4; ++j) { const int tt = c * 64 + l_ - 3 + j; kpre[i][j] = (tt >= 0) ? *(const u32x4*)(Kb + (size_t)tt * 512 + h * 128 + d0) : (u32x4){0u, 0u, 0u, 0u}; } }
      } else { const int d0 = (tid >> 6) * 8, t = c * 64 + l_; kpos = ((const int*)p.in[2])[t];
        kpre[0][0] = *(const u32x4*)(Kb + (size_t)t * 512 + h * 128 + d0); kpre[0][1] = *(const u32x4*)(Kb + (size_t)t * 512 + h * 128 + 64 + d0); } }
    LBAR();
    if (!RT) { if (w == 0) { float bcum, g; ml_chunk_gates(ic, fpv, lane, bcum, g);
            const float bl = __shfl(bcum, 63), al = __shfl(g, 63);
            wend[lane] = fexp(bl - bcum + ic - al);
            *(float2*)((float*)(ws + OFF_GATES) + ((size_t)h * S_ + c * 64 + lane) * 2) = make_float2(bcum, g);
            if (lane == 0) { SC[h * 256 + c] = bl; SC[1024 + h * 256 + c] = al; } } }
    else { if (tid < 64) wend[tid] = fexp(log_gamma(h) * (float)(63 - tid)); }
    LBAR();
    { const int l_ = tid & 63; const float sr = QSCALE * wend[l_];
      if (!RT) { const LAS float* convw = (const LAS float*)(lds + LDS_CONV) + 2048;
#pragma unroll
        for (int i = 0; i < 2; ++i) { const int d0 = ((tid >> 6) + 8 * i) * 8; float a[8];
#pragma unroll
            for (int e = 0; e < 8; ++e) a[e] = 0.f;
#pragma unroll
            for (int j = 0; j < 4; ++j) { const f32x4 w0 = *(const LAS f32x4*)(convw + j * 512 + h * 128 + d0), w1 = *(const LAS f32x4*)(convw + j * 512 + h * 128 + d0 + 4);
#pragma unroll
                for (int e = 0; e < 4; ++e) { a[e] += w0[e] * bfe(kpre[i][j], e); a[4 + e] += w1[e] * bfe(kpre[i][j], 4 + e); } }
#pragma unroll
            for (int e = 0; e < 8; ++e) a[e] = siluf_(a[e]) * sr;
            st_tr8(KWT, 72, d0, l_, a); }
      } else { const int d0 = (tid >> 6) * 8; float a[8], b[8];
#pragma unroll
        for (int e = 0; e < 8; ++e) { float cs, sn; rot_cs(kpos, d0 + e, cs, sn); const float t1 = bfe(kpre[0][0], e), t2 = bfe(kpre[0][1], e); a[e] = (t1 * cs - t2 * sn) * sr; b[e] = (t1 * sn + t2 * cs) * sr; }
        st_tr8(KWT, 72, d0, l_, a); st_tr8(KWT, 72, 64 + d0, l_, b); } }
#pragma unroll
    for (int i = 0; i < 2; ++i) { const int ch = tid + i * 512; *(LAS u32x4*)(VT + (ch >> 3) * 72 + (ch & 7) * 8) = vpre[i]; }
    LBAR();
    const int db = (w & 3) * 32, eh = (w >> 2) * 64;
    f32x4 acc[2][4];
#pragma unroll
    for (int a = 0; a < 2; ++a)
#pragma unroll
        for (int b = 0; b < 4; ++b) acc[a][b] = (f32x4){0.f, 0.f, 0.f, 0.f};
#pragma unroll
    for (int ks = 0; ks < 2; ++ks) { bf16x8 af[2], bfr[4];
#pragma unroll
        for (int a = 0; a < 2; ++a) af[a] = lfrag(KWT, db + a * 16 + fr, 72, ks * 32 + quad * 8);
#pragma unroll
        for (int b = 0; b < 4; ++b) bfr[b] = lfrag(VT, eh + b * 16 + fr, 72, ks * 32 + quad * 8);
#pragma unroll
        for (int a = 0; a < 2; ++a)
#pragma unroll
            for (int b = 0; b < 4; ++b) acc[a][b] = MFMA16(af[a], bfr[b], acc[a][b]); }
    u16* ST = (u16*)(ws + OFF_KV) + ((size_t)((RT ? 4 : 0) + h) * 256 + c) * 16384;
#pragma unroll
    for (int a = 0; a < 2; ++a)
#pragma unroll
        for (int b = 0; b < 4; ++b) { const int e = eh + b * 16 + fr, d = db + a * 16 + quad * 4;
            u32x2 r; r.x = cvt_pk_bf16(acc[a][b][0], acc[a][b][1]); r.y = cvt_pk_bf16(acc[a][b][2], acc[a][b][3]); *(u32x2*)(ST + e * 128 + d) = r; }
    if (!RT && tid < 128) { float s = 0.f;
#pragma unroll 8
        for (int i = 0; i < 64; ++i) s += bf2f(KWT[tid * 72 + i]);
        ((float*)(ws + OFF_NST))[((size_t)h * 256 + c) * 128 + tid] = s; }
}

__device__ __forceinline__ void scan_item(const Params& p, LAS unsigned char* lds, const int tid, const int it, const bool dummy) {
    unsigned char* ws = p.ws;
    const float* SC = (const float*)(ws + OFF_SC);
    LAS float* do_s = (LAS float*)lds;
    LAS float* dl_s = do_s + 1024;
    LAS float* mp_s = dl_s + 1024;
    LAS float* bl_s = mp_s + 1024;
    LAS float* al_s = bl_s + 1024;
    LBAR();
    for (int i = tid; i < 2048; i += 512) bl_s[i] = SC[i];
    LBAR();
    if (tid < 4) { float m = 0.f;
        for (int c0 = 0; c0 < 256; c0 += 16) { float bl[16], al[16], mo[16];
#pragma unroll
            for (int i = 0; i < 16; ++i) { bl[i] = bl_s[tid * 256 + c0 + i]; al[i] = al_s[tid * 256 + c0 + i]; }
#pragma unroll
            for (int i = 0; i < 16; ++i) { mo[i] = m; m = fmaxf(bl[i] + m, al[i]); }
#pragma unroll
            for (int i = 0; i < 16; ++i) { const float mn = fmaxf(bl[i] + mo[i], al[i]);
                do_s[tid * 256 + c0 + i] = fexp(bl[i] + mo[i] - mn); dl_s[tid * 256 + c0 + i] = fexp(al[i] - mn); mp_s[tid * 256 + c0 + i] = mo[i]; } } }
    LBAR();
    {
        if (it < 128) {
            const int brh = it >> 4, part = it & 15, br = brh >> 2, h = brh & 3;
            unsigned* base = (unsigned*)(ws + OFF_KV) + (size_t)brh * 256 * 8192 + part * 512 + tid;
            unsigned* wbase = dummy ? (unsigned*)p.out + (size_t)brh * 256 * 8192 + part * 512 + tid : base;
            float s0 = 0.f, s1 = 0.f;
            const float cd = fexp(log_gamma(h) * 64.0f);
            for (int c0 = 0; c0 < 256; c0 += 32) {
                unsigned kv[32];
#pragma unroll
                for (int i = 0; i < 32; ++i) kv[i] = base[(size_t)(c0 + i) * 8192];
#pragma unroll
                for (int i = 0; i < 32; ++i) { const int c = c0 + i;
                    wbase[(size_t)c * 8192] = cvt_pk_bf16(s0, s1);
                    const float dold = (br == 0) ? do_s[h * 256 + c] : cd, dloc = (br == 0) ? dl_s[h * 256 + c] : 1.0f;
                    s0 = dold * s0 + dloc * bf_lo(kv[i]); s1 = dold * s1 + dloc * bf_hi(kv[i]); }
            }
        } else {
            const int h = tid >> 7, d = tid & 127;
            float* NST = (float*)(ws + OFF_NST) + (size_t)h * 256 * 128 + d; float* MP = (float*)(ws + OFF_SC) + 2048;
            for (int i = tid; i < 1024; i += 512) MP[i] = mp_s[i];
            float n = 0.f;
            for (int c0 = 0; c0 < 256; c0 += 16) {
                float nl[16];
#pragma unroll
                for (int i = 0; i < 16; ++i) nl[i] = NST[(c0 + i) * 128];
#pragma unroll
                for (int i = 0; i < 16; ++i) { const int c = c0 + i; if (!dummy) NST[c * 128] = n; n = do_s[h * 256 + c] * n + dl_s[h * 256 + c] * nl[i]; }
            }
        }
    }
}

template <bool RT>
__device__ __forceinline__ void out3_item(const Params& p, int l, int c, int h, LAS unsigned char* lds, const int tid, u16* zwb, const int nc, const int nh) {
    const int lane = tid & 63, w = tid >> 6, fr = lane & 15, quad = lane >> 4;
    unsigned char* ws = p.ws;
    LAS u16* Qs = (LAS u16*)lds;
    LAS u16* Ks = Qs + 64 * 136;
    LAS u16* VT = Ks + 64 * 136;
    LAS u16* STs = VT + 128 * 72;
    LAS float* fs = (LAS float*)(STs + 128 * 136);
    LAS float* rowterm = fs;
    LAS float* colterm = fs + 64;
    LAS float* dinter = fs + 128;
    LAS float* emt = fs + 192;
    LAS float* nprev = fs + 256;
    LAS float* red = fs + 384;
    const u16* proj = (const u16*)(ws + OFF_PROJ);
    float ic = 0.f, mp = 0.f, npv = 0.f;
    float2 bg = make_float2(0.f, 0.f);
    if (!RT) { if (w == 0) { const float* IFg = (const float*)(ws + OFF_IF) + (size_t)(c * 64 + lane) * 8; ic = IFg[h]; mp = ((const float*)(ws + OFF_SC))[2048 + h * 256 + c];
            bg = *(const float2*)((const float*)(ws + OFF_GATES) + ((size_t)h * S_ + c * 64 + lane) * 2); }
        if (tid >= 64 && tid < 192) npv = ((const float*)(ws + OFF_NST))[((size_t)h * 256 + c) * 128 + tid - 64]; }
    u32x4 vpre[2], spre[4];
#pragma unroll
    for (int i = 0; i < 2; ++i) vpre[i] = *(const u32x4*)(proj + (size_t)(RT ? T_RTV : T_MLV) * S_ * 512 + (size_t)(c * 4 + h) * 8192 + (size_t)(tid + i * 512) * 8);
    u32x4 qraw[2][4], kraw[2][4]; int ppos = 0;
    { const u16* Qb = proj + (size_t)(RT ? T_RTQ : T_MLQ) * S_ * 512; const u16* Kb = proj + (size_t)(RT ? T_RTK : T_MLK) * S_ * 512;
      if (!RT) {
        const int l0 = (tid >> 4) * 2, d0 = (tid & 15) * 8;
#pragma unroll
        for (int j = 0; j < 5; ++j) { const int tt = c * 64 + l0 - 3 + j; const size_t go_ = (size_t)tt * 512 + h * 128 + d0;
            qraw[j >> 2][j & 3] = (tt >= 0) ? *(const u32x4*)(Qb + go_) : (u32x4){0u, 0u, 0u, 0u}; kraw[j >> 2][j & 3] = (tt >= 0) ? *(const u32x4*)(Kb + go_) : (u32x4){0u, 0u, 0u, 0u}; }
      } else { const int l_ = tid >> 3, d0 = (tid & 7) * 8, t = c * 64 + l_; ppos = ((const int*)p.in[2])[t]; const size_t go_ = (size_t)t * 512 + h * 128 + d0;
        qraw[0][0] = *(const u32x4*)(Qb + go_); qraw[0][1] = *(const u32x4*)(Qb + go_ + 64); kraw[0][0] = *(const u32x4*)(Kb + go_); kraw[0][1] = *(const u32x4*)(Kb + go_ + 64); } }
    { const u16* ST = (const u16*)(ws + OFF_KV) + ((size_t)((RT ? 4 : 0) + h) * 256 + c) * 16384;
#pragma unroll
      for (int i = 0; i < 4; ++i) { const int ch = tid + i * 512; spre[i] = *(const u32x4*)(ST + (ch >> 4) * 128 + (ch & 15) * 8); } }
    LBAR();
    if (!RT) {
        if (w == 0) { const float bcum = bg.x, g = bg.y;
            const float mt = fmaxf(bcum + mp, g);
            rowterm[lane] = bcum - mt; colterm[lane] = ic - bcum; dinter[lane] = fexp(bcum + mp - mt); emt[lane] = fexp(-mt); }
        if (tid >= 64 && tid < 192) nprev[tid - 64] = npv;
        const LAS float* cwq = (const LAS float*)(lds + LDS_CONV); const LAS float* cwk = cwq + 2048;
        const int l0 = (tid >> 4) * 2, d0 = (tid & 15) * 8;
        f32x4 wq[4][2], wk[4][2];
#pragma unroll
        for (int j = 0; j < 4; ++j) { wq[j][0] = *(const LAS f32x4*)(cwq + j * 512 + h * 128 + d0); wq[j][1] = *(const LAS f32x4*)(cwq + j * 512 + h * 128 + d0 + 4);
            wk[j][0] = *(const LAS f32x4*)(cwk + j * 512 + h * 128 + d0); wk[j][1] = *(const LAS f32x4*)(cwk + j * 512 + h * 128 + d0 + 4); }
#pragma unroll
        for (int i = 0; i < 2; ++i) { const int l_ = l0 + i; float a[8], b[8];
#pragma unroll
            for (int e = 0; e < 8; ++e) { a[e] = 0.f; b[e] = 0.f; }
#pragma unroll
            for (int j = 0; j < 4; ++j) { const u32x4 qv = qraw[(i + j) >> 2][(i + j) & 3], kv = kraw[(i + j) >> 2][(i + j) & 3];
#pragma unroll
                for (int e = 0; e < 4; ++e) { a[e] += wq[j][0][e] * bfe(qv, e); a[4 + e] += wq[j][1][e] * bfe(qv, 4 + e); b[e] += wk[j][0][e] * bfe(kv, e); b[4 + e] += wk[j][1][e] * bfe(kv, 4 + e); } }
#pragma unroll
            for (int e = 0; e < 8; ++e) { a[e] = siluf_(a[e]); b[e] = siluf_(b[e]) * QSCALE; }
            u32x4 o; o.x = cvt_pk_bf16(a[0], a[1]); o.y = cvt_pk_bf16(a[2], a[3]); o.z = cvt_pk_bf16(a[4], a[5]); o.w = cvt_pk_bf16(a[6], a[7]); *(LAS u32x4*)(Qs + l_ * 136 + d0) = o;
            o.x = cvt_pk_bf16(b[0], b[1]); o.y = cvt_pk_bf16(b[2], b[3]); o.z = cvt_pk_bf16(b[4], b[5]); o.w = cvt_pk_bf16(b[6], b[7]); *(LAS u32x4*)(Ks + l_ * 136 + d0) = o; }
    } else {
        const int l_ = tid >> 3, d0 = (tid & 7) * 8; float a[8], b[8], a2[8], b2[8];
#pragma unroll
        for (int e = 0; e < 8; ++e) { float cs, sn; rot_cs(ppos, d0 + e, cs, sn);
            const float q1 = bfe(qraw[0][0], e), q2 = bfe(qraw[0][1], e), k1 = bfe(kraw[0][0], e), k2 = bfe(kraw[0][1], e);
            a[e] = q1 * cs - q2 * sn; a2[e] = q1 * sn + q2 * cs; b[e] = (k1 * cs - k2 * sn) * QSCALE; b2[e] = (k1 * sn + k2 * cs) * QSCALE; }
        u32x4 o; o.x = cvt_pk_bf16(a[0], a[1]); o.y = cvt_pk_bf16(a[2], a[3]); o.z = cvt_pk_bf16(a[4], a[5]); o.w = cvt_pk_bf16(a[6], a[7]); *(LAS u32x4*)(Qs + l_ * 136 + d0) = o;
        o.x = cvt_pk_bf16(a2[0], a2[1]); o.y = cvt_pk_bf16(a2[2], a2[3]); o.z = cvt_pk_bf16(a2[4], a2[5]); o.w = cvt_pk_bf16(a2[6], a2[7]); *(LAS u32x4*)(Qs + l_ * 136 + 64 + d0) = o;
        o.x = cvt_pk_bf16(b[0], b[1]); o.y = cvt_pk_bf16(b[2], b[3]); o.z = cvt_pk_bf16(b[4], b[5]); o.w = cvt_pk_bf16(b[6], b[7]); *(LAS u32x4*)(Ks + l_ * 136 + d0) = o;
        o.x = cvt_pk_bf16(b2[0], b2[1]); o.y = cvt_pk_bf16(b2[2], b2[3]); o.z = cvt_pk_bf16(b2[4], b2[5]); o.w = cvt_pk_bf16(b2[6], b2[7]); *(LAS u32x4*)(Ks + l_ * 136 + 64 + d0) = o;
    }
#pragma unroll
    for (int i = 0; i < 2; ++i) { const int ch = tid + i * 512; *(LAS u32x4*)(VT + (ch >> 3) * 72 + (ch & 7) * 8) = vpre[i]; }
#pragma unroll
    for (int i = 0; i < 4; ++i) { const int ch = tid + i * 512; *(LAS u32x4*)(STs + (ch >> 4) * 136 + (ch & 15) * 8) = spre[i]; }
    LBAR();
    const int tb = (w & 3) * 16, eh = (w >> 2) * 64;
    const int tl = tb + fr;
    const size_t go = (size_t)(c * 64 + tl) * 512 + h * 128 + eh + quad * 4;
    const u16* zr = (const u16*)(ws + OFF_PROJ) + (size_t)(RT ? T_RTZ : T_MLZ) * S_ * 512 + go; u16* zw = zwb + go;
    const u16* orow = proj + (size_t)T_MLO * S_ * 512 + go;
    u32x2 zpre[4], opre[4];
#pragma unroll
    for (int mt = 0; mt < 4; ++mt) { zpre[mt] = *(const u32x2*)(zr + mt * 16); if (!RT) opre[mt] = *(const u32x2*)(orow + mt * 16); else opre[mt] = zpre[mt]; }
    f32x4 st[4];
#pragma unroll
    for (int i = 0; i < 4; ++i) st[i] = (f32x4){0.f, 0.f, 0.f, 0.f};
    f32x4 oe[4], oi[4];
#pragma unroll
    for (int i = 0; i < 4; ++i) { oe[i] = (f32x4){0.f, 0.f, 0.f, 0.f}; oi[i] = (f32x4){0.f, 0.f, 0.f, 0.f}; }
#pragma unroll
    for (int ks = 0; ks < 4; ++ks) { const bf16x8 qf = lfrag(Qs, tl, 136, ks * 32 + quad * 8);
#pragma unroll
        for (int mt = 0; mt < 4; ++mt) st[mt] = MFMA16(lfrag(Ks, mt * 16 + fr, 136, ks * 32 + quad * 8), qf, st[mt]);
#pragma unroll
        for (int mt = 0; mt < 4; ++mt) oe[mt] = MFMA16(lfrag(STs, eh + mt * 16 + fr, 136, ks * 32 + quad * 8), qf, oe[mt]); }
    float dsum = 0.f;
    const float lg = log_gamma(h);
    const float rt_ = RT ? 0.f : rowterm[tl];
#pragma unroll
    for (int mt = 0; mt < 4; ++mt)
#pragma unroll
        for (int j = 0; j < 4; ++j) { const int s = mt * 16 + quad * 4 + j; float dec;
            if (RT) dec = fexp(lg * fabsf((float)(tl - s)));
            else dec = (s <= tl) ? fexp(rt_ + colterm[s]) : 0.f;
            const float v = st[mt][j] * dec; st[mt][j] = v; dsum += v; }
#pragma unroll
    for (int k2 = 0; k2 < 2; ++k2) { const bf16x8 pf = pack_p(st[2 * k2], st[2 * k2 + 1]);
#pragma unroll
        for (int mt = 0; mt < 4; ++mt) oi[mt] = MFMA16(lfrag_slot(VT, eh + mt * 16 + fr, 72, k2 * 32, quad), pf, oi[mt]); }
    float cin, cden = 1.0f;
    if (!RT) {
        dsum += __shfl_xor(dsum, 16); dsum += __shfl_xor(dsum, 32);
        float qn = 0.f;
#pragma unroll 8
        for (int i = 0; i < 32; ++i) qn += bf2f(Qs[tl * 136 + quad * 32 + i]) * nprev[quad * 32 + i];
        qn += __shfl_xor(qn, 16); qn += __shfl_xor(qn, 32);
        cin = dinter[tl];
        const float den = cin * qn + dsum;
        cden = 1.0f / fmaxf(fabsf(den), emt[tl]);
    } else cin = fexp(lg * (float)(tl + 1));
    float s1 = 0.f, s2 = 0.f;
#pragma unroll
    for (int mt = 0; mt < 4; ++mt)
#pragma unroll
        for (int j = 0; j < 4; ++j) { const float v = (cin * oe[mt][j] + oi[mt][j]) * cden; oi[mt][j] = v; s1 += v; s2 += v * v; }
    s1 += __shfl_xor(s1, 16); s1 += __shfl_xor(s1, 32); s2 += __shfl_xor(s2, 16); s2 += __shfl_xor(s2, 32);
    if (quad == 0) { red[((w >> 2) * 64 + tl) * 2] = s1; red[((w >> 2) * 64 + tl) * 2 + 1] = s2; }
    LBAR();
    const float t1 = red[tl * 2] + red[(64 + tl) * 2], t2 = red[tl * 2 + 1] + red[(64 + tl) * 2 + 1];
    const float mu = t1 * (1.0f / 128.0f); const float var = fmaxf(t2 * (1.0f / 128.0f) - mu * mu, 0.f); const float rstd = rsqrtf(var + EPS);
#pragma unroll
    for (int mt = 0; mt < 4; ++mt) { const u32x2 z = zpre[mt];
        float g0 = siluf_(bf_lo(z.x)), g1 = siluf_(bf_hi(z.x)), g2 = siluf_(bf_lo(z.y)), g3 = siluf_(bf_hi(z.y));
        if (!RT) { const u32x2 ov = opre[mt]; g0 *= sigmoidf_(bf_lo(ov.x)); g1 *= sigmoidf_(bf_hi(ov.x)); g2 *= sigmoidf_(bf_lo(ov.y)); g3 *= sigmoidf_(bf_hi(ov.y)); }
        u32x2 r; r.x = cvt_pk_bf16((oi[mt][0] - mu) * rstd * g0, (oi[mt][1] - mu) * rstd * g1); r.y = cvt_pk_bf16((oi[mt][2] - mu) * rstd * g2, (oi[mt][3] - mu) * rstd * g3);
        *(u32x2*)(zw + mt * 16) = r; }
}

__device__ __forceinline__ void gm_item(const Params& p, int l, int nb, LAS unsigned char* lds, const int tid, u16* zwb) {
    const int lane = tid & 63, w = tid >> 6, fr = lane & 15, quad = lane >> 4;
    unsigned char* ws = p.ws;
    LAS u16* Wm = (LAS u16*)lds;
    LAS u16* VNT = Wm + 128 * 136;
    LAS float* mu_s = (LAS float*)(VNT + 128 * 136);
    LAS float* rs_s = mu_s + 128;
    const u16* V = (const u16*)(ws + OFF_PROJ) + (size_t)T_GMV * S_ * 512 + (size_t)nb * 128 * 512;
    LBAR();
    { const int r = tid >> 2, part = tid & 3; float s1 = 0.f, s2 = 0.f;
#pragma unroll 8
      for (int i = 0; i < 16; ++i) { const u32x4 v = *(const u32x4*)(V + (size_t)r * 512 + part * 128 + i * 8);
#pragma unroll
          for (int e = 0; e < 8; ++e) { const float x = geluf_(bfe(v, e)); s1 += x; s2 += x * x; } }
      s1 += __shfl_xor(s1, 1); s1 += __shfl_xor(s1, 2); s2 += __shfl_xor(s2, 1); s2 += __shfl_xor(s2, 2);
      if (part == 0) { const float mu = s1 * (1.0f / 512.0f); const float var = fmaxf(s2 * (1.0f / 512.0f) - mu * mu, 0.f); mu_s[r] = mu; rs_s[r] = rsqrtf(var + EPS); } }
    for (int g = 0; g < 4; ++g) {
    if (g) LBAR();
    { const float* wsrc = (const float*)p.in[12] + ((size_t)l * 4 + g) * 16384;
#pragma unroll
      for (int i = 0; i < 4; ++i) { const int ch = tid + i * 512, pr = ch >> 4, q0 = (ch & 15) * 8;
          f32x4 a = *(const f32x4*)(wsrc + pr * 128 + q0), b = *(const f32x4*)(wsrc + pr * 128 + q0 + 4);
          if (pr < 64 && q0 >= 64) { a = (f32x4){0.f, 0.f, 0.f, 0.f}; b = a; }
          u32x4 o; o.x = cvt_pk_bf16(a[0], a[1]); o.y = cvt_pk_bf16(a[2], a[3]); o.z = cvt_pk_bf16(b[0], b[1]); o.w = cvt_pk_bf16(b[2], b[3]);
          *(LAS u32x4*)(Wm + pr * 136 + q0) = o; } }
    LBAR();
    { const float* lng = (const float*)p.in[10] + l * 512 + g * 128; const float* lnb = (const float*)p.in[11] + l * 512 + g * 128;
#pragma unroll
      for (int i = 0; i < 4; ++i) { const int q = lane + 64 * (i & 1), c0 = (w + 8 * (i >> 1)) * 8;
          const u32x4 v = *(const u32x4*)(V + (size_t)q * 512 + g * 128 + c0); const float mu = mu_s[q], rs = rs_s[q];
          float a[8];
#pragma unroll
          for (int e = 0; e < 8; ++e) a[e] = (geluf_(bfe(v, e)) - mu) * rs * lng[c0 + e] + lnb[c0 + e];
          st_tr8(VNT, 136, c0, q, a); } }
    LBAR();
    const int cb = (w & 3) * 32, ph = (w >> 2) * 64;
    u32x2 upre[4][2], zpre[4][2];
#pragma unroll
    for (int b = 0; b < 4; ++b)
#pragma unroll
        for (int a = 0; a < 2; ++a) { const size_t go = (size_t)(nb * 128 + ph + b * 16 + fr) * 512 + g * 128 + cb + a * 16 + quad * 4;
            upre[b][a] = *(const u32x2*)((const u16*)(ws + OFF_PROJ) + (size_t)T_GMU * S_ * 512 + go); zpre[b][a] = *(const u32x2*)((const u16*)(ws + OFF_PROJ) + (size_t)T_GMZ * S_ * 512 + go); }
    f32x4 acc[2][4];
#pragma unroll
    for (int a = 0; a < 2; ++a)
#pragma unroll
        for (int b = 0; b < 4; ++b) acc[a][b] = (f32x4){0.f, 0.f, 0.f, 0.f};
#pragma unroll
    for (int ks = 0; ks < 4; ++ks) { bf16x8 af[2], bfr[4];
#pragma unroll
        for (int a = 0; a < 2; ++a) af[a] = lfrag(VNT, cb + a * 16 + fr, 136, ks * 32 + quad * 8);
#pragma unroll
        for (int b = 0; b < 4; ++b) bfr[b] = lfrag(Wm, ph + b * 16 + fr, 136, ks * 32 + quad * 8);
#pragma unroll
        for (int a = 0; a < 2; ++a)
#pragma unroll
            for (int b = 0; b < 4; ++b) acc[a][b] = MFMA16(af[a], bfr[b], acc[a][b]); }
    const float* bs = (const float*)p.in[13] + ((size_t)l * 4 + g) * 128;
#pragma unroll
    for (int b = 0; b < 4; ++b) { const int pl = ph + b * 16 + fr; const float bias = bs[pl];
#pragma unroll
        for (int a = 0; a < 2; ++a) { const size_t go = (size_t)(nb * 128 + pl) * 512 + g * 128 + cb + a * 16 + quad * 4;
            const u32x2 uv = upre[b][a], z = zpre[b][a];
            u32x2 r; r.x = cvt_pk_bf16(geluf_(bf_lo(uv.x)) * (acc[a][b][0] + bias) * siluf_(bf_lo(z.x)), geluf_(bf_hi(uv.x)) * (acc[a][b][1] + bias) * siluf_(bf_hi(z.x)));
            r.y = cvt_pk_bf16(geluf_(bf_lo(uv.y)) * (acc[a][b][2] + bias) * siluf_(bf_lo(z.y)), geluf_(bf_hi(uv.y)) * (acc[a][b][3] + bias) * siluf_(bf_hi(z.y)));
            *(u32x2*)(zwb + go) = r; } }
    }
}

__device__ __forceinline__ void xa_item(const Params& p, int sb5, int h, LAS unsigned char* lds, const int tid, u16* zwb) {
    const int lane = tid & 63, w = tid >> 6, fr = lane & 15, quad = lane >> 4;
    unsigned char* ws = p.ws;
    LAS u16* KM = (LAS u16*)lds;
    LAS u16* VT = KM + 256 * 136;
    const u16* MKV = (const u16*)(ws + OFF_MKV);
    u32x4 kpre[8], vpre[8];
#pragma unroll
    for (int i = 0; i < 8; ++i) { const int ch = tid + i * 512, r = ch >> 4, c = ch & 15; kpre[i] = *(const u32x4*)(MKV + (size_t)r * 1024 + h * 128 + c * 8); }
#pragma unroll
    for (int i = 0; i < 8; ++i) { const int ch = tid + i * 512; vpre[i] = *(const u32x4*)(MKV + 256 * 1024 + (size_t)(h * 128 + (ch >> 5)) * 256 + (ch & 31) * 8); }
    LBAR();
#pragma unroll
    for (int i = 0; i < 8; ++i) { const int ch = tid + i * 512, r = ch >> 4, c = ch & 15; *(LAS u32x4*)(KM + r * 136 + c * 8) = kpre[i]; }
#pragma unroll
    for (int i = 0; i < 8; ++i) { const int ch = tid + i * 512; *(LAS u32x4*)(VT + (ch >> 5) * 264 + (ch & 31) * 8) = vpre[i]; }
    LBAR();
#pragma unroll 1
    for (int sub = 0; sub < 4; ++sub) {
        int row = (sb5 * 4 + sub) * 128 + w * 16 + fr;
        asm volatile("" : "+v"(row));
        const u16* Qr = (const u16*)(ws + OFF_PROJ) + (size_t)T_XAQ * S_ * 512 + (size_t)row * 512 + h * 128 + quad * 8;
        bf16x8 qf[4];
#pragma unroll
        for (int ks = 0; ks < 4; ++ks) qf[ks] = *(const bf16x8*)(Qr + ks * 32);
        const size_t zo = (size_t)row * 512 + h * 128 + quad * 4;
        const u16* zr = (const u16*)(ws + OFF_PROJ) + (size_t)T_XAZ * S_ * 512 + zo; u16* zw = zwb + zo;
        u32x2 zpre[8];
#pragma unroll
        for (int mt = 0; mt < 8; ++mt) zpre[mt] = *(const u32x2*)(zr + mt * 16);
        f32x4 st[16];
#pragma unroll
        for (int i = 0; i < 16; ++i) st[i] = (f32x4){0.f, 0.f, 0.f, 0.f};
#pragma unroll
        for (int ks = 0; ks < 4; ++ks) {
#pragma unroll
            for (int mt = 0; mt < 16; ++mt) st[mt] = MFMA16(lfrag(KM, mt * 16 + fr, 136, ks * 32 + quad * 8), qf[ks], st[mt]); }
        float mx = -1e30f;
#pragma unroll
        for (int mt = 0; mt < 16; ++mt)
#pragma unroll
            for (int j = 0; j < 4; ++j) mx = fmaxf(mx, st[mt][j]);
        mx = fmaxf(mx, __shfl_xor(mx, 16)); mx = fmaxf(mx, __shfl_xor(mx, 32));
        float sum = 0.f;
#pragma unroll
        for (int mt = 0; mt < 16; ++mt)
#pragma unroll
            for (int j = 0; j < 4; ++j) { const float e = fexp(st[mt][j] - mx); st[mt][j] = e; sum += e; }
        sum += __shfl_xor(sum, 16); sum += __shfl_xor(sum, 32);
        f32x4 o[8];
#pragma unroll
        for (int i = 0; i < 8; ++i) o[i] = (f32x4){0.f, 0.f, 0.f, 0.f};
#pragma unroll
        for (int k2 = 0; k2 < 8; ++k2) { const bf16x8 pf = pack_p(st[2 * k2], st[2 * k2 + 1]);
#pragma unroll
            for (int mt = 0; mt < 8; ++mt) o[mt] = MFMA16(lfrag_slot(VT, mt * 16 + fr, 264, k2 * 32, quad), pf, o[mt]); }
        const float inv = 1.0f / sum;
#pragma unroll
        for (int mt = 0; mt < 8; ++mt) { const u32x2 z = zpre[mt];
            u32x2 r; r.x = cvt_pk_bf16(o[mt][0] * inv * siluf_(bf_lo(z.x)), o[mt][1] * inv * siluf_(bf_hi(z.x))); r.y = cvt_pk_bf16(o[mt][2] * inv * siluf_(bf_lo(z.y)), o[mt][3] * inv * siluf_(bf_hi(z.y)));
            *(u32x2*)(zw + mt * 16) = r; }
    }
}

__device__ __forceinline__ int q_pop(unsigned* ctr, LAS int* slot, const int tid) {
    LBAR();
    if (tid == 0) *slot = (int)__hip_atomic_fetch_add(ctr, 1u, __ATOMIC_RELAXED, __HIP_MEMORY_SCOPE_AGENT);
    LBAR();
    return *slot;
}
constexpr int N_PHASES = 17;
#ifdef DUP_MASK
#define DUPREP rep
#else
#define DUPREP 0
#endif
#ifndef P3MASK
#define P3MASK 15
#endif
#ifndef DUPSEL
#define DUPSEL 15
#endif
#ifndef DUP_PHMAX
#define DUP_PHMAX 16
#endif
#ifndef IMASK
#define IMASK 31
#endif
#ifndef PMASK
#define PMASK 127
#endif
__global__ void __launch_bounds__(512) hybrid_fwd(Params p) {
    extern __shared__ __attribute__((aligned(16))) unsigned char lds_raw[];
    LAS unsigned char* lds = (LAS unsigned char*)lds_raw;
    volatile LAS unsigned* xst = (volatile LAS unsigned*)(lds + LDS_CTL);
    LAS int* qslot = (LAS int*)(lds + LDS_CTL + 32);
    if (p.ph_hi - p.ph_lo > 2) { if (threadIdx.x < 4) xst[threadIdx.x] = 0u; __syncthreads();
        const XcdBarrier b0 = xcd_barrier_post((unsigned*)(p.ws + OFF_BAR), xst); if (threadIdx.x == 0) xst[2] = b0.x; }
    for (int ph = p.ph_lo; ph < p.ph_hi; ++ph) {
        if (ph > p.ph_lo) { if (p.ph_hi > 1000) cg::this_grid().sync();
            else { size_t boff = OFF_BAR; asm volatile("" : "+s"(boff)); unsigned* barp = (unsigned*)(p.ws + boff); XcdBarrier xb;     xb.bar = barp; xb.x = xst[2]; xb.st = xst; xcd_barrier(xb); } }
#ifdef DUP_MASK
        for (int rep = 0; rep < ((ph < DUP_PHMAX) ? 1 + ((DUP_MASK >> (ph % 8)) & 1) : 1); ++rep) { if (rep) __syncthreads();
#endif
        int tid = threadIdx.x, bid = blockIdx.x, nblk = gridDim.x; unsigned char* ws = p.ws;
        size_t wso = 0; asm volatile("" : "+v"(tid), "+s"(bid), "+s"(nblk), "+s"(wso)); ws = p.ws + wso;
        Params q = p; q.ws = ws;
#ifdef DUP_MASK
        const bool dummy = (rep == 0) && (((DUP_MASK >> (ph % 8)) & 1) != 0) && ph < DUP_PHMAX;
#else
        const bool dummy = false;
#endif
#define ZW(T) (dummy ? (u16*)p.out : (u16*)(ws + OFF_PROJ) + (size_t)(T) * S_ * 512)
        if (ph == 16) { if (PMASK & 1) phase_prep(q, 2, lds, tid, bid, nblk); continue; }
        const int l = ph / 8, s = ph % 8;
        if (s == 0) { if (PMASK & 1) phase_prep(q, l, lds, tid, bid, nblk); }
        else if (s == 1) { if (PMASK & 2) {
            pg8::Gemm g{(const u16*)(ws + OFF_H), (const u16*)(ws + OFF_WIN), S_, NPROJ, 1024};
            pg8::StaticOrder so; so.init(S_, NPROJ, nblk, bid);
            EpiProj E{(u16*)(ws + OFF_PROJ), (u16*)(ws + OFF_MKV)};
            pg8::gemm_phase<EpiProj, pg8::StaticOrder>(lds, g, so, E, tid);
        } } else if (s == 2) { if (PMASK & 4) { const int tid_ = tid;
            static_assert(OFF_MEMH == OFF_H + 64ull * 256 * 1024 * 2 && OFF_WMKV == OFF_WIN + 70ull * 256 * 1024 * 2, "the mem_kv GEMM addresses MEMH / WMKV as tile (64, 70..73) of the projection GEMM");
            unsigned* ctr = (unsigned*)(ws + OFF_BAR) + XCD_BAR_WORDS + 64 * (2 * l + 4 * DUPREP);
            { LAS float* cw = (LAS float*)(lds + LDS_CONV); const float* cq = (const float*)p.in[8] + (size_t)l * 2048; const float* ck = (const float*)p.in[9] + (size_t)l * 2048;
              for (int i = tid_; i < 2048; i += 512) { cw[i] = cq[i]; cw[2048 + i] = ck[i]; } }
            int it = q_pop(ctr, qslot, tid_);
            while (it < 4 + 2048) {
                int tid = tid_; asm volatile("" : "+v"(tid));
                unsigned nxt = 0; if (tid_ == 0) nxt = __hip_atomic_fetch_add(ctr, 1u, __ATOMIC_RELAXED, __HIP_MEMORY_SCOPE_AGENT);
                if (it < 4) { pg8::Gemm g{(const u16*)(ws + OFF_H), (const u16*)(ws + OFF_WIN), S_, NPROJ, 1024}; OneUnit ou{64, 70 + it, p.ph_hi > 1000 ? 2 : 1};
                    EpiProj E{(u16*)(ws + OFF_PROJ), (u16*)(ws + OFF_MKV)}; pg8::gemm_phase<EpiProj, OneUnit>(lds, g, ou, E, tid);
                    { LAS float* cw = (LAS float*)(lds + LDS_CONV); const float* cq = (const float*)p.in[8] + (size_t)l * 2048; const float* ck = (const float*)p.in[9] + (size_t)l * 2048;
                      for (int i = tid_; i < 2048; i += 512) { cw[i] = cq[i]; cw[2048 + i] = ck[i]; } } }
                else if (it < 4 + 1024) { const int j = it - 4; kv1_item<false>(q, l, j >> 2, j & 3, lds, tid); }
                else { const int j = it - 4 - 1024; kv1_item<true>(q, l, j >> 2, j & 3, lds, tid); }
                LBAR(); if (tid_ == 0) *qslot = (int)nxt; LBAR(); it = *qslot;
            }
        } } else if (s == 3) { if (PMASK & 8) { const int tid_ = tid;
            const u16* proj = (const u16*)(ws + OFF_PROJ);
            unsigned* ctr = (unsigned*)(ws + OFF_BAR) + XCD_BAR_WORDS + 64 * (2 * l + 1 + 4 * DUPREP);
            int it = q_pop(ctr, qslot, tid_);
            while (it < 129 + 128 + 512 + 128) {
                int tid = tid_; asm volatile("" : "+v"(tid));
                unsigned nxt = 0; if (tid_ == 0) nxt = __hip_atomic_fetch_add(ctr, 1u, __ATOMIC_RELAXED, __HIP_MEMORY_SCOPE_AGENT);
                if (it < 129) { if ((P3MASK & 1) && (!dummy || (DUPSEL & 1))) scan_item(q, lds, tid, it, dummy); }
                else if (it < 129 + 128) { const int j = it - 129; if ((P3MASK & 8) && (!dummy || (DUPSEL & 8))) xa_item(q, j >> 2, j & 3, lds, tid, ZW(T_XAZ)); }
                else if (it < 129 + 256) { if ((P3MASK & 2) && (!dummy || (DUPSEL & 2))) gm_item(q, l, it - 257, lds, tid, ZW(T_GMZ)); }
                else { const int j = it - 385; if ((P3MASK & 4) && (!dummy || (DUPSEL & 4))) sb_item(proj + (size_t)T_SBQ * S_ * 512, proj + (size_t)T_SBK * S_ * 512, proj + (size_t)T_SBV * S_ * 512, proj + (size_t)T_SBZ * S_ * 512, ZW(T_SBZ), j >> 2, j & 3, lds, tid); }
                LBAR(); if (tid_ == 0) *qslot = (int)nxt; LBAR(); it = *qslot;
            }
        } }
        else if (s == 4) { if (PMASK & 16) { const int tid_ = tid;
            { LAS float* cw = (LAS float*)(lds + LDS_CONV); const float* cq = (const float*)p.in[8] + (size_t)l * 2048; const float* ck = (const float*)p.in[9] + (size_t)l * 2048;
              for (int i = tid_; i < 2048; i += 512) { cw[i] = cq[i]; cw[2048 + i] = ck[i]; } __syncthreads(); }
            for (int it = bid; it < 2048; it += nblk) {
                int tid = tid_; asm volatile("" : "+v"(tid));
                const int itn = it + nblk; const bool same = (itn < 2048) && ((itn < 1024) == (it < 1024)); const int jn = itn < 1024 ? itn : itn - 1024;
                if (it < 1024) { if (!dummy || (DUPSEL & 1)) out3_item<false>(q, l, it >> 2, it & 3, lds, tid, ZW(T_MLZ), same ? (jn >> 2) : -1, jn & 3); }
                else { const int j = it - 1024; if (!dummy || (DUPSEL & 2)) out3_item<true>(q, l, j >> 2, j & 3, lds, tid, ZW(T_RTZ), same ? (jn >> 2) : -1, jn & 3); }
            }
        } } else if (s == 5) { if (PMASK & 32) {
            pg8::Gemm g{(const u16*)(ws + OFF_H), (const u16*)(ws + OFF_WIN) + (size_t)NPROJ * 1024, S_, 5120, 1024};
            pg8::StaticOrder so; so.init(S_, 5120, nblk, bid);
            EpiGateE E{(u16*)(ws + OFF_PROJ)};
            pg8::gemm_phase<EpiGateE, pg8::StaticOrder>(lds, g, so, E, tid);
        } } else if (s == 6) { if (PMASK & 32) {
            pg8::Gemm g{(const u16*)(ws + OFF_PROJ), (const u16*)(ws + OFF_WUP), S_, 1024, 512};
            UpOrder so; so.init(S_, 1024, nblk, bid);
            EpiMerge E{(const u16*)(ws + OFF_PROJ), (u16*)(ws + OFF_MERGED)};
            pg8::gemm_phase<EpiMerge, UpOrder>(lds, g, so, E, tid);
        } } else { if (PMASK & 64) {
            pg8::Gemm g{(const u16*)(ws + OFF_MERGED), (const u16*)(ws + OFF_WOUT), S_, 1024, 1024};
            pg8::StaticOrder so; so.init(S_, 1024, nblk, bid);
            EpiOutBf16 E{(u16*)(ws + OFF_OUTF)};
            pg8::gemm_phase<EpiOutBf16, pg8::StaticOrder>(lds, g, so, E, tid);
        } }
#ifdef DUP_MASK
        }
#endif
    }
}

#ifdef DBG_K
__global__ void dbg_dump(const unsigned* ws, float* out, size_t nwords, int n) {
    for (int i = blockIdx.x * blockDim.x + threadIdx.x; i < n; i += gridDim.x * blockDim.x) {
        unsigned s = 0; for (size_t k = i; k < nwords; k += (size_t)n) s += ws[k] * 2654435761u + (ws[k] >> 16);
        out[i] = (float)(s & 0xFFFFFu); }
}
#endif
extern "C" void kernel_launch(void* const* d_in, const int* in_sizes, int n_in, void* d_out, int out_size, void* d_ws, size_t ws_size, hipStream_t stream) {
    static int grid = 0;
    if (grid == 0) {
        if (n_in != 18 || out_size != S_ * DM || ws_size < WS_END) { fprintf(stderr, "kernel_launch: unexpected shapes / workspace (%d inputs, out %d, ws %zu < %zu)\n", n_in, out_size, ws_size, (size_t)WS_END); grid = -1; return; }
        int dev = 0, cus = 0, per_cu = 0;
        (void)hipGetDevice(&dev); (void)hipDeviceGetAttribute(&cus, hipDeviceAttributeMultiprocessorCount, dev);
        if (hipFuncSetAttribute((const void*)hybrid_fwd, hipFuncAttributeMaxDynamicSharedMemorySize, LDS_BYTES) != hipSuccess) { fprintf(stderr, "kernel_launch: hipFuncSetAttribute failed\n"); grid = -1; return; }
        if (hipOccupancyMaxActiveBlocksPerMultiprocessor(&per_cu, (const void*)hybrid_fwd, 512, LDS_BYTES) != hipSuccess || per_cu < 1) per_cu = 1;
        (void)hipGetLastError();
        grid = cus * per_cu; if (grid > 256) grid = 256; if (grid < 4) grid = 4;
    }
    if (grid < 0) return;
    (void)hipMemsetAsync((unsigned char*)d_ws + OFF_BAR, 0, 16384, stream);
    Params p{};
    for (int i = 0; i < 18; ++i) p.in[i] = d_in[i];
    p.out = (float*)d_out; p.ws = (unsigned char*)d_ws;
#if ONE_LAUNCH
    p.ph_lo = 0; p.ph_hi = N_PHASES;
    void* args[] = {&p};
    hipError_t e = hipLaunchCooperativeKernel((const void*)hybrid_fwd, dim3(grid), dim3(512), args, LDS_BYTES, stream);
    if (e != hipSuccess) fprintf(stderr, "cooperative launch failed: %s (grid %d)\n", hipGetErrorString(e), grid);
#else
#ifdef DBG_K
    for (int ph = 0; ph < DBG_K; ++ph) { p.ph_lo = ph; p.ph_hi = ph + 1; hipLaunchKernelGGL(hybrid_fwd, dim3(grid), dim3(512), LDS_BYTES, stream, p); }
    hipLaunchKernelGGL(dbg_dump, dim3(2048), dim3(256), 0, stream, (const unsigned*)d_ws, (float*)d_out, (size_t)(WS_END / 4), out_size);
#else
    for (int ph = 0; ph < N_PHASES; ++ph) { p.ph_lo = ph; p.ph_hi = ph + 1; hipLaunchKernelGGL(hybrid_fwd, dim3(grid), dim3(512), LDS_BYTES, stream, p); }
#endif
#endif
}
```

```cpp
#include <hip/hip_runtime.h>
#include <hip/hip_cooperative_groups.h>
#include <cstdio>
namespace cg = cooperative_groups;
#ifndef ONE_LAUNCH
#define ONE_LAUNCH 1
#endif
namespace pg8 {
#define PG8_LAS __attribute__((address_space(3)))
typedef unsigned short bf16_t;
typedef short bf16x8 __attribute__((ext_vector_type(8)));
typedef float f32x4 __attribute__((ext_vector_type(4)));
typedef unsigned u32x4 __attribute__((ext_vector_type(4)));
constexpr int BM = 256, BK = 64, HALF = 128, HTB = HALF * BK * 2  , STAGE_BYTES = 8 * HTB, NXCD = 8, WGM = 8;

__host__ __device__ __forceinline__ int lds_byte(int r, int c) { const int st = (r >> 4) * 2 + (c >> 5), rr = r & 15, cc = c & 31, ob = rr * 64 + cc * 2; return st * 1024 + (ob ^ (((ob >> 9) & 1) << 5)); }
__host__ __device__ __forceinline__ void stage_rc(int b, int& R, int& C) { const int st = b / 1024, sb = b % 1024, swz = sb ^ (((sb >> 9) & 1) << 5); R = (st >> 1) * 16 + swz / 64; C = (st & 1) * 32 + (swz % 64) / 2; }
__host__ __device__ __forceinline__ int perm32(int rho) { const int n = rho >> 4, i = rho & 15; return 8 * (i >> 2) + 4 * n + (i & 3); }

struct Unit { int pm, pn, n; };
struct Gemm { const bf16_t* A; const bf16_t* Bt; int M, N, K; };

struct StaticOrder {
    int nM, nN, nwg, G, c;
    __host__ __device__ __forceinline__ void init(int M, int N, int G_, int c_) { nM = M / BM; nN = N / BM; nwg = nM * nN; G = G_; c = c_; }
    __host__ __device__ __forceinline__ bool next(int i, Unit& u) const {
        const long L = (long)i * G + c; if (L >= nwg) return false;
        int wgid = (int)L; { const int q = nwg / NXCD, r = nwg % NXCD, xcd = wgid % NXCD, off = wgid / NXCD; wgid = (xcd < r ? xcd * (q + 1) : r * (q + 1) + (xcd - r) * q) + off; }
        const int nig = WGM * nN, gid = wgid / nig, fm = gid * WGM, gsz = (nM - fm) < WGM ? (nM - fm) : WGM;
        u.pm = fm + ((wgid % nig) % gsz); u.pn = (wgid % nig) / gsz; return true;
    }
    __device__ __forceinline__ void a_ready(const Unit&) const {}
    __device__ __forceinline__ void done(const Unit&) const {}
    __device__ __forceinline__ const char* abase(const Gemm& g, const Unit& u, size_t tstep) const { return (const char*)g.A + (size_t)u.pm * tstep; }
    __device__ __forceinline__ const char* bbase(const Gemm& g, const Unit& u, size_t tstep) const { return (const char*)g.Bt + (size_t)u.pn * tstep; }
};

typedef __bf16 bf16v2_t __attribute__((ext_vector_type(2)));
typedef float f32v2_t __attribute__((ext_vector_type(2)));
__device__ __forceinline__ unsigned cvt_pk_bf16(float lo, float hi) { const f32v2_t v = {lo, hi}; const bf16v2_t r = __builtin_convertvector(v, bf16v2_t); return __builtin_bit_cast(unsigned, r); }
template <class Epi, class Sched, bool ALIGN_EPI = true, bool SP2 = true>
__device__ __forceinline__ void gemm_phase(PG8_LAS unsigned char* lds, const Gemm g, const Sched& S, const Epi& E, const int tid) {
    const int wid = __builtin_amdgcn_readfirstlane(tid >> 6), lane = tid & 63, wr = wid >> 2, wc = wid & 3, fr = lane & 15, fq = lane >> 4;
    const int K = g.K, nt = K / BK;
    unsigned voffA[2], voffB[2];
#pragma unroll
    for (int i = 0; i < 2; ++i) { int R, C; stage_rc(tid * 16 + i * 8192, R, C); const int Rb = Epi::PERM ? ((R & ~31) + perm32(R & 31)) : R;
        voffA[i] = (unsigned)(R * K + C) * 2u; voffB[i] = (unsigned)(Rb * K + C) * 2u; }
    const size_t kstep = (size_t)(BK * 2);
    const size_t hstep = (size_t)HALF * K * 2;
    const size_t tstep = 2 * hstep;
    const unsigned ldsw = (unsigned)wid * 1024u;
    const int aoff = lds_byte(wr * 64 + fr, fq * 8), boff = lds_byte(wc * 32 + fr, fq * 8);
#define PG8_SA(b, h) (((b) * 2 + (h)) * HTB)
#define PG8_SB(b, h) ((4 + (b) * 2 + (h)) * HTB)
#define PG8_STAGE(bufoff, gbase, voff) do { _Pragma("unroll") for (int _i = 0; _i < 2; ++_i) \
        __builtin_amdgcn_global_load_lds((const unsigned*)((const char*)(gbase) + (voff)[_i]), (PG8_LAS unsigned*)(lds + (bufoff) + ldsw + _i * 8192), 16, 0, 0); } while (0)
#define PG8_LDA(dst, b, h) do { _Pragma("unroll") for (int m = 0; m < 4; ++m) _Pragma("unroll") for (int k = 0; k < 2; ++k) dst[m][k] = *(const PG8_LAS bf16x8*)(lds + PG8_SA(b, h) + aoff + m * 2048 + k * 1024); } while (0)
#define PG8_LDB(dst, b, h) do { _Pragma("unroll") for (int n = 0; n < 2; ++n) _Pragma("unroll") for (int k = 0; k < 2; ++k) dst[n][k] = *(const PG8_LAS bf16x8*)(lds + PG8_SB(b, h) + boff + n * 2048 + k * 1024); } while (0)
#define PG8_MMA(ai, bj, At, Bt) do { __builtin_amdgcn_s_setprio(1); _Pragma("unroll") for (int m = 0; m < 4; ++m) _Pragma("unroll") for (int n = 0; n < 2; ++n) _Pragma("unroll") for (int k = 0; k < 2; ++k) \
        acc[ai][bj][m][n] = __builtin_amdgcn_mfma_f32_16x16x32_bf16(Bt[n][k], At[m][k], acc[ai][bj][m][n], 0, 0, 0); __builtin_amdgcn_s_setprio(0); } while (0)
#define PG8_WAIT_V(n) asm volatile("s_waitcnt vmcnt(" #n ")" ::: "memory")
#define PG8_WAIT_L(n) asm volatile("s_waitcnt lgkmcnt(" #n ")" ::: "memory")
#define PG8_BAR __builtin_amdgcn_s_barrier()
#define PG8_SCHED __builtin_amdgcn_sched_barrier(0)
    Unit cur, nxt; int ui = 0;
    if (!S.next(0, cur)) return;
    f32x4 acc[2][2][4][2];
#pragma unroll
    for (int a = 0; a < 2; ++a)
#pragma unroll
        for (int b = 0; b < 2; ++b)
#pragma unroll
            for (int m = 0; m < 4; ++m)
#pragma unroll
                for (int n = 0; n < 2; ++n) acc[a][b][m][n] = (f32x4){0.f, 0.f, 0.f, 0.f};
    bf16x8 At[4][2], B0[2][2], B1[2][2];
    const char* cA = S.abase(g, cur, tstep); const char* cB = S.bbase(g, cur, tstep);
    S.a_ready(cur);
    if constexpr (SP2) {
        PG8_STAGE(PG8_SB(0, 0), cB, voffB); PG8_STAGE(PG8_SB(0, 1), cB + hstep, voffB); PG8_STAGE(PG8_SA(0, 0), cA, voffA); PG8_STAGE(PG8_SA(0, 1), cA + hstep, voffA);
        if (wr == 1) PG8_BAR;
        PG8_WAIT_V(2); PG8_BAR;
        PG8_STAGE(PG8_SB(1, 0), cB + kstep, voffB); PG8_STAGE(PG8_SA(1, 0), cA + kstep, voffA); PG8_STAGE(PG8_SB(1, 1), cB + hstep + kstep, voffB);
        PG8_WAIT_V(6); PG8_BAR;
    } else {
        PG8_STAGE(PG8_SB(0, 0), cB, voffB); PG8_STAGE(PG8_SA(0, 0), cA, voffA); PG8_STAGE(PG8_SB(0, 1), cB + hstep, voffB); PG8_STAGE(PG8_SA(0, 1), cA + hstep, voffA);
        if (wr == 1) PG8_BAR;
        PG8_WAIT_V(4); PG8_BAR;
        PG8_STAGE(PG8_SB(1, 0), cB + kstep, voffB); PG8_STAGE(PG8_SA(1, 0), cA + kstep, voffA); PG8_STAGE(PG8_SB(1, 1), cB + hstep + kstep, voffB);
        PG8_WAIT_V(6); PG8_BAR;
    }
    for (;;) {
        const bool has_next = S.next(ui + 1, nxt);
        const char* nA = has_next ? S.abase(g, nxt, tstep) : cA; const char* nB = has_next ? S.bbase(g, nxt, tstep) : cB;
        for (int t = 0; t < nt; t += 2) {
            const bool last = (t == nt - 2);
            const char* a1 = cA + (size_t)(t + 1) * kstep;
            const char* a2 = last ? nA : cA + (size_t)(t + 2) * kstep; const char* b2 = last ? nB : cB + (size_t)(t + 2) * kstep;
            const char* a3 = a2 + kstep; const char* b3 = b2 + kstep;
            if (last && has_next) S.a_ready(nxt);
            if constexpr (SP2) {
            PG8_LDB(B0, 0, 0); PG8_LDB(B1, 0, 1); PG8_SCHED; PG8_LDA(At, 0, 0); PG8_STAGE(PG8_SA(1, 1), a1 + hstep, voffA);
            PG8_WAIT_V(8); PG8_WAIT_L(0); PG8_BAR; PG8_MMA(0, 0, At, B0); PG8_MMA(0, 1, At, B1); PG8_BAR; PG8_SCHED;
            PG8_LDA(At, 0, 1); PG8_STAGE(PG8_SB(0, 0), b2, voffB); PG8_STAGE(PG8_SB(0, 1), b2 + hstep, voffB); PG8_STAGE(PG8_SA(0, 0), a2, voffA);
            PG8_WAIT_V(8); PG8_WAIT_L(0); PG8_BAR; PG8_MMA(1, 0, At, B0); PG8_MMA(1, 1, At, B1); PG8_BAR; PG8_SCHED;
            PG8_LDB(B0, 1, 0); PG8_LDB(B1, 1, 1); PG8_SCHED; PG8_LDA(At, 1, 0); PG8_STAGE(PG8_SA(0, 1), a2 + hstep, voffA);
            PG8_WAIT_V(8); PG8_WAIT_L(0); PG8_BAR; PG8_MMA(0, 0, At, B0); PG8_MMA(0, 1, At, B1); PG8_BAR; PG8_SCHED;
            PG8_LDA(At, 1, 1); PG8_STAGE(PG8_SB(1, 0), b3, voffB); PG8_STAGE(PG8_SB(1, 1), b3 + hstep, voffB); PG8_STAGE(PG8_SA(1, 0), a3, voffA);
            PG8_WAIT_V(8); PG8_WAIT_L(0); PG8_BAR; PG8_MMA(1, 0, At, B0); PG8_MMA(1, 1, At, B1); PG8_BAR; PG8_SCHED;
            } else {
            PG8_LDB(B0, 0, 0); PG8_SCHED; PG8_LDA(At, 0, 0); PG8_STAGE(PG8_SA(1, 1), a1 + hstep, voffA);
            PG8_WAIT_L(8); PG8_BAR; PG8_WAIT_L(0); PG8_MMA(0, 0, At, B0); PG8_BAR; PG8_SCHED;
            PG8_LDB(B1, 0, 1); PG8_STAGE(PG8_SB(0, 0), b2, voffB);
            PG8_BAR; PG8_WAIT_L(0); PG8_MMA(0, 1, At, B1); PG8_BAR;
            PG8_LDA(At, 0, 1); PG8_STAGE(PG8_SA(0, 0), a2, voffA);
            PG8_BAR; PG8_WAIT_L(0); PG8_MMA(1, 0, At, B0); PG8_BAR; PG8_SCHED;
            PG8_STAGE(PG8_SB(0, 1), b2 + hstep, voffB);
            PG8_WAIT_V(6); PG8_BAR; PG8_MMA(1, 1, At, B1); PG8_BAR;
            PG8_LDB(B0, 1, 0); PG8_SCHED; PG8_LDA(At, 1, 0); PG8_STAGE(PG8_SA(0, 1), a2 + hstep, voffA);
            PG8_WAIT_L(8); PG8_BAR; PG8_WAIT_L(0); PG8_MMA(0, 0, At, B0); PG8_BAR; PG8_SCHED;
            PG8_LDB(B1, 1, 1); PG8_STAGE(PG8_SB(1, 0), b3, voffB);
            PG8_BAR; PG8_WAIT_L(0); PG8_MMA(0, 1, At, B1); PG8_BAR;
            PG8_LDA(At, 1, 1); PG8_STAGE(PG8_SA(1, 0), a3, voffA);
            PG8_BAR; PG8_WAIT_L(0); PG8_MMA(1, 0, At, B0); PG8_BAR; PG8_SCHED;
            PG8_STAGE(PG8_SB(1, 1), b3 + hstep, voffB);
            PG8_WAIT_V(6); PG8_BAR; PG8_MMA(1, 1, At, B1); PG8_BAR;
            }
        }
        if constexpr (ALIGN_EPI) { if (wr == 0) PG8_BAR; }
        if constexpr (!Epi::AFTER_DRAIN) { E(acc, cur, wr, wc, fr, fq); S.done(cur); }
        if (!has_next) break;
        bool zero_acc = true;
        if constexpr (Epi::KEEPS) zero_acc = !E.keep(cur);
        if (zero_acc) {
#pragma unroll
        for (int a = 0; a < 2; ++a)
#pragma unroll
            for (int b = 0; b < 2; ++b)
#pragma unroll
                for (int m = 0; m < 4; ++m)
#pragma unroll
                    for (int n = 0; n < 2; ++n) acc[a][b][m][n] = (f32x4){0.f, 0.f, 0.f, 0.f};
        }
        cur = nxt; cA = nA; cB = nB; ++ui;
        if constexpr (ALIGN_EPI) { if (wr == 1) PG8_BAR; }
    }
    PG8_WAIT_V(0);
    if constexpr (!ALIGN_EPI) { if (wr == 0) PG8_BAR; }
    PG8_BAR;
    if constexpr (Epi::AFTER_DRAIN) { E.fused(acc, cur, wr, wc, fr, fq, lds, wid, lane); S.done(cur); }
#undef PG8_SA
#undef PG8_SB
#undef PG8_STAGE
#undef PG8_LDA
#undef PG8_LDB
#undef PG8_MMA
#undef PG8_WAIT_V
#undef PG8_WAIT_L
#undef PG8_BAR
#undef PG8_SCHED
}
}

#define LAS __attribute__((address_space(3)))
typedef unsigned short u16;
typedef short bf16x8 __attribute__((ext_vector_type(8)));
typedef short s16x4 __attribute__((ext_vector_type(4)));
typedef float f32x4 __attribute__((ext_vector_type(4)));
typedef unsigned u32x4 __attribute__((ext_vector_type(4)));
typedef unsigned u32x2 __attribute__((ext_vector_type(2)));
using pg8::cvt_pk_bf16;

constexpr int S_ = 16384, DM = 1024, BW = 512, HD = 128, NCH = 256, DIN = 14344;
constexpr int NPROJ = 9216, NWIN = 14336;
constexpr float EPS = 1e-6f;
constexpr float QSCALE = 0.08838834764831845f;
constexpr int LDS_BYTES = 147456, LDS_CTL = LDS_BYTES - 64;

constexpr size_t OFF_WIN = 0;
constexpr size_t SZ_WIN = (size_t)NWIN * 1024 * 2;
constexpr size_t OFF_WUP = OFF_WIN + SZ_WIN;
constexpr size_t SZ_WUP = 5ull * 1024 * 512 * 2;
constexpr size_t OFF_WOUT = OFF_WUP + SZ_WUP;
constexpr size_t SZ_WSQ = 1024ull * 1024 * 2;
constexpr size_t OFF_WMKV = OFF_WOUT + SZ_WSQ;
constexpr size_t OFF_H = OFF_WMKV + SZ_WSQ;
constexpr size_t SZ_H = (size_t)S_ * 1024 * 2;
constexpr size_t OFF_MEMH = OFF_H + SZ_H;
constexpr size_t OFF_MKV = OFF_MEMH + 256 * 1024 * 2;
constexpr size_t OFF_IF = OFF_MKV + 256 * 1024 * 2 + 512 * 256 * 2;
constexpr size_t OFF_SC = OFF_IF + (size_t)S_ * 8 * 4;
constexpr size_t OFF_NST = OFF_SC + 3 * 4 * 256 * 4;
constexpr size_t OFF_PROJ = OFF_NST + 4 * 256 * 128 * 4;
constexpr size_t SZ_T = (size_t)S_ * 512 * 2;
constexpr size_t OFF_KV = OFF_PROJ + 18 * SZ_T;
constexpr size_t SZ_KV = 2ull * 4 * 256 * 128 * 128 * 2;
constexpr size_t OFF_BAR = OFF_KV + SZ_KV;
constexpr size_t OFF_GATES = OFF_BAR + 16384;
constexpr size_t WS_END = OFF_GATES + 4ull * 16384 * 2 * 4;
constexpr int LDS_CONV = 98304;
constexpr size_t OFF_MERGED = OFF_KV;
constexpr size_t OFF_MSCR = OFF_PROJ + 4 * SZ_T;
constexpr size_t OFF_GSCR = OFF_PROJ + 9 * SZ_T;
constexpr size_t OFF_OUTF = OFF_PROJ + 4 * SZ_T;
static_assert(OFF_PROJ % 256 == 0 && OFF_KV % 256 == 0, "align");

enum { T_SBQ = 0, T_SBK, T_SBV, T_SBZ, T_MLQ, T_MLK, T_MLV, T_MLO, T_MLZ, T_GMU, T_GMV, T_GMZ, T_RTQ, T_RTK, T_RTV, T_RTZ, T_XAQ, T_XAZ };

__device__ const float INVF[64] = {
1.000000000e+00f, 8.659643531e-01f, 7.498942614e-01f, 6.493816376e-01f, 5.623413324e-01f, 4.869675338e-01f, 4.216965139e-01f, 3.651741147e-01f, 3.162277639e-01f, 2.738419771e-01f, 2.371373773e-01f, 2.053525001e-01f, 1.778279394e-01f, 1.539926529e-01f, 1.333521307e-01f, 1.154782027e-01f, 1.000000015e-01f, 8.659642935e-02f, 7.498941571e-02f, 6.493816525e-02f, 5.623413250e-02f, 4.869675264e-02f, 4.216965288e-02f, 3.651741147e-02f, 3.162277490e-02f, 2.738419734e-02f, 2.371373773e-02f, 2.053525113e-02f, 1.778279431e-02f, 1.539926510e-02f, 1.333521493e-02f, 1.154782064e-02f, 9.999999776e-03f, 8.659643121e-03f, 7.498941850e-03f, 6.493816152e-03f, 5.623413250e-03f, 4.869675264e-03f, 4.216964822e-03f, 3.651741194e-03f, 3.162277630e-03f, 2.738419687e-03f, 2.371373586e-03f, 2.053524833e-03f, 1.778279431e-03f, 1.539926510e-03f, 1.333521446e-03f, 1.154781901e-03f, 1.000000047e-03f, 8.659643354e-04f, 7.498942432e-04f, 6.493816618e-04f, 5.623413017e-04f, 4.869675322e-04f, 4.216965172e-04f, 3.651741426e-04f, 3.162277571e-04f, 2.738419571e-04f, 2.371373703e-04f, 2.053525095e-04f, 1.778279402e-04f, 1.539926452e-04f, 1.333521504e-04f, 1.154782003e-04f };
__device__ __forceinline__ float log_gamma(int h) { return h == 0 ? -3.174869716e-02f : h == 1 ? -1.574835740e-02f : h == 2 ? -7.843177766e-03f : -3.913899418e-03f; }

struct Params { const void* in[18]; float* out; unsigned char* ws; int ph_lo, ph_hi; };

__device__ __forceinline__ float bf_lo(unsigned w) { return __uint_as_float(w << 16); }
__device__ __forceinline__ float bf_hi(unsigned w) { return __uint_as_float(w & 0xffff0000u); }
__device__ __forceinline__ float bf2f(u16 b) { return __uint_as_float(((unsigned)b) << 16); }
__device__ __forceinline__ float fexp(float x) { return __expf(x); }
__device__ __forceinline__ float sigmoidf_(float x) { return __builtin_amdgcn_rcpf(1.0f + __expf(-x)); }
__device__ __forceinline__ float siluf_(float x) { return x * __builtin_amdgcn_rcpf(1.0f + __expf(-x)); }
__device__ __forceinline__ float geluf_(float v) { return v * sigmoidf_(1.5957691216057308f * (v + 0.044715f * v * v * v)); }
__device__ __forceinline__ float softplusf_(float z) { return fmaxf(z, 0.f) + __logf(1.0f + __expf(-fabsf(z))); }
__device__ __forceinline__ float wave_sum(float v) {
#pragma unroll
    for (int o = 1; o < 64; o <<= 1) v += __shfl_xor(v, o);
    return v;
}
#define LDS_WAIT() asm volatile("s_waitcnt lgkmcnt(0)" ::: "memory")
#define LBAR() do { asm volatile("s_waitcnt lgkmcnt(0)" ::: "memory"); __builtin_amdgcn_s_barrier(); asm volatile("" ::: "memory"); } while (0)
#define MFMA16(a, b, c) __builtin_amdgcn_mfma_f32_16x16x32_bf16((a), (b), (c), 0, 0, 0)
__device__ __forceinline__ bf16x8 lfrag(const LAS u16* base, int row, int ld, int kofs) { return *(const LAS bf16x8*)(base + row * ld + kofs); }
__device__ __forceinline__ bf16x8 lfrag_slot(const LAS u16* base, int row, int ld, int kb, int quad) {
    const s16x4 lo = *(const LAS s16x4*)(base + row * ld + kb + quad * 4);
    const s16x4 hi = *(const LAS s16x4*)(base + row * ld + kb + 16 + quad * 4);
    bf16x8 r; r[0] = lo[0]; r[1] = lo[1]; r[2] = lo[2]; r[3] = lo[3]; r[4] = hi[0]; r[5] = hi[1]; r[6] = hi[2]; r[7] = hi[3]; return r;
}
__device__ __forceinline__ bf16x8 pack_p(const f32x4 a, const f32x4 b) {
    u32x4 w; w.x = cvt_pk_bf16(a[0], a[1]); w.y = cvt_pk_bf16(a[2], a[3]); w.z = cvt_pk_bf16(b[0], b[1]); w.w = cvt_pk_bf16(b[2], b[3]);
    return __builtin_bit_cast(bf16x8, w);
}
__device__ __forceinline__ float bfe(const u32x4 v, int e) { const unsigned w = v[e >> 1]; return (e & 1) ? bf_hi(w) : bf_lo(w); }
__device__ __forceinline__ void st_tr8(LAS u16* XT, int ld, int c0, int row, const float (&val)[8]) {
#pragma unroll
    for (int e = 0; e < 8; e += 2) { const unsigned w = cvt_pk_bf16(val[e], val[e + 1]); XT[(c0 + e) * ld + row] = (u16)(w & 0xffffu); XT[(c0 + e + 1) * ld + row] = (u16)(w >> 16); }
}
__device__ __forceinline__ void st_tr8_raw(LAS u16* XT, int ld, int c0, int row, const u32x4 v) {
#pragma unroll
    for (int e = 0; e < 4; ++e) { XT[(c0 + 2 * e) * ld + row] = (u16)(v[e] & 0xffffu); XT[(c0 + 2 * e + 1) * ld + row] = (u16)(v[e] >> 16); }
}
#include <cstdint>
#include <cstdlib>
#include <vector>

#define XB_TMO      128
#define XB_XCNT(j)  (256  + 64 * (j))
#define XB_XSUB(j)  (1280 + 64 * (j))
#define XB_XGEN(j)  (2304 + 64 * (j))
#define XB_TOP      3328
#define XB_TOPGEN   3392
#define XCD_BAR_WORDS 3456
#define XB_SPIN_CAP (1u << 18)

__device__ __forceinline__ unsigned xb_ld(unsigned* p)              { return __hip_atomic_load(p, __ATOMIC_RELAXED, __HIP_MEMORY_SCOPE_AGENT); }
__device__ __forceinline__ unsigned xb_add(unsigned* p, unsigned v) { return __hip_atomic_fetch_add(p, v, __ATOMIC_RELAXED, __HIP_MEMORY_SCOPE_AGENT); }
__device__ __forceinline__ unsigned xb_xcc_id() { return (unsigned)__builtin_amdgcn_s_getreg((3 << 11) | 20) & 0xFu; }
#define XB_SPIN(cond, bar) do { unsigned _sp = 0; while (cond) { __builtin_amdgcn_s_sleep(1); \
    if ((++_sp & 255u) == 0u) { if (xb_ld(&(bar)[XB_TMO])) break; if (_sp > XB_SPIN_CAP) { atomicAdd(&(bar)[XB_TMO], 1u); break; } } } } while (0)

struct XcdBarrier {
    unsigned* bar; unsigned x;
    volatile LAS unsigned* st;
};

__device__ __forceinline__ XcdBarrier xcd_barrier_post(unsigned* bar, volatile LAS unsigned* st) {
    XcdBarrier b; b.bar = bar; b.x = xb_xcc_id(); b.st = st;
    if (threadIdx.x == 0) (void)xb_add(&bar[XB_XCNT(b.x)], 1u);
    return b;
}
__device__ __forceinline__ void xcd_barrier_complete(unsigned* bar, unsigned x, unsigned& nloc, unsigned& nx) {
    const unsigned G = gridDim.x * gridDim.y * gridDim.z;
    unsigned sum, cnt, mine, sp = 0u;
    for (;;) {
        sum = 0u; cnt = 0u; mine = 0u;
#pragma unroll
        for (unsigned j = 0; j < 16; ++j) { const unsigned c = xb_ld(&bar[XB_XCNT(j)]); sum += c; cnt += (c > 0u) ? 1u : 0u; mine = (j == x) ? c : mine; }
        if (sum == G) break;
        __builtin_amdgcn_s_sleep(1);
        if ((++sp & 255u) == 0u) { if (xb_ld(&bar[XB_TMO])) break; if (sp > XB_SPIN_CAP) { atomicAdd(&bar[XB_TMO], 1u); break; } }
    }
    nloc = mine > 0u ? mine : 1u; nx = cnt > 0u ? cnt : 1u;
}

__device__ __forceinline__ void xcd_barrier(const XcdBarrier& b) {
    asm volatile("s_waitcnt vmcnt(0)" ::: "memory");
    __syncthreads();
    if (threadIdx.x == 0) {
        unsigned* bar = b.bar;
        __builtin_amdgcn_s_waitcnt(0);
        unsigned nloc = b.st[0], nx = b.st[1];
        if (nloc == 0u) { xcd_barrier_complete(bar, b.x, nloc, nx); b.st[0] = nloc; b.st[1] = nx; }
        const unsigned old = xb_add(&bar[XB_XSUB(b.x)], 1u);
        const unsigned gen = old / nloc;
        if (old + 1u == (gen + 1u) * nloc) {
            __builtin_amdgcn_fence(__ATOMIC_RELEASE, "agent");
            asm volatile("s_waitcnt vmcnt(0)" ::: "memory");
            const unsigned og = xb_add(&bar[XB_TOP], 1u);
            const unsigned tg = og / nx;
            if (og + 1u == (tg + 1u) * nx) xb_add(&bar[XB_TOPGEN], 1u);
            else XB_SPIN(xb_ld(&bar[XB_TOPGEN]) == tg, bar);
            __builtin_amdgcn_fence(__ATOMIC_ACQUIRE, "agent");
            xb_add(&bar[XB_XGEN(b.x)], 1u);
            asm volatile("s_waitcnt vmcnt(0)" ::: "memory");
        } else {
            XB_SPIN(xb_ld(&bar[XB_XGEN(b.x)]) == gen, bar);
            __builtin_amdgcn_fence(__ATOMIC_ACQUIRE, "agent");
            asm volatile("s_waitcnt vmcnt(0)" ::: "memory");
        }
    }
    __syncthreads();
}

__device__ __forceinline__ float act_apply(float v, int mode) {
    if (mode == 0) return v;
    if (mode == 1) return v * QSCALE;
    if (mode == 2) return v * (QSCALE * 1.4426950408889634f);
    if (mode == 3) return sigmoidf_(v);
    const float y = 1.5957691216057308f * (v + 0.044715f * v * v * v);
    return v * sigmoidf_(y);
}
struct EpiProj {
    static constexpr bool PERM = true, AFTER_DRAIN = false, KEEPS = false;
    u16* base; u16* mkv;
    __device__ __forceinline__ void operator()(const f32x4 (&acc)[2][2][4][2], const pg8::Unit& u, int wr, int wc, int fr, int fq) const {
        int mode = 0; u16* b = mkv; int colt = (u.pn - 70) * 256; int ldc = 1024; int pm = 0;
        if (u.pm < 64) {
            const int t = u.pn >> 1; colt = (u.pn & 1) * 256; b = base + (size_t)t * ((size_t)S_ * 512); ldc = 512; pm = u.pm;
            mode = (t == T_SBQ) ? 2 : (t == T_XAQ) ? 1 : 0;
        }
        const int row0 = pm * 256 + wr * 64 + fr, col0 = colt + wc * 32 + 8 * fq;
        if (u.pm >= 64 && u.pn >= 72) {
#pragma unroll
            for (int ai = 0; ai < 2; ++ai)
#pragma unroll
                for (int m = 0; m < 4; ++m) { const int r = row0 + ai * 128 + m * 16;
#pragma unroll
                    for (int bj = 0; bj < 2; ++bj) { const int cv = col0 + bj * 128 - 512; u16* tp = mkv + 256 * 1024 + (size_t)cv * 256 + r;
                        const f32x4 v0 = acc[ai][bj][m][0], v1 = acc[ai][bj][m][1];
                        const unsigned w0 = cvt_pk_bf16(v0[0], v0[1]), w1 = cvt_pk_bf16(v0[2], v0[3]), w2 = cvt_pk_bf16(v1[0], v1[1]), w3 = cvt_pk_bf16(v1[2], v1[3]);
                        tp[0] = (u16)(w0 & 0xffffu); tp[256] = (u16)(w0 >> 16); tp[512] = (u16)(w1 & 0xffffu); tp[768] = (u16)(w1 >> 16);
                        tp[1024] = (u16)(w2 & 0xffffu); tp[1280] = (u16)(w2 >> 16); tp[1536] = (u16)(w3 & 0xffffu); tp[1792] = (u16)(w3 >> 16); } }
            return;
        }
        if (u.pm < 64 && ((u.pn >> 1) == T_SBV || (u.pn >> 1) == T_MLV || (u.pn >> 1) == T_RTV)) {
#pragma unroll
            for (int ai = 0; ai < 2; ++ai)
#pragma unroll
                for (int m = 0; m < 4; ++m) { const int r = row0 + ai * 128 + m * 16;
#pragma unroll
                    for (int bj = 0; bj < 2; ++bj) { const int c = col0 + bj * 128; u16* tp = b + ((size_t)((r >> 6) * 4 + (c >> 7))) * 8192 + (size_t)(c & 127) * 64 + (r & 63);
                        const f32x4 v0 = acc[ai][bj][m][0], v1 = acc[ai][bj][m][1];
                        const unsigned w0 = cvt_pk_bf16(v0[0], v0[1]), w1 = cvt_pk_bf16(v0[2], v0[3]), w2 = cvt_pk_bf16(v1[0], v1[1]), w3 = cvt_pk_bf16(v1[2], v1[3]);
                        tp[0] = (u16)(w0 & 0xffffu); tp[64] = (u16)(w0 >> 16); tp[128] = (u16)(w1 & 0xffffu); tp[192] = (u16)(w1 >> 16);
                        tp[256] = (u16)(w2 & 0xffffu); tp[320] = (u16)(w2 >> 16); tp[384] = (u16)(w3 & 0xffffu); tp[448] = (u16)(w3 >> 16); } }
            return;
        }
#pragma unroll
        for (int ai = 0; ai < 2; ++ai)
#pragma unroll
            for (int m = 0; m < 4; ++m) { u16* rowp = b + (size_t)(row0 + ai * 128 + m * 16) * ldc + col0;
#pragma unroll
                for (int bj = 0; bj < 2; ++bj) { const f32x4 v0 = acc[ai][bj][m][0], v1 = acc[ai][bj][m][1];
                    u32x4 w; w.x = cvt_pk_bf16(act_apply(v0[0], mode), act_apply(v0[1], mode)); w.y = cvt_pk_bf16(act_apply(v0[2], mode), act_apply(v0[3], mode));
                    w.z = cvt_pk_bf16(act_apply(v1[0], mode), act_apply(v1[1], mode)); w.w = cvt_pk_bf16(act_apply(v1[2], mode), act_apply(v1[3], mode));
                    *(u32x4*)(rowp + bj * 128) = w; __builtin_amdgcn_sched_barrier(0); } }
    }
};
__device__ __forceinline__ int eslot(int n) { return n == 0 ? T_SBQ : n == 1 ? T_MLQ : n == 2 ? T_MLV : n == 3 ? T_GMU : T_RTQ; }
__device__ __forceinline__ int yslot(int n) { return n == 0 ? T_SBZ : n == 1 ? T_MLZ : n == 2 ? T_GMZ : n == 3 ? T_RTZ : T_XAZ; }
struct EpiGateE {
    static constexpr bool PERM = true, AFTER_DRAIN = false, KEEPS = false;
    u16* proj;
    __device__ __forceinline__ void operator()(const f32x4 (&acc)[2][2][4][2], const pg8::Unit& u, int wr, int wc, int fr, int fq) const {
        const int n = u.pn >> 2; u16* b = proj + (size_t)eslot(n) * ((size_t)S_ * 512);
        const int row0 = u.pm * 256 + wr * 64 + fr, col0 = (u.pn & 3) * 256 + wc * 32 + 8 * fq;
#pragma unroll
        for (int ai = 0; ai < 2; ++ai)
#pragma unroll
            for (int m = 0; m < 4; ++m) { u16* rowp = b + (size_t)(row0 + ai * 128 + m * 16) * 1024 + col0;
#pragma unroll
                for (int bj = 0; bj < 2; ++bj) { const f32x4 v0 = acc[ai][bj][m][0], v1 = acc[ai][bj][m][1];
                    float e[8];
#pragma unroll
                    for (int i = 0; i < 4; ++i) { e[i] = fminf(1.0f + __expf(-v0[i]), 1e30f); e[4 + i] = fminf(1.0f + __expf(-v1[i]), 1e30f); }
                    u32x4 w; w.x = cvt_pk_bf16(e[0], e[1]); w.y = cvt_pk_bf16(e[2], e[3]); w.z = cvt_pk_bf16(e[4], e[5]); w.w = cvt_pk_bf16(e[6], e[7]);
                    *(u32x4*)(rowp + bj * 128) = w; } }
    }
};
struct EpiMerge {
    static constexpr bool PERM = true, AFTER_DRAIN = false, KEEPS = true;
    const u16* proj; u16* merged;
    __device__ __forceinline__ bool keep(const pg8::Unit& u) const { return u.n < 4; }
    __device__ __forceinline__ void operator()(f32x4 (&acc)[2][2][4][2], const pg8::Unit& u, int wr, int wc, int fr, int fq) const {
        const int n = u.n; const bool last = (n == 4);
        const u16* e0 = proj + (size_t)eslot(n) * ((size_t)S_ * 512); const u16* e1 = proj + (size_t)eslot(last ? 4 : n + 1) * ((size_t)S_ * 512);
        const int row0 = u.pm * 256 + wr * 64 + fr, col0 = u.pn * 256 + wc * 32 + 8 * fq;
#pragma unroll
        for (int ai = 0; ai < 2; ++ai) {
            u32x4 a[4][2], b[4][2];
#pragma unroll
            for (int m = 0; m < 4; ++m)
#pragma unroll
                for (int bj = 0; bj < 2; ++bj) { const size_t ro = (size_t)(row0 + ai * 128 + m * 16) * 1024 + col0 + bj * 128;
                    a[m][bj] = *(const u32x4*)(e0 + ro); b[m][bj] = *(const u32x4*)(e1 + ro); }
#pragma unroll
            for (int m = 0; m < 4; ++m)
#pragma unroll
                for (int bj = 0; bj < 2; ++bj) {
                    float f[8];
#pragma unroll
                    for (int i = 0; i < 8; ++i) { f[i] = __builtin_amdgcn_rcpf(bfe(a[m][bj], i)); if (!last) f[i] *= bfe(b[m][bj], i); }
#pragma unroll
                    for (int i = 0; i < 4; ++i) { acc[ai][bj][m][0][i] *= f[i]; acc[ai][bj][m][1][i] *= f[4 + i]; }
                    if (last) { const f32x4 v0 = acc[ai][bj][m][0], v1 = acc[ai][bj][m][1];
                        u32x4 w; w.x = cvt_pk_bf16(v0[0], v0[1]); w.y = cvt_pk_bf16(v0[2], v0[3]); w.z = cvt_pk_bf16(v1[0], v1[1]); w.w = cvt_pk_bf16(v1[2], v1[3]);
                        *(u32x4*)(merged + (size_t)(row0 + ai * 128 + m * 16) * 1024 + col0 + bj * 128) = w; } }
            asm volatile("" ::: "memory"); }
    }
};
struct UpOrder : pg8::StaticOrder {
    __device__ __forceinline__ bool next(int i, pg8::Unit& u) const { const int ti = i / 5; if (!pg8::StaticOrder::next(ti, u)) return false; u.n = i - ti * 5; return true; }
    __device__ __forceinline__ const char* abase(const pg8::Gemm& g, const pg8::Unit& u, size_t tstep) const { return (const char*)g.A + (size_t)yslot(u.n) * SZ_T + (size_t)u.pm * tstep; }
    __device__ __forceinline__ const char* bbase(const pg8::Gemm& g, const pg8::Unit& u, size_t tstep) const { return (const char*)g.Bt + ((size_t)u.n * 1024 + (size_t)u.pn * 256) * 1024; }
};
struct EpiOutBf16 {
    static constexpr bool PERM = true, AFTER_DRAIN = false, KEEPS = false;
    u16* C;
    __device__ __forceinline__ void operator()(const f32x4 (&acc)[2][2][4][2], const pg8::Unit& u, int wr, int wc, int fr, int fq) const {
        const int row0 = u.pm * 256 + wr * 64 + fr, col0 = u.pn * 256 + wc * 32 + 8 * fq;
#pragma unroll
        for (int ai = 0; ai < 2; ++ai)
#pragma unroll
            for (int m = 0; m < 4; ++m) { u16* rowp = C + (size_t)(row0 + ai * 128 + m * 16) * 1024 + col0;
#pragma unroll
                for (int bj = 0; bj < 2; ++bj) { const f32x4 v0 = acc[ai][bj][m][0], v1 = acc[ai][bj][m][1];
                    u32x4 w; w.x = cvt_pk_bf16(v0[0], v0[1]); w.y = cvt_pk_bf16(v0[2], v0[3]); w.z = cvt_pk_bf16(v1[0], v1[1]); w.w = cvt_pk_bf16(v1[2], v1[3]);
                    *(u32x4*)(rowp + bj * 128) = w; } }
    }
};
struct EpiF32 {
    static constexpr bool PERM = false, AFTER_DRAIN = false, KEEPS = false;
    float* C; int ldc;
    __device__ __forceinline__ void operator()(const f32x4 (&acc)[2][2][4][2], const pg8::Unit& u, int wr, int wc, int fr, int fq) const {
        const int row0 = u.pm * 256 + wr * 64 + fr, col0 = u.pn * 256 + wc * 32 + 4 * fq;
#pragma unroll
        for (int ai = 0; ai < 2; ++ai)
#pragma unroll
            for (int m = 0; m < 4; ++m) { float* rowp = C + (size_t)(row0 + ai * 128 + m * 16) * ldc + col0;
#pragma unroll
                for (int bj = 0; bj < 2; ++bj)
#pragma unroll
                    for (int n = 0; n < 2; ++n) *(f32x4*)(rowp + bj * 128 + n * 16) = acc[ai][bj][m][n]; }
    }
};
struct ProjOrder : pg8::StaticOrder {
    int nfull;
    __device__ __forceinline__ bool next(int i, pg8::Unit& u) const {
        if (i < nfull) return pg8::StaticOrder::next(i, u);
        if (i == nfull && c < 4) { u.pm = 64; u.pn = 70 + c; return true; }
        return false; }
};
struct OneUnit { int pm, pn, cnt;
    __device__ __forceinline__ const char* abase(const pg8::Gemm& g, const pg8::Unit& u, size_t tstep) const { return (const char*)g.A + (size_t)u.pm * tstep; }
    __device__ __forceinline__ const char* bbase(const pg8::Gemm& g, const pg8::Unit& u, size_t tstep) const { return (const char*)g.Bt + (size_t)u.pn * tstep; }
    __device__ __forceinline__ bool next(int i, pg8::Unit& u) const { if (i >= cnt) return false; u.pm = pm; u.pn = pn; return true; }
    __device__ __forceinline__ void a_ready(const pg8::Unit&) const {}
    __device__ __forceinline__ void done(const pg8::Unit&) const {}
};

__device__ __forceinline__ void transpose_item(const float* W, int ldw, int c0, int k0, u16* WT, int K, int n0, LAS float* scr, int lane) {
    f32x4 tv[8];
#pragma unroll
    for (int i = 0; i < 8; ++i) { const int kk = 8 * i + (lane >> 3); tv[i] = *(const f32x4*)(W + (size_t)(k0 + kk) * ldw + c0 + (lane & 7) * 4); }
#pragma unroll
    for (int i = 0; i < 8; ++i) { const int kk = 8 * i + (lane >> 3); LAS float* d = scr + kk * 33 + (lane & 7) * 4; d[0] = tv[i][0]; d[1] = tv[i][1]; d[2] = tv[i][2]; d[3] = tv[i][3]; }
    LDS_WAIT();
    const int c = lane & 7;
#pragma unroll
    for (int j = 0; j < 4; ++j) { const int n = (lane >> 3) + 8 * j; const LAS float* s = scr + (8 * c) * 33 + n;
        u32x4 o; o.x = cvt_pk_bf16(s[0 * 33], s[1 * 33]); o.y = cvt_pk_bf16(s[2 * 33], s[3 * 33]); o.z = cvt_pk_bf16(s[4 * 33], s[5 * 33]); o.w = cvt_pk_bf16(s[6 * 33], s[7 * 33]);
        *(u32x4*)(WT + (size_t)(n0 + n) * K + k0 + 8 * c) = o; }
    LDS_WAIT();
}
__device__ __forceinline__ void phase_prep(const Params& p, int l, LAS unsigned char* lds, const int tid, const int bid, const int nblk) {
    const int lane = tid & 63, wave = tid >> 6;
    unsigned char* ws = p.ws;
    const int gw = bid * 8 + wave, NGW = nblk * 8;
    if (l < 2) {
        LAS float* scr = (LAS float*)(lds + wave * 8448);
        const float* w_in = (const float*)p.in[5] + (size_t)l * 1024 * DIN;
        const float* w_mkv = (const float*)p.in[15] + (size_t)l * 1024 * 1024;
        const float* w_up = (const float*)p.in[16] + (size_t)l * 5 * 512 * 1024;
        const float* w_out = (const float*)p.in[17] + (size_t)l * 1024 * 1024;
        constexpr int I_IN = 16 * 448, I_UP = 5 * 256, I_SQ = 512;
        for (int it = gw; it < I_IN + I_UP + 2 * I_SQ; it += NGW) {
            int r = it;
            if (r < I_IN) { const int kb = r / 448, nb = r % 448, n0 = nb * 32; transpose_item(w_in, DIN, n0 + (n0 >= 4608 ? 8 : 0), kb * 64, (u16*)(ws + OFF_WIN), 1024, n0, scr, lane); continue; }
            r -= I_IN;
            if (r < I_UP) { const int n = r / 256, q = r % 256, kb = q / 32, nb = q % 32; transpose_item(w_up + (size_t)n * 512 * 1024, 1024, nb * 32, kb * 64, (u16*)(ws + OFF_WUP) + (size_t)n * 1024 * 512, 512, nb * 32, scr, lane); continue; }
            r -= I_UP;
            if (r < I_SQ) { const int kb = r / 32, nb = r % 32; transpose_item(w_out, 1024, nb * 32, kb * 64, (u16*)(ws + OFF_WOUT), 1024, nb * 32, scr, lane); continue; }
            r -= I_SQ;
            { const int kb = r / 32, nb = r % 32; transpose_item(w_mkv, 1024, nb * 32, kb * 64, (u16*)(ws + OFF_WMKV), 1024, nb * 32, scr, lane); }
        }
    }
    LAS float* w8 = (LAS float*)(lds + 73728);
    if (l < 2) {
        const float* w_in = (const float*)p.in[5] + (size_t)l * 1024 * DIN;
        for (int i = tid; i < 8192; i += 512) w8[i] = w_in[(size_t)(i >> 3) * DIN + 4608 + (i & 7)];
    }
    __syncthreads();
    const float* xin = (l <= 1) ? (const float*)p.in[0] : (const float*)p.out;
    const u16* outf = (const u16*)(ws + OFF_OUTF);
    const int nrows = S_ + (l < 2 ? 256 : 0);
    for (int row = gw; row < nrows; row += NGW) {
        if (row < S_) {
            f32x4 v[4];
            const f32x4* xr = (const f32x4*)(xin + (size_t)row * 1024) + lane;
#pragma unroll
            for (int j = 0; j < 4; ++j) v[j] = xr[64 * j];
            if (l > 0) {
                const u32x2* orow = (const u32x2*)(outf + (size_t)row * 1024) + lane; const f32x4* gp = (const f32x4*)((const float*)p.in[4] + (size_t)(l - 1) * 1024) + lane;
                f32x4 o[4]; float ss = 0.f;
#pragma unroll
                for (int j = 0; j < 4; ++j) { const u32x2 ob = orow[64 * j]; o[j] = (f32x4){bf_lo(ob.x), bf_hi(ob.x), bf_lo(ob.y), bf_hi(ob.y)}; ss += (o[j][0] * o[j][0] + o[j][1] * o[j][1]) + (o[j][2] * o[j][2] + o[j][3] * o[j][3]); }
                const float rs = rsqrtf(wave_sum(ss) * (1.0f / 1024.0f) + EPS);
                f32x4* dst = (f32x4*)(p.out + (size_t)row * 1024) + lane;
#pragma unroll
                for (int j = 0; j < 4; ++j) { v[j] = v[j] + o[j] * rs * gp[64 * j]; dst[64 * j] = v[j]; }
            }
            if (l < 2) {
                float ss = 0.f;
#pragma unroll
                for (int j = 0; j < 4; ++j) ss += (v[j][0] * v[j][0] + v[j][1] * v[j][1]) + (v[j][2] * v[j][2] + v[j][3] * v[j][3]);
                const float rs = rsqrtf(wave_sum(ss) * (1.0f / 1024.0f) + EPS);
                const f32x4* gp = (const f32x4*)((const float*)p.in[3] + (size_t)l * 1024) + lane;
                u32x2* hrow = (u32x2*)((u16*)(ws + OFF_H) + (size_t)row * 1024) + lane;
                float g8[8];
#pragma unroll
                for (int q = 0; q < 8; ++q) g8[q] = 0.f;
#pragma unroll
                for (int j = 0; j < 4; ++j) { const f32x4 hv = v[j] * rs * gp[64 * j];
                    u32x2 w; w.x = cvt_pk_bf16(hv[0], hv[1]); w.y = cvt_pk_bf16(hv[2], hv[3]); hrow[64 * j] = w;
#pragma unroll
                    for (int i = 0; i < 4; ++i) { const int k = 4 * lane + 256 * j + i; const f32x4 wa = *(const LAS f32x4*)(w8 + k * 8), wb = *(const LAS f32x4*)(w8 + k * 8 + 4);
                        g8[0] += hv[i] * wa[0]; g8[1] += hv[i] * wa[1]; g8[2] += hv[i] * wa[2]; g8[3] += hv[i] * wa[3];
                        g8[4] += hv[i] * wb[0]; g8[5] += hv[i] * wb[1]; g8[6] += hv[i] * wb[2]; g8[7] += hv[i] * wb[3]; } }
#pragma unroll
                for (int q = 0; q < 8; ++q) g8[q] = wave_sum(g8[q]);
                if (lane < 8) { float val = g8[0];
#pragma unroll
                    for (int q = 1; q < 8; ++q) val = (lane == q) ? g8[q] : val;
                    const float bias = (lane < 4) ? ((const float*)p.in[6])[l * 4 + lane] : ((const float*)p.in[7])[l * 4 + lane - 4];
                    ((float*)(ws + OFF_IF))[(size_t)row * 8 + lane] = val + bias; }
            }
        } else {
            const int mr = row - S_;
            const f32x4* xr = (const f32x4*)((const float*)p.in[1] + (size_t)mr * 1024) + lane; const f32x4* gp = (const f32x4*)((const float*)p.in[14] + (size_t)l * 1024) + lane;
            f32x4 v[4]; float ss = 0.f;
#pragma unroll
            for (int j = 0; j < 4; ++j) { v[j] = xr[64 * j]; ss += (v[j][0] * v[j][0] + v[j][1] * v[j][1]) + (v[j][2] * v[j][2] + v[j][3] * v[j][3]); }
            const float rs = rsqrtf(wave_sum(ss) * (1.0f / 1024.0f) + EPS);
            u32x2* hrow = (u32x2*)((u16*)(ws + OFF_MEMH) + (size_t)mr * 1024) + lane;
#pragma unroll
            for (int j = 0; j < 4; ++j) { const f32x4 hv = v[j] * rs * gp[64 * j]; u32x2 w; w.x = cvt_pk_bf16(hv[0], hv[1]); w.y = cvt_pk_bf16(hv[2], hv[3]); hrow[64 * j] = w; }
        }
    }
}

__device__ __forceinline__ void sb_item(const u16* Q, const u16* Kg, const u16* Vg, const u16* ZY, u16* ZW, int qb, int h, LAS unsigned char* lds, const int tid) {
    const int lane = tid & 63, w = tid >> 6, fr = lane & 15, quad = lane >> 4;
    LAS u16* Qs = (LAS u16*)lds;
    LAS u16* Ks = Qs + 128 * 136;
    LAS u16* VT = Ks + 64 * 136;
    LAS int* flg = (LAS int*)(VT + 128 * 72);
    const int q0 = qb * 128;
    u32x4 qpre[4];
#pragma unroll
    for (int i = 0; i < 4; ++i) { const int ch = tid + i * 512, r = ch >> 4, c = ch & 15; qpre[i] = *(const u32x4*)(Q + (size_t)(q0 + r) * 512 + h * 128 + c * 8); }
    u32x4 kreg[2], vreg[2];
#pragma unroll
    for (int i = 0; i < 2; ++i) { const int ch = tid + i * 512, r = ch >> 4, c = ch & 15, c2 = w + 8 * i; const int kt = 2 * qb + 1;
        kreg[i] = *(const u32x4*)(Kg + (size_t)(kt * 64 + r) * 512 + h * 128 + c * 8);
        vreg[i] = *(const u32x4*)(Vg + (size_t)(kt * 4 + h) * 8192 + (size_t)ch * 8); (void)c2; }
    LBAR();
#pragma unroll
    for (int i = 0; i < 4; ++i) { const int ch = tid + i * 512, r = ch >> 4, c = ch & 15; *(LAS u32x4*)(Qs + r * 136 + c * 8) = qpre[i]; }
    if (tid < 8) flg[tid] = 0;
    f32x4 o[8];
#pragma unroll
    for (int i = 0; i < 8; ++i) o[i] = (f32x4){0.f, 0.f, 0.f, 0.f};
    float carry = 0.f; int wdone = 0;
    const int tq = q0 + w * 16 + fr;
    for (int kt = 2 * qb + 1; kt >= 0; --kt) {
        LBAR();
        int nd = 0;
#pragma unroll
        for (int i = 0; i < 8; ++i) nd += flg[i];
        if (nd == 8) break;
#pragma unroll
        for (int i = 0; i < 2; ++i) { const int ch = tid + i * 512, r = ch >> 4, c = ch & 15;
            *(LAS u32x4*)(Ks + r * 136 + c * 8) = kreg[i];
            *(LAS u32x4*)(VT + (ch >> 3) * 72 + (ch & 7) * 8) = vreg[i]; }
        LBAR();
        if (kt > 0) {
#pragma unroll
            for (int i = 0; i < 2; ++i) { const int ch = tid + i * 512, r = ch >> 4, c = ch & 15, c2 = w + 8 * i;
                kreg[i] = *(const u32x4*)(Kg + (size_t)((kt - 1) * 64 + r) * 512 + h * 128 + c * 8);
                vreg[i] = *(const u32x4*)(Vg + (size_t)((kt - 1) * 4 + h) * 8192 + (size_t)ch * 8); (void)c2; } }
        const int wq0 = q0 + w * 16;
        if (!wdone && kt * 64 < wq0 + 15) {
        const bool full = (kt * 64 + 63 < wq0);
        f32x4 st[4];
#pragma unroll
        for (int i = 0; i < 4; ++i) st[i] = (f32x4){0.f, 0.f, 0.f, 0.f};
#pragma unroll
        for (int ks = 0; ks < 4; ++ks) { const bf16x8 qf = lfrag(Qs, w * 16 + fr, 136, ks * 32 + quad * 8);
#pragma unroll
            for (int mt = 0; mt < 4; ++mt) st[mt] = MFMA16(lfrag(Ks, mt * 16 + fr, 136, ks * 32 + quad * 8), qf, st[mt]); }
        float run = carry; int dead = 0;
#pragma unroll
        for (int mt = 3; mt >= 0; --mt) {
            const int kb = kt * 64 + mt * 16;
            if (dead || kb >= wq0 + 16) { st[mt] = (f32x4){0.f, 0.f, 0.f, 0.f}; }
            else {
                const bool mfull = full || (kb + 15 < wq0);
                float l[4], ls[4], gs = 0.f;
#pragma unroll
                for (int j = 0; j < 4; ++j) { const float zc = __builtin_amdgcn_fmed3f(st[mt][j], -115.0f, 115.0f);
                    const float sp = __builtin_amdgcn_logf(1.0f + __builtin_amdgcn_exp2f(zc));
                    l[j] = -sp; ls[j] = zc - sp;
                    if (!mfull) { const bool valid = (kb + quad * 4 + j) < tq; l[j] = valid ? l[j] : 0.f; ls[j] = valid ? ls[j] : -1e30f; }
                    gs += l[j]; }
                const float g1 = __shfl(gs, ((quad + 1) & 3) * 16 + fr), g2 = __shfl(gs, ((quad + 2) & 3) * 16 + fr), g3 = __shfl(gs, ((quad + 3) & 3) * 16 + fr);
                const float qsuf = (quad < 3 ? g1 : 0.f) + (quad < 2 ? g2 : 0.f) + (quad < 1 ? g3 : 0.f);
                const float b3 = run + qsuf, b2 = b3 + l[3], b1 = b2 + l[2], b0 = b1 + l[1];
                st[mt][3] = __builtin_amdgcn_exp2f(ls[3] + b3); st[mt][2] = __builtin_amdgcn_exp2f(ls[2] + b2); st[mt][1] = __builtin_amdgcn_exp2f(ls[1] + b1); st[mt][0] = __builtin_amdgcn_exp2f(ls[0] + b0);
                run += gs + g1 + g2 + g3;
                dead = __all(run < -151.0f);
            }
        }
        carry = run;
#pragma unroll
        for (int k2 = 0; k2 < 2; ++k2) { const bf16x8 pf = pack_p(st[2 * k2], st[2 * k2 + 1]);
#pragma unroll
            for (int mt = 0; mt < 8; ++mt) o[mt] = MFMA16(lfrag_slot(VT, mt * 16 + fr, 72, k2 * 32, quad), pf, o[mt]); }
        wdone = __all(carry < -151.0f);
        if (lane == 0) flg[w] = wdone ? 1 : 0;
        }
    }
    const u16* zr = ZY + (size_t)tq * 512 + h * 128 + quad * 4; u16* zw = ZW + (size_t)tq * 512 + h * 128 + quad * 4;
#pragma unroll
    for (int mt = 0; mt < 8; ++mt) { const u32x2 z = *(const u32x2*)(zr + mt * 16);
        u32x2 r; r.x = cvt_pk_bf16(o[mt][0] * siluf_(bf_lo(z.x)), o[mt][1] * siluf_(bf_hi(z.x))); r.y = cvt_pk_bf16(o[mt][2] * siluf_(bf_lo(z.y)), o[mt][3] * siluf_(bf_hi(z.y)));
        *(u32x2*)(zw + mt * 16) = r; }
}

__device__ __forceinline__ void ml_chunk_gates(const float ic, const float fp, int lane, float& bcum, float& g) {
    float b = fminf(fp, 0.f) - __logf(1.0f + __expf(-fabsf(fp)));
#pragma unroll
    for (int o = 1; o < 64; o <<= 1) { const float n = __shfl_up(b, o); if (lane >= o) b += n; }
    float x = ic - b;
#pragma unroll
    for (int o = 1; o < 64; o <<= 1) { const float n = __shfl_up(x, o); if (lane >= o) x = fmaxf(x, n); }
    bcum = b; g = b + x;
}
__device__ __forceinline__ void rot_cs(int pos, int i, float& cs, float& sn) {
    const float ang = (float)pos * INVF[i];
    double rev = (double)ang * 0.15915494309189535; rev -= floor(rev);
    const float fr = (float)rev;
    sn = __builtin_amdgcn_sinf(fr); cs = __builtin_amdgcn_cosf(fr);
}
template <bool RT, bool TRANSPOSED>
__device__ __forceinline__ void stage_qk(const u16* X, const float* convw, const int* pos, int c, int h, float scale, const LAS float* scale_row, LAS u16* dst, const int tid) {
    if (!RT) {
#pragma unroll
        for (int i = 0; i < 2; ++i) { const int ch = tid + i * 512; const int l = TRANSPOSED ? (tid & 63) : (ch >> 4), d0 = TRANSPOSED ? ((tid >> 6) + 8 * i) * 8 : (ch & 15) * 8;
            float a[8];
#pragma unroll
            for (int e = 0; e < 8; ++e) a[e] = 0.f;
#pragma unroll
            for (int j = 0; j < 4; ++j) { const int tt = c * 64 + l - 3 + j;
                if (tt >= 0) { const u32x4 v = *(const u32x4*)(X + (size_t)tt * 512 + h * 128 + d0); const f32x4 w0 = *(const f32x4*)(convw + j * 512 + h * 128 + d0), w1 = *(const f32x4*)(convw + j * 512 + h * 128 + d0 + 4);
#pragma unroll
                    for (int e = 0; e < 4; ++e) { a[e] += w0[e] * bfe(v, e); a[4 + e] += w1[e] * bfe(v, 4 + e); } } }
            const float sr = scale * (scale_row ? scale_row[l] : 1.0f);
#pragma unroll
            for (int e = 0; e < 8; ++e) a[e] = siluf_(a[e]) * sr;
            if (TRANSPOSED) st_tr8(dst, 72, d0, l, a);
            else { u32x4 o; o.x = cvt_pk_bf16(a[0], a[1]); o.y = cvt_pk_bf16(a[2], a[3]); o.z = cvt_pk_bf16(a[4], a[5]); o.w = cvt_pk_bf16(a[6], a[7]); *(LAS u32x4*)(dst + l * 136 + d0) = o; } }
    } else {
        const int l = TRANSPOSED ? (tid & 63) : (tid >> 3), d0 = TRANSPOSED ? (tid >> 6) * 8 : (tid & 7) * 8; const int t = c * 64 + l; const int ps = pos[t];
        const u32x4 v1 = *(const u32x4*)(X + (size_t)t * 512 + h * 128 + d0), v2 = *(const u32x4*)(X + (size_t)t * 512 + h * 128 + 64 + d0);
        const float sr = scale * (scale_row ? scale_row[l] : 1.0f);
        float a[8], b[8];
#pragma unroll
        for (int e = 0; e < 8; ++e) { float cs, sn; rot_cs(ps, d0 + e, cs, sn); const float t1 = bfe(v1, e), t2 = bfe(v2, e); a[e] = (t1 * cs - t2 * sn) * sr; b[e] = (t1 * sn + t2 * cs) * sr; }
        if (TRANSPOSED) { st_tr8(dst, 72, d0, l, a); st_tr8(dst, 72, 64 + d0, l, b); }
        else { u32x4 o; o.x = cvt_pk_bf16(a[0], a[1]); o.y = cvt_pk_bf16(a[2], a[3]); o.z = cvt_pk_bf16(a[4], a[5]); o.w = cvt_pk_bf16(a[6], a[7]); *(LAS u32x4*)(dst + l * 136 + d0) = o;
               o.x = cvt_pk_bf16(b[0], b[1]); o.y = cvt_pk_bf16(b[2], b[3]); o.z = cvt_pk_bf16(b[4], b[5]); o.w = cvt_pk_bf16(b[6], b[7]); *(LAS u32x4*)(dst + l * 136 + 64 + d0) = o; }
    }
}
__device__ __forceinline__ void stage_vt(const u16* V, int c, int h, LAS u16* VT, const int tid) {
#pragma unroll
    for (int i = 0; i < 2; ++i) { const int l = tid & 63, d0 = ((tid >> 6) + 8 * i) * 8;
        st_tr8_raw(VT, 72, d0, l, *(const u32x4*)(V + (size_t)(c * 64 + l) * 512 + h * 128 + d0)); }
}

template <bool RT>
__device__ __forceinline__ void kv1_item(const Params& p, int l, int c, int h, LAS unsigned char* lds, const int tid) {
    const int lane = tid & 63, w = tid >> 6, fr = lane & 15, quad = lane >> 4;
    unsigned char* ws = p.ws;
    LAS u16* KWT = (LAS u16*)lds;
    LAS u16* VT = KWT + 128 * 72;
    LAS float* wend = (LAS float*)(VT + 128 * 72);
    const u16* proj = (const u16*)(ws + OFF_PROJ);
    float* SC = (float*)(ws + OFF_SC);
    float ic = 0.f, fpv = 0.f;
    if (!RT && w == 0) { const float* IFg = (const float*)(ws + OFF_IF) + (size_t)(c * 64 + lane) * 8; ic = IFg[h]; fpv = IFg[4 + h]; }
    u32x4 vpre[2];
#pragma unroll
    for (int i = 0; i < 2; ++i) vpre[i] = *(const u32x4*)(proj + (size_t)(RT ? T_RTV : T_MLV) * S_ * 512 + (size_t)(c * 4 + h) * 8192 + (size_t)(tid + i * 512) * 8);
    u32x4 kpre[2][4]; int kpos = 0;
    { const int l_ = tid & 63; const u16* Kb = proj + (size_t)(RT ? T_RTK : T_MLK) * S_ * 512;
      if (!RT) {
#pragma unroll
        for (int i = 0; i < 2; ++i) { const int d0 = ((tid >> 6) + 8 * i) * 8;
#pragma unroll
            for (int j = 0; j < 4; ++j) { const int tt = c * 64 + l_ - 3 + j; kpre[i][j] = (tt >= 0) ? *(const u32x4*)(Kb + (size_t)tt * 512 + h * 128 + d0) : (u32x4){0u, 0u, 0u, 0u}; } }
      } else { const int d0 = (tid >> 6) * 8, t = c * 64 + l_; kpos = ((const int*)p.in[2])[t];
        kpre[0][0] = *(const u32x4*)(Kb + (size_t)t * 512 + h * 128 + d0); kpre[0][1] = *(const u32x4*)(Kb + (size_t)t * 512 + h * 128 + 64 + d0); } }
    LBAR();
    if (!RT) { if (w == 0) { float bcum, g; ml_chunk_gates(ic, fpv, lane, bcum, g);
            const float bl = __shfl(bcum, 63), al = __shfl(g, 63);
            wend[lane] = fexp(bl - bcum + ic - al);
            *(float2*)((float*)(ws + OFF_GATES) + ((size_t)h * S_ + c * 64 + lane) * 2) = make_float2(bcum, g);
            if (lane == 0) { SC[h * 256 + c] = bl; SC[1024 + h * 256 + c] = al; } } }
    else { if (tid < 64) wend[tid] = fexp(log_gamma(h) * (float)(63 - tid)); }
    LBAR();
    { const int l_ = tid & 63; const float sr = QSCALE * wend[l_];
      if (!RT) { const LAS float* convw = (const LAS float*)(lds + LDS_CONV) + 2048;
#pragma unroll
        for (int i = 0; i < 2; ++i) { const int d0 = ((tid >> 6) + 8 * i) * 8; float a[8];
#pragma unroll
            for (int e = 0; e < 8; ++e) a[e] = 0.f;
#pragma unroll
            for (int j = 0; j < 4; ++j) { const f32x4 w0 = *(const LAS f32x4*)(convw + j * 512 + h * 128 + d0), w1 = *(const LAS f32x4*)(convw + j * 512 + h * 128 + d0 + 4);
#pragma unroll
                for (int e = 0; e < 4; ++e) { a[e] += w0[e] * bfe(kpre[i][j], e); a[4 + e] += w1[e] * bfe(kpre[i][j], 4 + e); } }
#pragma unroll
            for (int e = 0; e < 8; ++e) a[e] = siluf_(a[e]) * sr;
            st_tr8(KWT, 72, d0, l_, a); }
      } else { const int d0 = (tid >> 6) * 8; float a[8], b[8];
#pragma unroll
        for (int e = 0; e < 8; ++e) { float cs, sn; rot_cs(kpos, d0 + e, cs, sn); const float t1 = bfe(kpre[0][0], e), t2 = bfe(kpre[0][1], e); a[e] = (t1 * cs - t2 * sn) * sr; b[e] = (t1 * sn + t2 * cs) * sr; }
        st_tr8(KWT, 72, d0, l_, a); st_tr8(KWT, 72, 64 + d0, l_, b); } }
#pragma unroll
    for (int i = 0; i < 2; ++i) { const int ch = tid + i * 512; *(LAS u32x4*)(VT + (ch >> 3) * 72 + (ch & 7) * 8) = vpre[i]; }
    LBAR();
    const int db = (w & 3) * 32, eh = (w >> 2) * 64;
    f32x4 acc[2][4];
#pragma unroll
    for (int a = 0; a < 2; ++a)
#pragma unroll
        for (int b = 0; b < 4; ++b) acc[a][b] = (f32x4){0.f, 0.f, 0.f, 0.f};
#pragma unroll
    for (int ks = 0; ks < 2; ++ks) { bf16x8 af[2], bfr[4];
#pragma unroll
        for (int a = 0; a < 2; ++a) af[a] = lfrag(KWT, db + a * 16 + fr, 72, ks * 32 + quad * 8);
#pragma unroll
        for (int b = 0; b < 4; ++b) bfr[b] = lfrag(VT, eh + b * 16 + fr, 72, ks * 32 + quad * 8);
#pragma unroll
        for (int a = 0; a < 2; ++a)
#pragma unroll
            for (int b = 0; b < 4; ++b) acc[a][b] = MFMA16(af[a], bfr[b], acc[a][b]); }
    u16* ST = (u16*)(ws + OFF_KV) + ((size_t)((RT ? 4 : 0) + h) * 256 + c) * 16384;
#pragma unroll
    for (int a = 0; a < 2; ++a)
#pragma unroll
        for (int b = 0; b < 4; ++b) { const int e = eh + b * 16 + fr, d = db + a * 16 + quad * 4;
            u32x2 r; r.x = cvt_pk_bf16(acc[a][b][0], acc[a][b][1]); r.y = cvt_pk_bf16(acc[a][b][2], acc[a][b][3]); *(u32x2*)(ST + e * 128 + d) = r; }
    if (!RT && tid < 128) { float s = 0.f;
#pragma unroll 8
        for (int i = 0; i < 64; ++i) s += bf2f(KWT[tid * 72 + i]);
        ((float*)(ws + OFF_NST))[((size_t)h * 256 + c) * 128 + tid] = s; }
}

__device__ __forceinline__ void kv1_pair(const Params& p, int l, int c, int h, LAS unsigned char* lds, const int tid) {
    const int lane = tid & 63, w = tid >> 6, fr = lane & 15, quad = lane >> 4;
    unsigned char* ws = p.ws;
    LAS u16* KWTa = (LAS u16*)lds;
    LAS u16* VTa = KWTa + 128 * 72;
    LAS float* wenda = (LAS float*)(VTa + 128 * 72);
    LAS u16* KWTb = (LAS u16*)(lds + 40960);
    LAS u16* VTb = KWTb + 128 * 72;
    LAS float* wendb = (LAS float*)(VTb + 128 * 72);
    const u16* proj = (const u16*)(ws + OFF_PROJ);
    float* SC = (float*)(ws + OFF_SC);
    const int l_ = tid & 63;
    float ic = 0.f, fpv = 0.f;
    if (w == 0) { const float* IFg = (const float*)(ws + OFF_IF) + (size_t)(c * 64 + lane) * 8; ic = IFg[h]; fpv = IFg[4 + h]; }
    u32x4 vpa[2], vpb[2], kpa[2][4], kpb[2];
#pragma unroll
    for (int i = 0; i < 2; ++i) { vpa[i] = *(const u32x4*)(proj + (size_t)T_MLV * S_ * 512 + (size_t)(c * 4 + h) * 8192 + (size_t)(tid + i * 512) * 8);
        vpb[i] = *(const u32x4*)(proj + (size_t)T_RTV * S_ * 512 + (size_t)(c * 4 + h) * 8192 + (size_t)(tid + i * 512) * 8); }
    { const u16* Kb = proj + (size_t)T_MLK * S_ * 512;
#pragma unroll
      for (int i = 0; i < 2; ++i) { const int d0 = ((tid >> 6) + 8 * i) * 8;
#pragma unroll
          for (int j = 0; j < 4; ++j) { const int tt = c * 64 + l_ - 3 + j; kpa[i][j] = (tt >= 0) ? *(const u32x4*)(Kb + (size_t)tt * 512 + h * 128 + d0) : (u32x4){0u, 0u, 0u, 0u}; } } }
    const int kpos = ((const int*)p.in[2])[c * 64 + l_];
    { const u16* Kb = proj + (size_t)T_RTK * S_ * 512; const int d0 = (tid >> 6) * 8, t = c * 64 + l_;
      kpb[0] = *(const u32x4*)(Kb + (size_t)t * 512 + h * 128 + d0); kpb[1] = *(const u32x4*)(Kb + (size_t)t * 512 + h * 128 + 64 + d0); }
    LBAR();
    if (w == 0) { float bcum, g; ml_chunk_gates(ic, fpv, lane, bcum, g);
        const float bl = __shfl(bcum, 63), al = __shfl(g, 63);
        wenda[lane] = fexp(bl - bcum + ic - al);
        *(float2*)((float*)(ws + OFF_GATES) + ((size_t)h * S_ + c * 64 + lane) * 2) = make_float2(bcum, g);
        if (lane == 0) { SC[h * 256 + c] = bl; SC[1024 + h * 256 + c] = al; } }
    else if (w == 1) wendb[lane] = fexp(log_gamma(h) * (float)(63 - lane));
    LBAR();
    { const float sra = QSCALE * wenda[l_], srb = QSCALE * wendb[l_];
      const LAS float* convw = (const LAS float*)(lds + LDS_CONV) + 2048;
#pragma unroll
      for (int i = 0; i < 2; ++i) { const int d0 = ((tid >> 6) + 8 * i) * 8; float a[8];
#pragma unroll
          for (int e = 0; e < 8; ++e) a[e] = 0.f;
#pragma unroll
          for (int j = 0; j < 4; ++j) { const f32x4 w0 = *(const LAS f32x4*)(convw + j * 512 + h * 128 + d0), w1 = *(const LAS f32x4*)(convw + j * 512 + h * 128 + d0 + 4);
#pragma unroll
              for (int e = 0; e < 4; ++e) { a[e] += w0[e] * bfe(kpa[i][j], e); a[4 + e] += w1[e] * bfe(kpa[i][j], 4 + e); } }
#pragma unroll
          for (int e = 0; e < 8; ++e) a[e] = siluf_(a[e]) * sra;
          st_tr8(KWTa, 72, d0, l_, a); }
      { const int d0 = (tid >> 6) * 8; float a[8], b[8];
#pragma unroll
        for (int e = 0; e < 8; ++e) { float cs, sn; rot_cs(kpos, d0 + e, cs, sn); const float t1 = bfe(kpb[0], e), t2 = bfe(kpb[1], e); a[e] = (t1 * cs - t2 * sn) * srb; b[e] = (t1 * sn + t2 * cs) * srb; }
        st_tr8(KWTb, 72, d0, l_, a); st_tr8(KWTb, 72, 64 + d0, l_, b); } }
#pragma unroll
    for (int i = 0; i < 2; ++i) { const int ch = tid + i * 512; *(LAS u32x4*)(VTa + (ch >> 3) * 72 + (ch & 7) * 8) = vpa[i]; *(LAS u32x4*)(VTb + (ch >> 3) * 72 + (ch & 7) * 8) = vpb[i]; }
    LBAR();
    const int db = (w & 3) * 32, eh = (w >> 2) * 64;
#pragma unroll
    for (int br = 0; br < 2; ++br) {
        const LAS u16* KWT = br ? KWTb : KWTa; const LAS u16* VT = br ? VTb : VTa;
        f32x4 acc[2][4];
#pragma unroll
        for (int a = 0; a < 2; ++a)
#pragma unroll
            for (int b = 0; b < 4; ++b) acc[a][b] = (f32x4){0.f, 0.f, 0.f, 0.f};
#pragma unroll
        for (int ks = 0; ks < 2; ++ks) { bf16x8 af[2], bfr[4];
#pragma unroll
            for (int a = 0; a < 2; ++a) af[a] = lfrag(KWT, db + a * 16 + fr, 72, ks * 32 + quad * 8);
#pragma unroll
            for (int b = 0; b < 4; ++b) bfr[b] = lfrag(VT, eh + b * 16 + fr, 72, ks * 32 + quad * 8);
#pragma unroll
            for (int a = 0; a < 2; ++a)
#pragma unroll
                for (int b = 0; b < 4; ++b) acc[a][b] = MFMA16(af[a], bfr[b], acc[a][b]); }
        u16* ST = (u16*)(ws + OFF_KV) + ((size_t)((br ? 4 : 0) + h) * 256 + c) * 16384;
#pragma unroll
        for (int a = 0; a < 2; ++a)
#pragma unroll
            for (int b = 0; b < 4; ++b) { const int e = eh + b * 16 + fr, d = db + a * 16 + quad * 4;
                u32x2 r; r.x = cvt_pk_bf16(acc[a][b][0], acc[a][b][1]); r.y = cvt_pk_bf16(acc[a][b][2], acc[a][b][3]); *(u32x2*)(ST + e * 128 + d) = r; }
    }
    if (tid < 128) { float sacc = 0.f;
#pragma unroll 8
        for (int i = 0; i < 64; ++i) sacc += bf2f(KWTa[tid * 72 + i]);
        ((float*)(ws + OFF_NST))[((size_t)h * 256 + c) * 128 + tid] = sacc; }
}

__device__ __forceinline__ void scan_item(const Params& p, LAS unsigned char* lds, const int tid, const int it, const bool dummy) {
    unsigned char* ws = p.ws;
    const float* SC = (const float*)(ws + OFF_SC);
    LAS float* do_s = (LAS float*)lds;
    LAS float* dl_s = do_s + 1024;
    LAS float* mp_s = dl_s + 1024;
    LAS float* bl_s = mp_s + 1024;
    LAS float* al_s = bl_s + 1024;
    LBAR();
    for (int i = tid; i < 2048; i += 512) bl_s[i] = SC[i];
    LBAR();
    if (tid < 4) { float m = 0.f;
        for (int c0 = 0; c0 < 256; c0 += 16) { float bl[16], al[16], mo[16];
#pragma unroll
            for (int i = 0; i < 16; ++i) { bl[i] = bl_s[tid * 256 + c0 + i]; al[i] = al_s[tid * 256 + c0 + i]; }
#pragma unroll
            for (int i = 0; i < 16; ++i) { mo[i] = m; m = fmaxf(bl[i] + m, al[i]); }
#pragma unroll
            for (int i = 0; i < 16; ++i) { const float mn = fmaxf(bl[i] + mo[i], al[i]);
                do_s[tid * 256 + c0 + i] = fexp(bl[i] + mo[i] - mn); dl_s[tid * 256 + c0 + i] = fexp(al[i] - mn); mp_s[tid * 256 + c0 + i] = mo[i]; } } }
    LBAR();
    {
        if (it < 128) {
            const int brh = it >> 4, part = it & 15, br = brh >> 2, h = brh & 3;
            unsigned* base = (unsigned*)(ws + OFF_KV) + (size_t)brh * 256 * 8192 + part * 512 + tid;
            unsigned* wbase = dummy ? (unsigned*)p.out + (size_t)brh * 256 * 8192 + part * 512 + tid : base;
            float s0 = 0.f, s1 = 0.f;
            const float cd = fexp(log_gamma(h) * 64.0f);
            for (int c0 = 0; c0 < 256; c0 += 32) {
                unsigned kv[32];
#pragma unroll
                for (int i = 0; i < 32; ++i) kv[i] = base[(size_t)(c0 + i) * 8192];
#pragma unroll
                for (int i = 0; i < 32; ++i) { const int c = c0 + i;
                    wbase[(size_t)c * 8192] = cvt_pk_bf16(s0, s1);
                    const float dold = (br == 0) ? do_s[h * 256 + c] : cd, dloc = (br == 0) ? dl_s[h * 256 + c] : 1.0f;
                    s0 = dold * s0 + dloc * bf_lo(kv[i]); s1 = dold * s1 + dloc * bf_hi(kv[i]); }
            }
        } else {
            const int h = tid >> 7, d = tid & 127;
            float* NST = (float*)(ws + OFF_NST) + (size_t)h * 256 * 128 + d; float* MP = (float*)(ws + OFF_SC) + 2048;
            for (int i = tid; i < 1024; i += 512) MP[i] = mp_s[i];
            float n = 0.f;
            for (int c0 = 0; c0 < 256; c0 += 16) {
                float nl[16];
#pragma unroll
                for (int i = 0; i < 16; ++i) nl[i] = NST[(c0 + i) * 128];
#pragma unroll
                for (int i = 0; i < 16; ++i) { const int c = c0 + i; if (!dummy) NST[c * 128] = n; n = do_s[h * 256 + c] * n + dl_s[h * 256 + c] * nl[i]; }
            }
        }
    }
}

template <bool RT>
__device__ __forceinline__ void out3_item(const Params& p, int l, int c, int h, LAS unsigned char* lds, const int tid, u16* zwb, const int nc, const int nh) {
    const int lane = tid & 63, w = tid >> 6, fr = lane & 15, quad = lane >> 4;
    unsigned char* ws = p.ws;
    LAS u16* Qs = (LAS u16*)lds;
    LAS u16* Ks = Qs + 64 * 136;
    LAS u16* VT = Ks + 64 * 136;
    LAS u16* STs = VT + 128 * 72;
    LAS float* fs = (LAS float*)(STs + 128 * 136);
    LAS float* rowterm = fs;
    LAS float* colterm = fs + 64;
    LAS float* dinter = fs + 128;
    LAS float* emt = fs + 192;
    LAS float* nprev = fs + 256;
    LAS float* red = fs + 384;
    const u16* proj = (const u16*)(ws + OFF_PROJ);
    float ic = 0.f, mp = 0.f, npv = 0.f;
    float2 bg = make_float2(0.f, 0.f);
    if (!RT) { if (w == 0) { const float* IFg = (const float*)(ws + OFF_IF) + (size_t)(c * 64 + lane) * 8; ic = IFg[h]; mp = ((const float*)(ws + OFF_SC))[2048 + h * 256 + c];
            bg = *(const float2*)((const float*)(ws + OFF_GATES) + ((size_t)h * S_ + c * 64 + lane) * 2); }
        if (tid >= 64 && tid < 192) npv = ((const float*)(ws + OFF_NST))[((size_t)h * 256 + c) * 128 + tid - 64]; }
    u32x4 vpre[2], spre[4];
#pragma unroll
    for (int i = 0; i < 2; ++i) vpre[i] = *(const u32x4*)(proj + (size_t)(RT ? T_RTV : T_MLV) * S_ * 512 + (size_t)(c * 4 + h) * 8192 + (size_t)(tid + i * 512) * 8);
    u32x4 qraw[2][4], kraw[2][4]; int ppos = 0;
    { const u16* Qb = proj + (size_t)(RT ? T_RTQ : T_MLQ) * S_ * 512; const u16* Kb = proj + (size_t)(RT ? T_RTK : T_MLK) * S_ * 512;
      if (!RT) {
        const int l0 = (tid >> 4) * 2, d0 = (tid & 15) * 8;
#pragma unroll
        for (int j = 0; j < 5; ++j) { const int tt = c * 64 + l0 - 3 + j; const size_t go_ = (size_t)tt * 512 + h * 128 + d0;
            qraw[j >> 2][j & 3] = (tt >= 0) ? *(const u32x4*)(Qb + go_) : (u32x4){0u, 0u, 0u, 0u}; kraw[j >> 2][j & 3] = (tt >= 0) ? *(const u32x4*)(Kb + go_) : (u32x4){0u, 0u, 0u, 0u}; }
      } else { const int l_ = tid >> 3, d0 = (tid & 7) * 8, t = c * 64 + l_; ppos = ((const int*)p.in[2])[t]; const size_t go_ = (size_t)t * 512 + h * 128 + d0;
        qraw[0][0] = *(const u32x4*)(Qb + go_); qraw[0][1] = *(const u32x4*)(Qb + go_ + 64); kraw[0][0] = *(const u32x4*)(Kb + go_); kraw[0][1] = *(const u32x4*)(Kb + go_ + 64); } }
    { const u16* ST = (const u16*)(ws + OFF_KV) + ((size_t)((RT ? 4 : 0) + h) * 256 + c) * 16384;
#pragma unroll
      for (int i = 0; i < 4; ++i) { const int ch = tid + i * 512; spre[i] = *(const u32x4*)(ST + (ch >> 4) * 128 + (ch & 15) * 8); } }
    LBAR();
    if (!RT) {
        if (w == 0) { const float bcum = bg.x, g = bg.y;
            const float mt = fmaxf(bcum + mp, g);
            rowterm[lane] = bcum - mt; colterm[lane] = ic - bcum; dinter[lane] = fexp(bcum + mp - mt); emt[lane] = fexp(-mt); }
        if (tid >= 64 && tid < 192) nprev[tid - 64] = npv;
        const LAS float* cwq = (const LAS float*)(lds + LDS_CONV); const LAS float* cwk = cwq + 2048;
        const int l0 = (tid >> 4) * 2, d0 = (tid & 15) * 8;
        f32x4 wq[4][2], wk[4][2];
#pragma unroll
        for (int j = 0; j < 4; ++j) { wq[j][0] = *(const LAS f32x4*)(cwq + j * 512 + h * 128 + d0); wq[j][1] = *(const LAS f32x4*)(cwq + j * 512 + h * 128 + d0 + 4);
            wk[j][0] = *(const LAS f32x4*)(cwk + j * 512 + h * 128 + d0); wk[j][1] = *(const LAS f32x4*)(cwk + j * 512 + h * 128 + d0 + 4); }
#pragma unroll
        for (int i = 0; i < 2; ++i) { const int l_ = l0 + i; float a[8], b[8];
#pragma unroll
            for (int e = 0; e < 8; ++e) { a[e] = 0.f; b[e] = 0.f; }
#pragma unroll
            for (int j = 0; j < 4; ++j) { const u32x4 qv = qraw[(i + j) >> 2][(i + j) & 3], kv = kraw[(i + j) >> 2][(i + j) & 3];
#pragma unroll
                for (int e = 0; e < 4; ++e) { a[e] += wq[j][0][e] * bfe(qv, e); a[4 + e] += wq[j][1][e] * bfe(qv, 4 + e); b[e] += wk[j][0][e] * bfe(kv, e); b[4 + e] += wk[j][1][e] * bfe(kv, 4 + e); } }
#pragma unroll
            for (int e = 0; e < 8; ++e) { a[e] = siluf_(a[e]); b[e] = siluf_(b[e]) * QSCALE; }
            u32x4 o; o.x = cvt_pk_bf16(a[0], a[1]); o.y = cvt_pk_bf16(a[2], a[3]); o.z = cvt_pk_bf16(a[4], a[5]); o.w = cvt_pk_bf16(a[6], a[7]); *(LAS u32x4*)(Qs + l_ * 136 + d0) = o;
            o.x = cvt_pk_bf16(b[0], b[1]); o.y = cvt_pk_bf16(b[2], b[3]); o.z = cvt_pk_bf16(b[4], b[5]); o.w = cvt_pk_bf16(b[6], b[7]); *(LAS u32x4*)(Ks + l_ * 136 + d0) = o; }
    } else {
        const int l_ = tid >> 3, d0 = (tid & 7) * 8; float a[8], b[8], a2[8], b2[8];
#pragma unroll
        for (int e = 0; e < 8; ++e) { float cs, sn; rot_cs(ppos, d0 + e, cs, sn);
            const float q1 = bfe(qraw[0][0], e), q2 = bfe(qraw[0][1], e), k1 = bfe(kraw[0][0], e), k2 = bfe(kraw[0][1], e);
            a[e] = q1 * cs - q2 * sn; a2[e] = q1 * sn + q2 * cs; b[e] = (k1 * cs - k2 * sn) * QSCALE; b2[e] = (k1 * sn + k2 * cs) * QSCALE; }
        u32x4 o; o.x = cvt_pk_bf16(a[0], a[1]); o.y = cvt_pk_bf16(a[2], a[3]); o.z = cvt_pk_bf16(a[4], a[5]); o.w = cvt_pk_bf16(a[6], a[7]); *(LAS u32x4*)(Qs + l_ * 136 + d0) = o;
        o.x = cvt_pk_bf16(a2[0], a2[1]); o.y = cvt_pk_bf16(a2[2], a2[3]); o.z = cvt_pk_bf16(a2[4], a2[5]); o.w = cvt_pk_bf16(a2[6], a2[7]); *(LAS u32x4*)(Qs + l_ * 136 + 64 + d0) = o;
        o.x = cvt_pk_bf16(b[0], b[1]); o.y = cvt_pk_bf16(b[2], b[3]); o.z = cvt_pk_bf16(b[4], b[5]); o.w = cvt_pk_bf16(b[6], b[7]); *(LAS u32x4*)(Ks + l_ * 136 + d0) = o;
        o.x = cvt_pk_bf16(b2[0], b2[1]); o.y = cvt_pk_bf16(b2[2], b2[3]); o.z = cvt_pk_bf16(b2[4], b2[5]); o.w = cvt_pk_bf16(b2[6], b2[7]); *(LAS u32x4*)(Ks + l_ * 136 + 64 + d0) = o;
    }
#pragma unroll
    for (int i = 0; i < 2; ++i) { const int ch = tid + i * 512; *(LAS u32x4*)(VT + (ch >> 3) * 72 + (ch & 7) * 8) = vpre[i]; }
#pragma unroll
    for (int i = 0; i < 4; ++i) { const int ch = tid + i * 512; *(LAS u32x4*)(STs + (ch >> 4) * 136 + (ch & 15) * 8) = spre[i]; }
    LBAR();
    const int tb = (w & 3) * 16, eh = (w >> 2) * 64;
    const int tl = tb + fr;
    const size_t go = (size_t)(c * 64 + tl) * 512 + h * 128 + eh + quad * 4;
    const u16* zr = (const u16*)(ws + OFF_PROJ) + (size_t)(RT ? T_RTZ : T_MLZ) * S_ * 512 + go; u16* zw = zwb + go;
    const u16* orow = proj + (size_t)T_MLO * S_ * 512 + go;
    u32x2 zpre[4], opre[4];
#pragma unroll
    for (int mt = 0; mt < 4; ++mt) { zpre[mt] = *(const u32x2*)(zr + mt * 16); if (!RT) opre[mt] = *(const u32x2*)(orow + mt * 16); else opre[mt] = zpre[mt]; }
    f32x4 st[4];
#pragma unroll
    for (int i = 0; i < 4; ++i) st[i] = (f32x4){0.f, 0.f, 0.f, 0.f};
    f32x4 oe[4], oi[4];
#pragma unroll
    for (int i = 0; i < 4; ++i) { oe[i] = (f32x4){0.f, 0.f, 0.f, 0.f}; oi[i] = (f32x4){0.f, 0.f, 0.f, 0.f}; }
#pragma unroll
    for (int ks = 0; ks < 4; ++ks) { const bf16x8 qf = lfrag(Qs, tl, 136, ks * 32 + quad * 8);
#pragma unroll
        for (int mt = 0; mt < 4; ++mt) st[mt] = MFMA16(lfrag(Ks, mt * 16 + fr, 136, ks * 32 + quad * 8), qf, st[mt]);
#pragma unroll
        for (int mt = 0; mt < 4; ++mt) oe[mt] = MFMA16(lfrag(STs, eh + mt * 16 + fr, 136, ks * 32 + quad * 8), qf, oe[mt]); }
    float dsum = 0.f;
    const float lg = log_gamma(h);
    const float rt_ = RT ? 0.f : rowterm[tl];
#pragma unroll
    for (int mt = 0; mt < 4; ++mt)
#pragma unroll
        for (int j = 0; j < 4; ++j) { const int s = mt * 16 + quad * 4 + j; float dec;
            if (RT) dec = fexp(lg * fabsf((float)(tl - s)));
            else dec = (s <= tl) ? fexp(rt_ + colterm[s]) : 0.f;
            const float v = st[mt][j] * dec; st[mt][j] = v; dsum += v; }
#pragma unroll
    for (int k2 = 0; k2 < 2; ++k2) { const bf16x8 pf = pack_p(st[2 * k2], st[2 * k2 + 1]);
#pragma unroll
        for (int mt = 0; mt < 4; ++mt) oi[mt] = MFMA16(lfrag_slot(VT, eh + mt * 16 + fr, 72, k2 * 32, quad), pf, oi[mt]); }
    float cin, cden = 1.0f;
    if (!RT) {
        dsum += __shfl_xor(dsum, 16); dsum += __shfl_xor(dsum, 32);
        float qn = 0.f;
#pragma unroll 8
        for (int i = 0; i < 32; ++i) qn += bf2f(Qs[tl * 136 + quad * 32 + i]) * nprev[quad * 32 + i];
        qn += __shfl_xor(qn, 16); qn += __shfl_xor(qn, 32);
        cin = dinter[tl];
        const float den = cin * qn + dsum;
        cden = 1.0f / fmaxf(fabsf(den), emt[tl]);
    } else cin = fexp(lg * (float)(tl + 1));
    float s1 = 0.f, s2 = 0.f;
#pragma unroll
    for (int mt = 0; mt < 4; ++mt)
#pragma unroll
        for (int j = 0; j < 4; ++j) { const float v = (cin * oe[mt][j] + oi[mt][j]) * cden; oi[mt][j] = v; s1 += v; s2 += v * v; }
    s1 += __shfl_xor(s1, 16); s1 += __shfl_xor(s1, 32); s2 += __shfl_xor(s2, 16); s2 += __shfl_xor(s2, 32);
    if (quad == 0) { red[((w >> 2) * 64 + tl) * 2] = s1; red[((w >> 2) * 64 + tl) * 2 + 1] = s2; }
    LBAR();
    const float t1 = red[tl * 2] + red[(64 + tl) * 2], t2 = red[tl * 2 + 1] + red[(64 + tl) * 2 + 1];
    const float mu = t1 * (1.0f / 128.0f); const float var = fmaxf(t2 * (1.0f / 128.0f) - mu * mu, 0.f); const float rstd = rsqrtf(var + EPS);
#pragma unroll
    for (int mt = 0; mt < 4; ++mt) { const u32x2 z = zpre[mt];
        float g0 = siluf_(bf_lo(z.x)), g1 = siluf_(bf_hi(z.x)), g2 = siluf_(bf_lo(z.y)), g3 = siluf_(bf_hi(z.y));
        if (!RT) { const u32x2 ov = opre[mt]; g0 *= sigmoidf_(bf_lo(ov.x)); g1 *= sigmoidf_(bf_hi(ov.x)); g2 *= sigmoidf_(bf_lo(ov.y)); g3 *= sigmoidf_(bf_hi(ov.y)); }
        u32x2 r; r.x = cvt_pk_bf16((oi[mt][0] - mu) * rstd * g0, (oi[mt][1] - mu) * rstd * g1); r.y = cvt_pk_bf16((oi[mt][2] - mu) * rstd * g2, (oi[mt][3] - mu) * rstd * g3);
        *(u32x2*)(zw + mt * 16) = r; }
}

__device__ __forceinline__ void gm_item(const Params& p, int l, int nb, LAS unsigned char* lds, const int tid, u16* zwb) {
    const int lane = tid & 63, w = tid >> 6, fr = lane & 15, quad = lane >> 4;
    unsigned char* ws = p.ws;
    LAS u16* Wm = (LAS u16*)lds;
    LAS u16* VNT = Wm + 128 * 136;
    LAS float* mu_s = (LAS float*)(VNT + 128 * 136);
    LAS float* rs_s = mu_s + 128;
    const u16* V = (const u16*)(ws + OFF_PROJ) + (size_t)T_GMV * S_ * 512 + (size_t)nb * 128 * 512;
    LBAR();
    { const int r = tid >> 2, part = tid & 3; float s1 = 0.f, s2 = 0.f;
#pragma unroll 8
      for (int i = 0; i < 16; ++i) { const u32x4 v = *(const u32x4*)(V + (size_t)r * 512 + part * 128 + i * 8);
#pragma unroll
          for (int e = 0; e < 8; ++e) { const float x = geluf_(bfe(v, e)); s1 += x; s2 += x * x; } }
      s1 += __shfl_xor(s1, 1); s1 += __shfl_xor(s1, 2); s2 += __shfl_xor(s2, 1); s2 += __shfl_xor(s2, 2);
      if (part == 0) { const float mu = s1 * (1.0f / 512.0f); const float var = fmaxf(s2 * (1.0f / 512.0f) - mu * mu, 0.f); mu_s[r] = mu; rs_s[r] = rsqrtf(var + EPS); } }
    for (int g = 0; g < 4; ++g) {
    if (g) LBAR();
    { const float* wsrc = (const float*)p.in[12] + ((size_t)l * 4 + g) * 16384;
#pragma unroll
      for (int i = 0; i < 4; ++i) { const int ch = tid + i * 512, pr = ch >> 4, q0 = (ch & 15) * 8;
          f32x4 a = *(const f32x4*)(wsrc + pr * 128 + q0), b = *(const f32x4*)(wsrc + pr * 128 + q0 + 4);
          if (pr < 64 && q0 >= 64) { a = (f32x4){0.f, 0.f, 0.f, 0.f}; b = a; }
          u32x4 o; o.x = cvt_pk_bf16(a[0], a[1]); o.y = cvt_pk_bf16(a[2], a[3]); o.z = cvt_pk_bf16(b[0], b[1]); o.w = cvt_pk_bf16(b[2], b[3]);
          *(LAS u32x4*)(Wm + pr * 136 + q0) = o; } }
    LBAR();
    { const float* lng = (const float*)p.in[10] + l * 512 + g * 128; const float* lnb = (const float*)p.in[11] + l * 512 + g * 128;
#pragma unroll
      for (int i = 0; i < 4; ++i) { const int q = lane + 64 * (i & 1), c0 = (w + 8 * (i >> 1)) * 8;
          const u32x4 v = *(const u32x4*)(V + (size_t)q * 512 + g * 128 + c0); const float mu = mu_s[q], rs = rs_s[q];
          float a[8];
#pragma unroll
          for (int e = 0; e < 8; ++e) a[e] = (geluf_(bfe(v, e)) - mu) * rs * lng[c0 + e] + lnb[c0 + e];
          st_tr8(VNT, 136, c0, q, a); } }
    LBAR();
    const int cb = (w & 3) * 32, ph = (w >> 2) * 64;
    u32x2 upre[4][2], zpre[4][2];
#pragma unroll
    for (int b = 0; b < 4; ++b)
#pragma unroll
        for (int a = 0; a < 2; ++a) { const size_t go = (size_t)(nb * 128 + ph + b * 16 + fr) * 512 + g * 128 + cb + a * 16 + quad * 4;
            upre[b][a] = *(const u32x2*)((const u16*)(ws + OFF_PROJ) + (size_t)T_GMU * S_ * 512 + go); zpre[b][a] = *(const u32x2*)((const u16*)(ws + OFF_PROJ) + (size_t)T_GMZ * S_ * 512 + go); }
    f32x4 acc[2][4];
#pragma unroll
    for (int a = 0; a < 2; ++a)
#pragma unroll
        for (int b = 0; b < 4; ++b) acc[a][b] = (f32x4){0.f, 0.f, 0.f, 0.f};
#pragma unroll
    for (int ks = 0; ks < 4; ++ks) { bf16x8 af[2], bfr[4];
#pragma unroll
        for (int a = 0; a < 2; ++a) af[a] = lfrag(VNT, cb + a * 16 + fr, 136, ks * 32 + quad * 8);
#pragma unroll
        for (int b = 0; b < 4; ++b) bfr[b] = lfrag(Wm, ph + b * 16 + fr, 136, ks * 32 + quad * 8);
#pragma unroll
        for (int a = 0; a < 2; ++a)
#pragma unroll
            for (int b = 0; b < 4; ++b) acc[a][b] = MFMA16(af[a], bfr[b], acc[a][b]); }
    const float* bs = (const float*)p.in[13] + ((size_t)l * 4 + g) * 128;
#pragma unroll
    for (int b = 0; b < 4; ++b) { const int pl = ph + b * 16 + fr; const float bias = bs[pl];
#pragma unroll
        for (int a = 0; a < 2; ++a) { const size_t go = (size_t)(nb * 128 + pl) * 512 + g * 128 + cb + a * 16 + quad * 4;
            const u32x2 uv = upre[b][a], z = zpre[b][a];
            u32x2 r; r.x = cvt_pk_bf16(geluf_(bf_lo(uv.x)) * (acc[a][b][0] + bias) * siluf_(bf_lo(z.x)), geluf_(bf_hi(uv.x)) * (acc[a][b][1] + bias) * siluf_(bf_hi(z.x)));
            r.y = cvt_pk_bf16(geluf_(bf_lo(uv.y)) * (acc[a][b][2] + bias) * siluf_(bf_lo(z.y)), geluf_(bf_hi(uv.y)) * (acc[a][b][3] + bias) * siluf_(bf_hi(z.y)));
            *(u32x2*)(zwb + go) = r; } }
    }
}

__device__ __forceinline__ void xa_item(const Params& p, int sb5, int h, LAS unsigned char* lds, const int tid, u16* zwb) {
    const int lane = tid & 63, w = tid >> 6, fr = lane & 15, quad = lane >> 4;
    unsigned char* ws = p.ws;
    LAS u16* KM = (LAS u16*)lds;
    LAS u16* VT = KM + 256 * 136;
    const u16* MKV = (const u16*)(ws + OFF_MKV);
    u32x4 kpre[8], vpre[8];
#pragma unroll
    for (int i = 0; i < 8; ++i) { const int ch = tid + i * 512, r = ch >> 4, c = ch & 15; kpre[i] = *(const u32x4*)(MKV + (size_t)r * 1024 + h * 128 + c * 8); }
#pragma unroll
    for (int i = 0; i < 8; ++i) { const int ch = tid + i * 512; vpre[i] = *(const u32x4*)(MKV + 256 * 1024 + (size_t)(h * 128 + (ch >> 5)) * 256 + (ch & 31) * 8); }
    LBAR();
#pragma unroll
    for (int i = 0; i < 8; ++i) { const int ch = tid + i * 512, r = ch >> 4, c = ch & 15; *(LAS u32x4*)(KM + r * 136 + c * 8) = kpre[i]; }
#pragma unroll
    for (int i = 0; i < 8; ++i) { const int ch = tid + i * 512; *(LAS u32x4*)(VT + (ch >> 5) * 264 + (ch & 31) * 8) = vpre[i]; }
    LBAR();
#pragma unroll 1
    for (int sub = 0; sub < 4; ++sub) {
        int row = (sb5 * 4 + sub) * 128 + w * 16 + fr;
        asm volatile("" : "+v"(row));
        const u16* Qr = (const u16*)(ws + OFF_PROJ) + (size_t)T_XAQ * S_ * 512 + (size_t)row * 512 + h * 128 + quad * 8;
        bf16x8 qf[4];
#pragma unroll
        for (int ks = 0; ks < 4; ++ks) qf[ks] = *(const bf16x8*)(Qr + ks * 32);
        const size_t zo = (size_t)row * 512 + h * 128 + quad * 4;
        const u16* zr = (const u16*)(ws + OFF_PROJ) + (size_t)T_XAZ * S_ * 512 + zo; u16* zw = zwb + zo;
        u32x2 zpre[8];
#pragma unroll
        for (int mt = 0; mt < 8; ++mt) zpre[mt] = *(const u32x2*)(zr + mt * 16);
        f32x4 st[16];
#pragma unroll
        for (int i = 0; i < 16; ++i) st[i] = (f32x4){0.f, 0.f, 0.f, 0.f};
#pragma unroll
        for (int ks = 0; ks < 4; ++ks) {
#pragma unroll
            for (int mt = 0; mt < 16; ++mt) st[mt] = MFMA16(lfrag(KM, mt * 16 + fr, 136, ks * 32 + quad * 8), qf[ks], st[mt]); }
        float mx = -1e30f;
#pragma unroll
        for (int mt = 0; mt < 16; ++mt)
#pragma unroll
            for (int j = 0; j < 4; ++j) mx = fmaxf(mx, st[mt][j]);
        mx = fmaxf(mx, __shfl_xor(mx, 16)); mx = fmaxf(mx, __shfl_xor(mx, 32));
        float sum = 0.f;
#pragma unroll
        for (int mt = 0; mt < 16; ++mt)
#pragma unroll
            for (int j = 0; j < 4; ++j) { const float e = fexp(st[mt][j] - mx); st[mt][j] = e; sum += e; }
        sum += __shfl_xor(sum, 16); sum += __shfl_xor(sum, 32);
        f32x4 o[8];
#pragma unroll
        for (int i = 0; i < 8; ++i) o[i] = (f32x4){0.f, 0.f, 0.f, 0.f};
#pragma unroll
        for (int k2 = 0; k2 < 8; ++k2) { const bf16x8 pf = pack_p(st[2 * k2], st[2 * k2 + 1]);
#pragma unroll
            for (int mt = 0; mt < 8; ++mt) o[mt] = MFMA16(lfrag_slot(VT, mt * 16 + fr, 264, k2 * 32, quad), pf, o[mt]); }
        const float inv = 1.0f / sum;
#pragma unroll
        for (int mt = 0; mt < 8; ++mt) { const u32x2 z = zpre[mt];
            u32x2 r; r.x = cvt_pk_bf16(o[mt][0] * inv * siluf_(bf_lo(z.x)), o[mt][1] * inv * siluf_(bf_hi(z.x))); r.y = cvt_pk_bf16(o[mt][2] * inv * siluf_(bf_lo(z.y)), o[mt][3] * inv * siluf_(bf_hi(z.y)));
            *(u32x2*)(zw + mt * 16) = r; }
    }
}

__device__ __forceinline__ int q_pop(unsigned* ctr, LAS int* slot, const int tid) {
    LBAR();
    if (tid == 0) *slot = (int)__hip_atomic_fetch_add(ctr, 1u, __ATOMIC_RELAXED, __HIP_MEMORY_SCOPE_AGENT);
    LBAR();
    return *slot;
}
constexpr int N_PHASES = 17;
#ifdef DUP_MASK
#define DUPREP rep
#else
#define DUPREP 0
#endif
#ifndef P3MASK
#define P3MASK 15
#endif
#ifndef DUPSEL
#define DUPSEL 15
#endif
#ifndef DUP_PHMAX
#define DUP_PHMAX 16
#endif
#ifndef IMASK
#define IMASK 31
#endif
#ifndef PMASK
#define PMASK 127
#endif
__global__ void __launch_bounds__(512) hybrid_fwd(Params p) {
    extern __shared__ __attribute__((aligned(16))) unsigned char lds_raw[];
    LAS unsigned char* lds = (LAS unsigned char*)lds_raw;
    volatile LAS unsigned* xst = (volatile LAS unsigned*)(lds + LDS_CTL);
    LAS int* qslot = (LAS int*)(lds + LDS_CTL + 32);
    if (p.ph_hi - p.ph_lo > 2) { if (threadIdx.x < 4) xst[threadIdx.x] = 0u; __syncthreads();
        const XcdBarrier b0 = xcd_barrier_post((unsigned*)(p.ws + OFF_BAR), xst); if (threadIdx.x == 0) xst[2] = b0.x; }
    for (int ph = p.ph_lo; ph < p.ph_hi; ++ph) {
        if (ph > p.ph_lo) { if (p.ph_hi > 1000) cg::this_grid().sync();
            else { size_t boff = OFF_BAR; asm volatile("" : "+s"(boff)); unsigned* barp = (unsigned*)(p.ws + boff); XcdBarrier xb;     xb.bar = barp; xb.x = xst[2]; xb.st = xst; xcd_barrier(xb); } }
#ifdef DUP_MASK
        for (int rep = 0; rep < ((ph < DUP_PHMAX) ? 1 + ((DUP_MASK >> (ph % 8)) & 1) : 1); ++rep) { if (rep) __syncthreads();
#endif
        int tid = threadIdx.x, bid = blockIdx.x, nblk = gridDim.x; unsigned char* ws = p.ws;
        size_t wso = 0; asm volatile("" : "+v"(tid), "+s"(bid), "+s"(nblk), "+s"(wso)); ws = p.ws + wso;
        Params q = p; q.ws = ws;
#ifdef DUP_MASK
        const bool dummy = (rep == 0) && (((DUP_MASK >> (ph % 8)) & 1) != 0) && ph < DUP_PHMAX;
#else
        const bool dummy = false;
#endif
#define ZW(T) (dummy ? (u16*)p.out : (u16*)(ws + OFF_PROJ) + (size_t)(T) * S_ * 512)
        if (ph == 16) { if (PMASK & 1) phase_prep(q, 2, lds, tid, bid, nblk); continue; }
        const int l = ph / 8, s = ph % 8;
        if (s == 0) { if (PMASK & 1) phase_prep(q, l, lds, tid, bid, nblk); }
        else if (s == 1) { if (PMASK & 2) {
            pg8::Gemm g{(const u16*)(ws + OFF_H), (const u16*)(ws + OFF_WIN), S_, NPROJ, 1024};
            pg8::StaticOrder so; so.init(S_, NPROJ, nblk, bid);
            EpiProj E{(u16*)(ws + OFF_PROJ), (u16*)(ws + OFF_MKV)};
            pg8::gemm_phase<EpiProj, pg8::StaticOrder>(lds, g, so, E, tid);
        } } else if (s == 2) { if (PMASK & 4) { const int tid_ = tid;
            static_assert(OFF_MEMH == OFF_H + 64ull * 256 * 1024 * 2 && OFF_WMKV == OFF_WIN + 70ull * 256 * 1024 * 2, "the mem_kv GEMM addresses MEMH / WMKV as tile (64, 70..73) of the projection GEMM");
            unsigned* ctr = (unsigned*)(ws + OFF_BAR) + XCD_BAR_WORDS + 64 * (2 * l + 4 * DUPREP);
            { LAS float* cw = (LAS float*)(lds + LDS_CONV); const float* cq = (const float*)p.in[8] + (size_t)l * 2048; const float* ck = (const float*)p.in[9] + (size_t)l * 2048;
              for (int i = tid_; i < 2048; i += 512) { cw[i] = cq[i]; cw[2048 + i] = ck[i]; } }
            int it = q_pop(ctr, qslot, tid_);
            while (it < 4 + 1024) {
                int tid = tid_; asm volatile("" : "+v"(tid));
                unsigned nxt = 0; if (tid_ == 0) nxt = __hip_atomic_fetch_add(ctr, 1u, __ATOMIC_RELAXED, __HIP_MEMORY_SCOPE_AGENT);
                if (it < 4) { pg8::Gemm g{(const u16*)(ws + OFF_H), (const u16*)(ws + OFF_WIN), S_, NPROJ, 1024}; OneUnit ou{64, 70 + it, p.ph_hi > 1000 ? 2 : 1};
                    EpiProj E{(u16*)(ws + OFF_PROJ), (u16*)(ws + OFF_MKV)}; pg8::gemm_phase<EpiProj, OneUnit>(lds, g, ou, E, tid);
                    { LAS float* cw = (LAS float*)(lds + LDS_CONV); const float* cq = (const float*)p.in[8] + (size_t)l * 2048; const float* ck = (const float*)p.in[9] + (size_t)l * 2048;
                      for (int i = tid_; i < 2048; i += 512) { cw[i] = cq[i]; cw[2048 + i] = ck[i]; } } }
                else { const int j = it - 4; kv1_pair(q, l, j >> 2, j & 3, lds, tid); }
                LBAR(); if (tid_ == 0) *qslot = (int)nxt; LBAR(); it = *qslot;
            }
        } } else if (s == 3) { if (PMASK & 8) { const int tid_ = tid;
            const u16* proj = (const u16*)(ws + OFF_PROJ);
            unsigned* ctr = (unsigned*)(ws + OFF_BAR) + XCD_BAR_WORDS + 64 * (2 * l + 1 + 4 * DUPREP);
            int it = q_pop(ctr, qslot, tid_);
            while (it < 129 + 128 + 512 + 128) {
                int tid = tid_; asm volatile("" : "+v"(tid));
                unsigned nxt = 0; if (tid_ == 0) nxt = __hip_atomic_fetch_add(ctr, 1u, __ATOMIC_RELAXED, __HIP_MEMORY_SCOPE_AGENT);
                if (it < 129) { if ((P3MASK & 1) && (!dummy || (DUPSEL & 1))) scan_item(q, lds, tid, it, dummy); }
                else if (it < 129 + 128) { const int j = it - 129; if ((P3MASK & 8) && (!dummy || (DUPSEL & 8))) xa_item(q, j >> 2, j & 3, lds, tid, ZW(T_XAZ)); }
                else if (it < 129 + 256) { if ((P3MASK & 2) && (!dummy || (DUPSEL & 2))) gm_item(q, l, it - 257, lds, tid, ZW(T_GMZ)); }
                else { const int j = it - 385; if ((P3MASK & 4) && (!dummy || (DUPSEL & 4))) sb_item(proj + (size_t)T_SBQ * S_ * 512, proj + (size_t)T_SBK * S_ * 512, proj + (size_t)T_SBV * S_ * 512, proj + (size_t)T_SBZ * S_ * 512, ZW(T_SBZ), j >> 2, j & 3, lds, tid); }
                LBAR(); if (tid_ == 0) *qslot = (int)nxt; LBAR(); it = *qslot;
            }
        } }
        else if (s == 4) { if (PMASK & 16) { const int tid_ = tid;
            { LAS float* cw = (LAS float*)(lds + LDS_CONV); const float* cq = (const float*)p.in[8] + (size_t)l * 2048; const float* ck = (const float*)p.in[9] + (size_t)l * 2048;
              for (int i = tid_; i < 2048; i += 512) { cw[i] = cq[i]; cw[2048 + i] = ck[i]; } __syncthreads(); }
            for (int it = bid; it < 2048; it += nblk) {
                int tid = tid_; asm volatile("" : "+v"(tid));
                const int itn = it + nblk; const bool same = (itn < 2048) && ((itn < 1024) == (it < 1024)); const int jn = itn < 1024 ? itn : itn - 1024;
                if (it < 1024) { if (!dummy || (DUPSEL & 1)) out3_item<false>(q, l, it >> 2, it & 3, lds, tid, ZW(T_MLZ), same ? (jn >> 2) : -1, jn & 3); }
                else { const int j = it - 1024; if (!dummy || (DUPSEL & 2)) out3_item<true>(q, l, j >> 2, j & 3, lds, tid, ZW(T_RTZ), same ? (jn >> 2) : -1, jn & 3); }
            }
        } } else if (s == 5) { if (PMASK & 32) {
            pg8::Gemm g{(const u16*)(ws + OFF_H), (const u16*)(ws + OFF_WIN) + (size_t)NPROJ * 1024, S_, 5120, 1024};
            pg8::StaticOrder so; so.init(S_, 5120, nblk, bid);
            EpiGateE E{(u16*)(ws + OFF_PROJ)};
            pg8::gemm_phase<EpiGateE, pg8::StaticOrder>(lds, g, so, E, tid);
        } } else if (s == 6) { if (PMASK & 32) {
            pg8::Gemm g{(const u16*)(ws + OFF_PROJ), (const u16*)(ws + OFF_WUP), S_, 1024, 512};
            UpOrder so; so.init(S_, 1024, nblk, bid);
            EpiMerge E{(const u16*)(ws + OFF_PROJ), (u16*)(ws + OFF_MERGED)};
            pg8::gemm_phase<EpiMerge, UpOrder>(lds, g, so, E, tid);
        } } else { if (PMASK & 64) {
            pg8::Gemm g{(const u16*)(ws + OFF_MERGED), (const u16*)(ws + OFF_WOUT), S_, 1024, 1024};
            pg8::StaticOrder so; so.init(S_, 1024, nblk, bid);
            EpiOutBf16 E{(u16*)(ws + OFF_OUTF)};
            pg8::gemm_phase<EpiOutBf16, pg8::StaticOrder>(lds, g, so, E, tid);
        } }
#ifdef DUP_MASK
        }
#endif
    }
}

#ifdef DBG_K
__global__ void dbg_dump(const unsigned* ws, float* out, size_t nwords, int n) {
    for (int i = blockIdx.x * blockDim.x + threadIdx.x; i < n; i += gridDim.x * blockDim.x) {
        unsigned s = 0; for (size_t k = i; k < nwords; k += (size_t)n) s += ws[k] * 2654435761u + (ws[k] >> 16);
        out[i] = (float)(s & 0xFFFFFu); }
}
#endif
extern "C" void kernel_launch(void* const* d_in, const int* in_sizes, int n_in, void* d_out, int out_size, void* d_ws, size_t ws_size, hipStream_t stream) {
    static int grid = 0;
    if (grid == 0) {
        if (n_in != 18 || out_size != S_ * DM || ws_size < WS_END) { fprintf(stderr, "kernel_launch: unexpected shapes / workspace (%d inputs, out %d, ws %zu < %zu)\n", n_in, out_size, ws_size, (size_t)WS_END); grid = -1; return; }
        int dev = 0, cus = 0, per_cu = 0;
        (void)hipGetDevice(&dev); (void)hipDeviceGetAttribute(&cus, hipDeviceAttributeMultiprocessorCount, dev);
        if (hipFuncSetAttribute((const void*)hybrid_fwd, hipFuncAttributeMaxDynamicSharedMemorySize, LDS_BYTES) != hipSuccess) { fprintf(stderr, "kernel_launch: hipFuncSetAttribute failed\n"); grid = -1; return; }
        if (hipOccupancyMaxActiveBlocksPerMultiprocessor(&per_cu, (const void*)hybrid_fwd, 512, LDS_BYTES) != hipSuccess || per_cu < 1) per_cu = 1;
        (void)hipGetLastError();
        grid = cus * per_cu; if (grid > 256) grid = 256; if (grid < 4) grid = 4;
    }
    if (grid < 0) return;
    (void)hipMemsetAsync((unsigned char*)d_ws + OFF_BAR, 0, 16384, stream);
    Params p{};
    for (int i = 0; i < 18; ++i) p.in[i] = d_in[i];
    p.out = (float*)d_out; p.ws = (unsigned char*)d_ws;
#if ONE_LAUNCH
    p.ph_lo = 0; p.ph_hi = N_PHASES;
    void* args[] = {&p};
    hipError_t e = hipLaunchCooperativeKernel((const void*)hybrid_fwd, dim3(grid), dim3(512), args, LDS_BYTES, stream);
    if (e != hipSuccess) fprintf(stderr, "cooperative launch failed: %s (grid %d)\n", hipGetErrorString(e), grid);
#else
#ifdef DBG_K
    for (int ph = 0; ph < DBG_K; ++ph) { p.ph_lo = ph; p.ph_hi = ph + 1; hipLaunchKernelGGL(hybrid_fwd, dim3(grid), dim3(512), LDS_BYTES, stream, p); }
    hipLaunchKernelGGL(dbg_dump, dim3(2048), dim3(256), 0, stream, (const unsigned*)d_ws, (float*)d_out, (size_t)(WS_END / 4), out_size);
#else
    for (int ph = 0; ph < N_PHASES; ++ph) { p.ph_lo = ph; p.ph_hi = ph + 1; hipLaunchKernelGGL(hybrid_fwd, dim3(grid), dim3(512), LDS_BYTES, stream, p); }
#endif
#endif
}
```
